# Optimizing an MI355X kernel written in HIP

```python
import math
import jax, jax.numpy as jnp
from jax import lax
import numpy as np

D_MODEL = 2048
BATCH = 4
SEQ = 4096
DEPTH = 4

N_A = DEPTH // 2
N_B = DEPTH - N_A
SSM_WIDTH = D_MODEL
SSM_GROUP = 16
SSM_GROUPS = SSM_WIDTH // SSM_GROUP
SSM_STATE = 64
N_HEADS = 16
N_KV = 4
HPG = N_HEADS // N_KV
HEAD_DIM = D_MODEL // N_HEADS
ATT_WIDTH = N_HEADS * HEAD_DIM
N_BRANCH = 3
CMP_LEN = 32
CMP_STRIDE = 16
SEL_LEN = 64
SEL_TOPK = 16
WINDOW = 512
WIN_QBLOCK = 128
SEL_QCHUNK = 32
SEL_BONUS = 1e3
NEG = -1e30
EPS = 1e-6

kernel_name = "yoco_s5_nsa_hybrid"


def rmsnorm(x, g):
    xf = x.astype(jnp.float32)
    y = xf * lax.rsqrt(jnp.mean(xf * xf, axis=-1, keepdims=True) + EPS)
    return (y * g.astype(jnp.float32)).astype(x.dtype)


def modulate(h, shift, scale):
    return h * (1.0 + scale[:, None, :]) + shift[:, None, :]


def masked_softmax(s, mask):
    s = jnp.where(mask, s.astype(jnp.float32), NEG)
    p = jax.nn.softmax(s, axis=-1)
    return jnp.where(mask, p, 0.0)


def s5_discretize(lam_re, lam_im, log_step, b_re, b_im):
    dt = jnp.exp(log_step.astype(jnp.float32))[:, None]
    lr, li = lam_re.astype(jnp.float32), lam_im.astype(jnp.float32)
    mag = jnp.exp(lr * dt)
    a_re, a_im = mag * jnp.cos(li * dt), mag * jnp.sin(li * dt)
    den = lr * lr + li * li
    coef_re = ((a_re - 1.0) * lr + a_im * li) / den
    coef_im = (a_im * lr - (a_re - 1.0) * li) / den
    br, bi = b_re.astype(jnp.float32), b_im.astype(jnp.float32)
    bb_re = coef_re[..., None] * br - coef_im[..., None] * bi
    bb_im = coef_re[..., None] * bi + coef_im[..., None] * br
    return a_re, a_im, bb_re, bb_im


def _ssm_combine(left, right):
    ar_i, ai_i, br_i, bi_i = left
    ar_j, ai_j, br_j, bi_j = right
    return (ar_j * ar_i - ai_j * ai_i,
            ar_j * ai_i + ai_j * ar_i,
            ar_j * br_i - ai_j * bi_i + br_j,
            ar_j * bi_i + ai_j * br_i + bi_j)


def _scan_one(a_re, a_im, bu_re, bu_im):
    out = lax.associative_scan(_ssm_combine, (a_re, a_im, bu_re, bu_im), axis=0)
    return out[2], out[3]


def s5_mixer(h, w_in, lam_re, lam_im, log_step, b_re, b_im, c_re, c_im, d_skip, w_glu, b_glu, w_out):
    B_, L, _ = h.shape
    u, z = jnp.split(h @ w_in, 2, axis=-1)
    ug = u.reshape(B_, L, SSM_GROUPS, SSM_GROUP).astype(jnp.float32)
    a_re, a_im, bb_re, bb_im = s5_discretize(lam_re, lam_im, log_step, b_re, b_im)
    bu_re = jnp.einsum('blgc,gnc->blgn', ug, bb_re)
    bu_im = jnp.einsum('blgc,gnc->blgn', ug, bb_im)
    shp = (L, SSM_GROUPS, SSM_STATE)
    x_re, x_im = jax.vmap(_scan_one, in_axes=(None, None, 0, 0))(
        jnp.broadcast_to(a_re, shp), jnp.broadcast_to(a_im, shp), bu_re, bu_im)
    y = (jnp.einsum('blgn,gcn->blgc', x_re, c_re.astype(jnp.float32))
         - jnp.einsum('blgn,gcn->blgc', x_im, c_im.astype(jnp.float32)))
    y = y + d_skip.astype(jnp.float32).reshape(SSM_GROUPS, SSM_GROUP) * ug
    y = jax.nn.gelu(y.reshape(B_, L, SSM_WIDTH).astype(h.dtype))
    y = y * jax.nn.sigmoid(y @ w_glu + b_glu)
    return (y * jax.nn.silu(z)) @ w_out


def compress_blocks(t, blk_idx, pe, w1, b1, w2, b2):
    blocks = t[:, blk_idx] + pe[None, None, :, None, :]
    B_, n = blocks.shape[:2]
    flat = jnp.moveaxis(blocks, 3, 2).reshape(B_, n, N_KV, CMP_LEN * HEAD_DIM)
    return jax.nn.gelu(flat @ w1 + b1) @ w2 + b2


def nsa_shared_kv(h_kv, w_kv, cmp_pe, cmp_w1, cmp_b1, cmp_w2, cmp_b2):
    B_, L, _ = h_kv.shape
    kv = (h_kv @ w_kv).reshape(B_, L, 2 * N_BRANCH, N_KV, HEAD_DIM)
    n_cmp = (L - CMP_LEN) // CMP_STRIDE + 1
    blk_idx = np.arange(n_cmp)[:, None] * CMP_STRIDE + np.arange(CMP_LEN)[None, :]
    kc = compress_blocks(kv[:, :, 0], blk_idx, cmp_pe[0], cmp_w1[0], cmp_b1[0], cmp_w2[0], cmp_b2[0])
    vc = compress_blocks(kv[:, :, 1], blk_idx, cmp_pe[1], cmp_w1[1], cmp_b1[1], cmp_w2[1], cmp_b2[1])
    return kc, vc, kv[:, :, 2], kv[:, :, 3], kv[:, :, 4], kv[:, :, 5]


def cmp_attention(q, kc, vc, pos):
    n_cmp = kc.shape[1]
    s = jnp.einsum('blghd,bngd->bghln', q, kc)
    blk_end = jnp.arange(n_cmp) * CMP_STRIDE + CMP_LEN - 1
    mask = blk_end[None, :] <= pos[:, None]
    p = masked_softmax(s, mask)
    o = jnp.einsum('bghln,bngd->blghd', p.astype(vc.dtype), vc)
    return o, p.sum(axis=2)


def selection_overlap(n_cmp, n_slc):
    c0 = np.arange(n_cmp)[:, None] * CMP_STRIDE
    s0 = np.arange(n_slc)[None, :] * SEL_LEN
    ov = np.clip(np.minimum(c0 + CMP_LEN, s0 + SEL_LEN) - np.maximum(c0, s0), 0, None)
    return (ov / CMP_STRIDE).astype(np.float32)


def select_blocks(p_cmp, pos):
    n_cmp = p_cmp.shape[-1]
    n_slc = pos.shape[0] // SEL_LEN
    p_slc = jnp.einsum('bgln,ns->bgls', p_cmp, jnp.asarray(selection_overlap(n_cmp, n_slc)))
    blk = jnp.arange(n_slc)[None, :]
    cur = (pos // SEL_LEN)[:, None]
    valid = blk <= cur
    forced = ((blk == 0) | (blk == cur) | (blk == cur - 1)).astype(jnp.float32)
    score = jnp.where(valid, p_slc + SEL_BONUS * forced, -SEL_BONUS)
    top, idx = lax.top_k(score, min(SEL_TOPK, n_slc))
    return idx, top > -0.5 * SEL_BONUS


def selected_attention(q, ks, vs, idx, ok):
    B_, L = q.shape[:2]
    n_slc = L // SEL_LEN
    n_ch = L // SEL_QCHUNK
    kb = jnp.moveaxis(ks.reshape(B_, n_slc, SEL_LEN, N_KV, HEAD_DIM), 3, 1)
    vb = jnp.moveaxis(vs.reshape(B_, n_slc, SEL_LEN, N_KV, HEAD_DIM), 3, 1)
    q_ch = jnp.moveaxis(q.reshape(B_, n_ch, SEL_QCHUNK, N_KV, HPG, HEAD_DIM), 1, 0)
    idx_ch = jnp.moveaxis(idx.reshape(B_, N_KV, n_ch, SEL_QCHUNK, -1), 2, 0)
    ok_ch = jnp.moveaxis(ok.reshape(B_, N_KV, n_ch, SEL_QCHUNK, -1), 2, 0)
    gather = jax.vmap(jax.vmap(lambda blocks, ix: blocks[ix]))
    offs = jnp.arange(SEL_LEN)

    def chunk(args):
        ci, qc, ic, oc = args
        t = ci * SEL_QCHUNK + jnp.arange(SEL_QCHUNK)
        kg = gather(kb, ic)
        vg = gather(vb, ic)
        s = jnp.einsum('bqghd,bgqksd->bgqhks', qc, kg)
        kpos = ic[..., None] * SEL_LEN + offs
        mask = (oc[..., None] & (kpos <= t[None, None, :, None, None]))[:, :, :, None]
        p = masked_softmax(s.reshape(*s.shape[:4], -1), mask.reshape(*mask.shape[:4], -1))
        p = p.reshape(s.shape).astype(vg.dtype)
        return jnp.einsum('bgqhks,bgqksd->bqghd', p, vg)

    o = lax.map(chunk, (jnp.arange(n_ch), q_ch, idx_ch, ok_ch))
    return jnp.moveaxis(o, 0, 1).reshape(B_, L, N_KV, HPG, HEAD_DIM)


def window_attention(q, kw, vw):
    B_, L = q.shape[:2]
    nb = L // WIN_QBLOCK
    span = WIN_QBLOCK + WINDOW
    pad = ((0, 0), (WINDOW, 0), (0, 0), (0, 0))
    kp, vp = jnp.pad(kw, pad), jnp.pad(vw, pad)
    q_blk = jnp.moveaxis(q.reshape(B_, nb, WIN_QBLOCK, N_KV, HPG, HEAD_DIM), 1, 0)
    koff = np.arange(span) - WINDOW
    rel = np.arange(WIN_QBLOCK)[:, None] - koff[None, :]
    band = (rel >= 0) & (rel < WINDOW)

    def block(args):
        bi, qb = args
        start = bi * WIN_QBLOCK
        kb = lax.dynamic_slice_in_dim(kp, start, span, axis=1)
        vb = lax.dynamic_slice_in_dim(vp, start, span, axis=1)
        mask = band & ((start + koff) >= 0)[None, :]
        s = jnp.einsum('bqghd,bkgd->bghqk', qb, kb)
        p = masked_softmax(s, mask).astype(vb.dtype)
        return jnp.einsum('bghqk,bkgd->bqghd', p, vb)

    o = lax.map(block, (jnp.arange(nb), q_blk))
    return jnp.moveaxis(o, 0, 1).reshape(B_, L, N_KV, HPG, HEAD_DIM)


def nsa_mixer(h, w_qg, w_o, kc, vc, ks, vs, kw, vw):
    B_, L, _ = h.shape
    proj = h @ w_qg
    q = proj[..., :ATT_WIDTH].reshape(B_, L, N_KV, HPG, HEAD_DIM) * (HEAD_DIM ** -0.5)
    g_end = ATT_WIDTH + N_BRANCH * N_HEADS
    gates = jax.nn.sigmoid(proj[..., ATT_WIDTH:g_end].astype(jnp.float32)).astype(h.dtype)
    gates = gates.reshape(B_, L, N_BRANCH, N_KV, HPG, 1)
    z = proj[..., g_end:].reshape(B_, L, N_BRANCH, N_KV, HPG, HEAD_DIM)
    pos = jnp.arange(L)
    o_cmp, p_cmp = cmp_attention(q, kc, vc, pos)
    idx, ok = select_blocks(p_cmp, pos)
    o_sel = selected_attention(q, ks, vs, idx, ok)
    o_win = window_attention(q, kw, vw)
    o_br = jnp.stack([o_cmp, o_sel, o_win], axis=2)
    o = jnp.sum(gates * jax.nn.silu(z) * o_br, axis=2)
    return o.reshape(B_, L, ATT_WIDTH) @ w_o


def setup_inputs(seed: int = 0) -> dict:
    key = jax.random.key(seed)
    keys = list(jax.random.split(key, 40))

    def nrm(shape, s):
        return s * jax.random.normal(keys.pop(), shape, jnp.float32)

    D, E, G, N = D_MODEL, SSM_WIDTH, SSM_GROUPS, SSM_STATE
    qg_cols = ATT_WIDTH + N_BRANCH * N_HEADS + N_BRANCH * ATT_WIDTH
    lam_im0 = jnp.pi * jnp.arange(N, dtype=jnp.float32)
    return {
        "x": nrm((BATCH, SEQ, D), 1.0),
        "c": nrm((BATCH, D), 1.0),
        "norm_g": 1.0 + nrm((DEPTH, D), 0.02),
        "mod_w": nrm((DEPTH, D, 3 * D), 0.5 * D ** -0.5),
        "mod_b": nrm((DEPTH, 3 * D), 0.01),
        "ssm_w_in": nrm((N_A, D, 2 * E), D ** -0.5),
        "ssm_lam_re": -0.5 + nrm((N_A, G, N), 0.01),
        "ssm_lam_im": lam_im0 + nrm((N_A, G, N), 0.01),
        "ssm_log_step": jax.random.uniform(keys.pop(), (N_A, G), jnp.float32, math.log(1e-3), math.log(1e-1)),
        "ssm_b_re": nrm((N_A, G, N, SSM_GROUP), (2 * SSM_GROUP) ** -0.5),
        "ssm_b_im": nrm((N_A, G, N, SSM_GROUP), (2 * SSM_GROUP) ** -0.5),
        "ssm_c_re": nrm((N_A, G, SSM_GROUP, N), 0.5),
        "ssm_c_im": nrm((N_A, G, SSM_GROUP, N), 0.5),
        "ssm_d": nrm((N_A, E), 1.0),
        "ssm_w_glu": nrm((N_A, E, E), E ** -0.5),
        "ssm_b_glu": nrm((N_A, E), 0.01),
        "ssm_w_out": nrm((N_A, E, D), E ** -0.5),
        "kv_norm_g": 1.0 + nrm((D,), 0.02),
        "kv_mod_w": nrm((D, 2 * D), 0.5 * D ** -0.5),
        "kv_mod_b": nrm((2 * D,), 0.01),
        "w_kv": nrm((D, 2 * N_BRANCH * N_KV * HEAD_DIM), D ** -0.5),
        "cmp_pe": nrm((2, CMP_LEN, HEAD_DIM), 0.02),
        "cmp_w1": nrm((2, CMP_LEN * HEAD_DIM, HEAD_DIM), (CMP_LEN * HEAD_DIM) ** -0.5),
        "cmp_b1": nrm((2, HEAD_DIM), 0.01),
        "cmp_w2": nrm((2, HEAD_DIM, HEAD_DIM), HEAD_DIM ** -0.5),
        "cmp_b2": nrm((2, HEAD_DIM), 0.01),
        "nsa_w_qg": nrm((N_B, D, qg_cols), D ** -0.5),
        "nsa_w_o": nrm((N_B, ATT_WIDTH, D), ATT_WIDTH ** -0.5),
        "final_norm_g": 1.0 + nrm((D,), 0.02),
    }


def reference(x, c, norm_g, mod_w, mod_b, ssm_w_in, ssm_lam_re, ssm_lam_im, ssm_log_step,
              ssm_b_re, ssm_b_im, ssm_c_re, ssm_c_im, ssm_d, ssm_w_glu, ssm_b_glu, ssm_w_out,
              kv_norm_g, kv_mod_w, kv_mod_b, w_kv, cmp_pe, cmp_w1, cmp_b1, cmp_w2, cmp_b2,
              nsa_w_qg, nsa_w_o, final_norm_g):
    c_act = jax.nn.silu(c)
    shared = None
    for layer in range(DEPTH):
        if layer == N_A:
            kv_shift, kv_scale = jnp.split(c_act @ kv_mod_w + kv_mod_b, 2, axis=-1)
            h_kv = modulate(rmsnorm(x, kv_norm_g), kv_shift, kv_scale)
            shared = nsa_shared_kv(h_kv, w_kv, cmp_pe, cmp_w1, cmp_b1, cmp_w2, cmp_b2)
        shift, scale, gate = jnp.split(c_act @ mod_w[layer] + mod_b[layer], 3, axis=-1)
        h = modulate(rmsnorm(x, norm_g[layer]), shift, scale)
        if layer < N_A:
            out = s5_mixer(h, ssm_w_in[layer], ssm_lam_re[layer], ssm_lam_im[layer],
                           ssm_log_step[layer], ssm_b_re[layer], ssm_b_im[layer],
                           ssm_c_re[layer], ssm_c_im[layer], ssm_d[layer],
                           ssm_w_glu[layer], ssm_b_glu[layer], ssm_w_out[layer])
        else:
            j = layer - N_A
            out = nsa_mixer(h, nsa_w_qg[j], nsa_w_o[j], *shared)
        x = x + gate[:, None, :] * out
    return rmsnorm(x, final_norm_g)
```

```cpp
#include <hip/hip_runtime.h>
#include <hip/hip_bf16.h>
#include <hip/hip_cooperative_groups.h>
#include <cstdio>
namespace cg = cooperative_groups;

typedef unsigned short u16;
typedef unsigned long long u64;
using bf16x8 = __attribute__((ext_vector_type(8))) short;
using f32x4 = __attribute__((ext_vector_type(4))) float;

#ifndef ONE_LAUNCH
#define ONE_LAUNCH 1
#endif
#ifndef REPEAT_MASK
#define REPEAT_MASK 0
#endif

constexpr int T_ = 16384, L_ = 4096, D_ = 2048;
constexpr size_t MB = 1ull << 20;
constexpr size_t OFF_WT_IN = 0;
constexpr size_t OFF_WT_GLU = 32 * MB;
constexpr size_t OFF_WT_OUT = 48 * MB;
constexpr size_t OFF_WT_KV = 64 * MB;
constexpr size_t OFF_WT_QG = 76 * MB;
constexpr size_t OFF_WT_O = 142 * MB;
constexpr size_t OFF_W1T = 158 * MB;
constexpr size_t OFF_SMALL = 160 * MB;
constexpr size_t OFF_MODV = OFF_SMALL;
constexpr size_t OFF_KVMOD = OFF_SMALL + 512 * 1024;
constexpr size_t OFF_ABAR = OFF_SMALL + 1 * MB;
constexpr size_t OFF_AQ = OFF_ABAR + 256 * 1024;
constexpr size_t OFF_PEB = OFF_AQ + 256 * 1024;
constexpr size_t OFF_PEBP = OFF_SMALL + 6 * MB;
constexpr size_t OFF_BBRE = OFF_SMALL + 2 * MB;
constexpr size_t OFF_BBIM = OFF_SMALL + 3 * MB;
constexpr size_t OFF_BAR = OFF_SMALL + 5 * MB;
constexpr size_t OFF_KC = 168 * MB;
constexpr size_t OFF_VCT = 169 * MB;
constexpr size_t OFF_SELM = 170 * MB;
constexpr size_t OFF_XBUF = 172 * MB;
constexpr size_t OFF_HBUF = 300 * MB;
constexpr size_t OFF_R = 364 * MB;
constexpr size_t OFF_UZ = OFF_R;
constexpr size_t OFF_Y = OFF_R + 128 * MB;
constexpr size_t OFF_V = OFF_R + 192 * MB;
constexpr size_t OFF_ST = OFF_R + 256 * MB;
constexpr size_t OFF_SSM_KT = OFF_R + 272 * MB;
constexpr size_t OFF_SSM_W1 = OFF_R + 276 * MB;
constexpr size_t OFF_SSM_W2 = OFF_R + 308 * MB;
constexpr size_t OFF_SSM_XP = OFF_R + 340 * MB;
constexpr size_t OFF_KVB = OFF_R;
constexpr size_t OFF_VT = OFF_R + 96 * MB;
constexpr size_t OFF_Q = OFF_R + 128 * MB;
constexpr size_t OFF_SZ3 = OFF_R + 192 * MB;
constexpr size_t OFF_HKV = OFF_SZ3;
constexpr size_t OFF_GATES = OFF_R + 384 * MB;
constexpr size_t WS_NEEDED = OFF_GATES + 4 * MB;

constexpr int LDS_BYTES = 145408;

struct Params {
  const float *x, *c, *norm_g, *mod_w, *mod_b, *w_in, *lam_re, *lam_im, *log_step, *b_re, *b_im, *c_re, *c_im,
      *dskip, *w_glu, *b_glu, *w_out, *kv_norm_g, *kv_mod_w, *kv_mod_b, *w_kv, *cmp_pe, *cmp_w1, *cmp_b1, *cmp_w2,
      *cmp_b2, *w_qg, *w_o, *final_g;
  float* out;
  char* ws;
};

typedef const __attribute__((address_space(4))) Params* PP;
#define DEVFN __device__ __attribute__((always_inline)) inline

extern __shared__ __attribute__((aligned(16))) char smem[];
__device__ __forceinline__ int opaque_tid(int wid) { unsigned z = 0; asm volatile("" : "+v"(z)); return wid * 64 + (int)__builtin_amdgcn_mbcnt_hi(~0u, __builtin_amdgcn_mbcnt_lo(~0u, z)); }
__device__ __forceinline__ int opaque_bid() { int v = blockIdx.x; asm volatile("" : "+s"(v)); return v; }
__device__ __forceinline__ float shx(float v, int mask, int lane) {
  return __int_as_float(__builtin_amdgcn_ds_bpermute((lane ^ mask) << 2, __float_as_int(v)));
}
__device__ __forceinline__ PP opaque_pp(PP p) { asm volatile("" : "+s"(p)); return p; }

__device__ __forceinline__ u16 f2bf(float f) {
  unsigned u = __float_as_uint(f);
  u += 0x7fffu + ((u >> 16) & 1u);
  return (u16)(u >> 16);
}
__device__ __forceinline__ unsigned pk_bf16(float lo, float hi) {
  unsigned r; asm("v_cvt_pk_bf16_f32 %0, %1, %2" : "=v"(r) : "v"(lo), "v"(hi)); return r;
}
typedef unsigned u32x4 __attribute__((ext_vector_type(4)));
__device__ __forceinline__ bf16x8 mk8(unsigned a, unsigned b, unsigned c, unsigned d) { u32x4 t = {a, b, c, d}; return __builtin_bit_cast(bf16x8, t); }
__device__ __forceinline__ float bf2f(u16 h) { return __uint_as_float(((unsigned)h) << 16); }
__device__ __forceinline__ float sigmoidf_(float x) { return 1.f / (1.f + __expf(-x)); }
__device__ __forceinline__ float siluf_(float x) { return x / (1.f + __expf(-x)); }
__device__ __forceinline__ float gelu_tanh(float x) {
  float u2 = 1.5957691216057308f * (x + 0.044715f * x * x * x);
  return x / (1.f + __expf(-u2));
}
__device__ __forceinline__ float wave_sum(float v, int lane) {
#pragma unroll
  for (int o = 32; o > 0; o >>= 1) v += shx(v, o, lane);
  return v;
}

DEVFN void xpose(const int WID, const float* __restrict__ src, u16* __restrict__ dst, int K, int Nsrc, int Ndst, int mode) {
  const int BID = opaque_bid();
  float* tile = (float*)smem;
  const int tid = opaque_tid(WID);
  const int tilesK = K / 64, nt = (Ndst / 64) * tilesK;
  const int kr = tid >> 4, nc = (tid & 15) * 4;
  const int n = tid >> 3, kc = (tid & 7) * 8;
  int t = BID;
  if (t >= nt) return;
  float4 cur0, cur1;
  {
    int tn = t / tilesK, tk = t - tn * tilesK; int n0 = tn * 64, k0 = tk * 64;
    int sc0 = n0, nvalid = 64;
    if (mode == 1) { if (n0 < 2048) sc0 = n0; else if (n0 < 8192) sc0 = n0 + 48; else if (n0 == 8192) { sc0 = 2048; nvalid = 48; } else { sc0 = 0; nvalid = 0; } }
    cur0 = make_float4(0.f, 0.f, 0.f, 0.f); cur1 = cur0;
    if (nc < nvalid) { cur0 = *(const float4*)&src[(size_t)(k0 + kr) * Nsrc + sc0 + nc]; cur1 = *(const float4*)&src[(size_t)(k0 + kr + 32) * Nsrc + sc0 + nc]; }
  }
  int it = 0;
  for (; t < nt; t += gridDim.x, ++it) {
    const int t2 = (t + (int)gridDim.x < nt) ? t + (int)gridDim.x : t;
    float4 nx0, nx1;
    {
      int tn = t2 / tilesK, tk = t2 - tn * tilesK; int n0 = tn * 64, k0 = tk * 64;
      int sc0 = n0, nvalid = 64;
      if (mode == 1) { if (n0 < 2048) sc0 = n0; else if (n0 < 8192) sc0 = n0 + 48; else if (n0 == 8192) { sc0 = 2048; nvalid = 48; } else { sc0 = 0; nvalid = 0; } }
      nx0 = make_float4(0.f, 0.f, 0.f, 0.f); nx1 = nx0;
      if (nc < nvalid) { nx0 = *(const float4*)&src[(size_t)(k0 + kr) * Nsrc + sc0 + nc]; nx1 = *(const float4*)&src[(size_t)(k0 + kr + 32) * Nsrc + sc0 + nc]; }
    }
    float* tb = tile + (it & 1) * (64 * 65);
    tb[kr * 65 + nc + 0] = cur0.x; tb[kr * 65 + nc + 1] = cur0.y; tb[kr * 65 + nc + 2] = cur0.z; tb[kr * 65 + nc + 3] = cur0.w;
    tb[(kr + 32) * 65 + nc + 0] = cur1.x; tb[(kr + 32) * 65 + nc + 1] = cur1.y; tb[(kr + 32) * 65 + nc + 2] = cur1.z; tb[(kr + 32) * 65 + nc + 3] = cur1.w;
    __syncthreads();
    {
      int tn = t / tilesK, tk = t - tn * tilesK; int n0 = tn * 64, k0 = tk * 64;
      uint4 o;
      o.x = pk_bf16(tb[(kc + 0) * 65 + n], tb[(kc + 1) * 65 + n]);
      o.y = pk_bf16(tb[(kc + 2) * 65 + n], tb[(kc + 3) * 65 + n]);
      o.z = pk_bf16(tb[(kc + 4) * 65 + n], tb[(kc + 5) * 65 + n]);
      o.w = pk_bf16(tb[(kc + 6) * 65 + n], tb[(kc + 7) * 65 + n]);
      *(uint4*)&dst[(size_t)(n0 + n) * K + k0 + kc] = o;
    }
    cur0 = nx0; cur1 = nx1;
  }
  __syncthreads();
}

DEVFN void phase_prep(const int WID, PP p) {
  const int BID = opaque_bid();
  const int tid = opaque_tid(WID), lane = tid & 63, wave = tid >> 6;
  char* ws = p->ws;
  for (int job = 0; job < 13; job++) {
    const float* src; u16* dst; int K = 2048, Nsrc, Ndst, mode = 0;
    int l = job & 1, kind = job >> 1;
    if (kind == 0) { src = p->w_in + (size_t)l * 2048 * 4096; dst = (u16*)(ws + OFF_WT_IN) + (size_t)l * 4096 * 2048; Nsrc = 4096; Ndst = 4096; }
    else if (kind == 1) { src = p->w_glu + (size_t)l * 2048 * 2048; dst = (u16*)(ws + OFF_WT_GLU) + (size_t)l * 2048 * 2048; Nsrc = 2048; Ndst = 2048; }
    else if (kind == 2) { src = p->w_out + (size_t)l * 2048 * 2048; dst = (u16*)(ws + OFF_WT_OUT) + (size_t)l * 2048 * 2048; Nsrc = 2048; Ndst = 2048; }
    else if (kind == 3) { src = p->w_qg + (size_t)l * 2048 * 8240; dst = (u16*)(ws + OFF_WT_QG) + (size_t)l * 8448 * 2048; Nsrc = 8240; Ndst = 8448; mode = 1; }
    else if (kind == 4) { src = p->w_o + (size_t)l * 2048 * 2048; dst = (u16*)(ws + OFF_WT_O) + (size_t)l * 2048 * 2048; Nsrc = 2048; Ndst = 2048; }
    else if (kind == 5) { src = p->cmp_w1 + (size_t)l * 4096 * 128; dst = (u16*)(ws + OFF_W1T) + (size_t)l * 128 * 4096; K = 4096; Nsrc = 128; Ndst = 128; }
    else { src = p->w_kv; dst = (u16*)(ws + OFF_WT_KV); Nsrc = 3072; Ndst = 3072; }
    xpose(WID, src, dst, K, Nsrc, Ndst, mode);
  }
  {
    uint4* z = (uint4*)(ws + OFF_KC);
    unsigned zz = 0; asm volatile("" : "+v"(zz));
    for (int i = BID * 512 + tid; i < (int)(2 * MB / 16); i += gridDim.x * 512) z[i] = make_uint4(zz, zz, zz, zz);
  }
  {
    float* cact = (float*)smem;
    float* red = cact + 8192;
    float* modv = (float*)(ws + OFF_MODV);
    float* kvmod = (float*)(ws + OFF_KVMOD);
    for (int i = tid; i < 8192; i += 512) { float v = p->c[i]; cact[i] = v / (1.f + expf(-v)); }
    __syncthreads();
    for (int task = BID; task < 448; task += gridDim.x) {
      const float* W; const float* bias; float* outp; int N; int col0;
      if (task < 384) {
        int l = task / 96; col0 = (task % 96) * 64; W = p->mod_w + (size_t)l * 2048 * 6144; N = 6144;
        bias = p->mod_b + l * 6144; outp = modv + l * 4 * 6144;
      } else {
        col0 = (task - 384) * 64; W = p->kv_mod_w; N = 4096; bias = p->kv_mod_b; outp = kvmod;
      }
      float a0 = 0, a1 = 0, a2 = 0, a3 = 0;
      int kb = wave * 256;
      const float* wp = W + (size_t)kb * N + col0 + lane;
#pragma unroll 1
      for (int k0 = 0; k0 < 256; k0 += 32) {
        float wv[32];
#pragma unroll
        for (int i = 0; i < 32; i++) wv[i] = wp[(size_t)(k0 + i) * N];
#pragma unroll
        for (int i = 0; i < 32; i++) {
          int k = kb + k0 + i;
          a0 += cact[k] * wv[i]; a1 += cact[2048 + k] * wv[i]; a2 += cact[4096 + k] * wv[i]; a3 += cact[6144 + k] * wv[i];
        }
      }
      red[(wave * 4 + 0) * 64 + lane] = a0; red[(wave * 4 + 1) * 64 + lane] = a1;
      red[(wave * 4 + 2) * 64 + lane] = a2; red[(wave * 4 + 3) * 64 + lane] = a3;
      __syncthreads();
      if (tid < 256) {
        int b = tid >> 6, ln = tid & 63; float s = 0;
#pragma unroll
        for (int w = 0; w < 8; w++) s += red[(w * 4 + b) * 64 + ln];
        outp[b * N + col0 + ln] = s + bias[col0 + ln];
      }
      __syncthreads();
    }
  }
  {
    float2* abar = (float2*)(ws + OFF_ABAR); float2* aq = (float2*)(ws + OFF_AQ);
    float* bbre = (float*)(ws + OFF_BBRE); float* bbim = (float*)(ws + OFF_BBIM);
    for (int i = BID * 512 + tid; i < 2 * 128 * 64; i += gridDim.x * 512) {
      int lg = i >> 6;
      float dt = expf(p->log_step[lg]);
      float lr = p->lam_re[i], li = p->lam_im[i];
      float zr = lr * dt, zi = li * dt;
      float em1 = expm1f(zr), cz = cosf(zi), sz = sinf(zi), sh = sinf(0.5f * zi);
      float mag = em1 + 1.f;
      float arm1 = em1 * cz - 2.f * sh * sh;
      float are = 1.f + arm1, aim = mag * sz;
      float den = lr * lr + li * li;
      float cre = (arm1 * lr + aim * li) / den, cim = (aim * lr - arm1 * li) / den;
      abar[i] = make_float2(are, aim);
      float m64 = expf(zr * 64.f), a64 = zi * 64.f;
      aq[i] = make_float2(m64 * cosf(a64), m64 * sinf(a64));
#pragma unroll
      for (int c = 0; c < 16; c++) {
        float br = p->b_re[(size_t)i * 16 + c], bi = p->b_im[(size_t)i * 16 + c];
        bbre[(size_t)i * 16 + c] = cre * br - cim * bi;
        bbim[(size_t)i * 16 + c] = cre * bi + cim * br;
      }
    }
  }
  {
    float* red = (float*)smem + 16384;
    float* pebp = (float*)(ws + OFF_PEBP);
    for (int task = BID; task < 256; task += gridDim.x) {
      int kvi = task >> 7, kq = task & 127;
      int j = tid & 127, sub = tid >> 7;
      const float* pe = p->cmp_pe + kvi * 4096 + kq * 32 + sub * 8; const float* w1 = p->cmp_w1 + ((size_t)kvi * 4096 + kq * 32 + sub * 8) * 128 + j;
      float a = 0;
#pragma unroll
      for (int k = 0; k < 8; k++) a += pe[k] * w1[(size_t)k * 128];
      red[tid] = a;
      __syncthreads();
      if (tid < 128) pebp[(size_t)task * 128 + tid] = red[tid] + red[tid + 128] + red[tid + 256] + red[tid + 384];
      __syncthreads();
    }
  }
}

DEVFN void phase_peb_final(const int WID, PP p) {
  const int BID = opaque_bid();
  const int tid = opaque_tid(WID);
  if (BID != 0 || tid >= 256) return;
  char* ws = p->ws;
  const float* pebp = (const float*)(ws + OFF_PEBP);
  float* peb = (float*)(ws + OFF_PEB);
  int kvi = tid >> 7, j = tid & 127;
  float s = p->cmp_b1[kvi * 128 + j];
#pragma unroll 1
  for (int k0 = 0; k0 < 128; k0 += 32) {
    float v[32];
#pragma unroll
    for (int i = 0; i < 32; i++) v[i] = pebp[(size_t)(kvi * 128 + k0 + i) * 128 + j];
#pragma unroll
    for (int i = 0; i < 32; i++) s += v[i];
  }
  peb[kvi * 128 + j] = s;
}

DEVFN void phase_prenorm(const int WID, PP p, int layer, bool dual) {
  const int BID = opaque_bid();
  const int tid = opaque_tid(WID), lane = tid & 63, wave = tid >> 6;
  char* ws = p->ws;
  const float* xin = (layer == 0) ? p->x : (const float*)(ws + OFF_XBUF);
  const float* modv = (const float*)(ws + OFF_MODV);
  const float* kvmod = (const float*)(ws + OFF_KVMOD);
  u16* hbuf = (u16*)(ws + OFF_HBUF);
  u16* hkv = (u16*)(ws + OFF_HKV);
  for (int r0 = (BID * 8 + wave) * 2; r0 < T_; r0 += gridDim.x * 16) {
    float4 v[2][8]; float ss[2] = {0.f, 0.f};
#pragma unroll
    for (int rr = 0; rr < 2; rr++) {
      const float* xr = xin + (size_t)(r0 + rr) * 2048;
#pragma unroll
      for (int i = 0; i < 8; i++) v[rr][i] = *(const float4*)&xr[(i * 64 + lane) * 4];
    }
#pragma unroll
    for (int rr = 0; rr < 2; rr++) {
#pragma unroll
      for (int i = 0; i < 8; i++) ss[rr] += v[rr][i].x * v[rr][i].x + v[rr][i].y * v[rr][i].y + v[rr][i].z * v[rr][i].z + v[rr][i].w * v[rr][i].w;
      ss[rr] = wave_sum(ss[rr], lane);
    }
    const int b = r0 >> 12;
    const float* g = p->norm_g + layer * 2048; const float* mv = modv + (size_t)(layer * 4 + b) * 6144;
#pragma unroll
    for (int rr = 0; rr < 2; rr++) {
      const int r = r0 + rr;
      const float rstd = rsqrtf(ss[rr] * (1.f / 2048.f) + 1e-6f);
#pragma unroll
      for (int i = 0; i < 8; i++) {
        int c = (i * 64 + lane) * 4;
        float4 gg = *(const float4*)&g[c], sh = *(const float4*)&mv[c], sc = *(const float4*)&mv[2048 + c];
        uint2 o;
        o.x = pk_bf16(v[rr][i].x * rstd * gg.x * (1.f + sc.x) + sh.x, v[rr][i].y * rstd * gg.y * (1.f + sc.y) + sh.y);
        o.y = pk_bf16(v[rr][i].z * rstd * gg.z * (1.f + sc.z) + sh.z, v[rr][i].w * rstd * gg.w * (1.f + sc.w) + sh.w);
        *(uint2*)&hbuf[(size_t)r * 2048 + c] = o;
      }
      if (dual) {
        const float* g2 = p->kv_norm_g; const float* mv2 = kvmod + (size_t)b * 4096;
#pragma unroll
        for (int i = 0; i < 8; i++) {
          int c = (i * 64 + lane) * 4;
          float4 gg = *(const float4*)&g2[c], sh = *(const float4*)&mv2[c], sc = *(const float4*)&mv2[2048 + c];
          uint2 o;
          o.x = pk_bf16(v[rr][i].x * rstd * gg.x * (1.f + sc.x) + sh.x, v[rr][i].y * rstd * gg.y * (1.f + sc.y) + sh.y);
          o.y = pk_bf16(v[rr][i].z * rstd * gg.z * (1.f + sc.z) + sh.z, v[rr][i].w * rstd * gg.w * (1.f + sc.w) + sh.w);
          *(uint2*)&hkv[(size_t)r * 2048 + c] = o;
        }
      }
    }
  }
}

DEVFN void phase_final(const int WID, PP p) {
  const int BID = opaque_bid();
  const int tid = opaque_tid(WID), lane = tid & 63, wave = tid >> 6;
  const float* xin = (const float*)(p->ws + OFF_XBUF);
  for (int r0 = (BID * 8 + wave) * 2; r0 < T_; r0 += gridDim.x * 16) {
    float4 v[2][8]; float ss[2] = {0.f, 0.f};
#pragma unroll
    for (int rr = 0; rr < 2; rr++) {
      const float* xr = xin + (size_t)(r0 + rr) * 2048;
#pragma unroll
      for (int i = 0; i < 8; i++) v[rr][i] = *(const float4*)&xr[(i * 64 + lane) * 4];
    }
#pragma unroll
    for (int rr = 0; rr < 2; rr++) {
#pragma unroll
      for (int i = 0; i < 8; i++) ss[rr] += v[rr][i].x * v[rr][i].x + v[rr][i].y * v[rr][i].y + v[rr][i].z * v[rr][i].z + v[rr][i].w * v[rr][i].w;
      ss[rr] = wave_sum(ss[rr], lane);
    }
#pragma unroll
    for (int rr = 0; rr < 2; rr++) {
      const float rstd = rsqrtf(ss[rr] * (1.f / 2048.f) + 1e-6f);
#pragma unroll
      for (int i = 0; i < 8; i++) {
        int c = (i * 64 + lane) * 4;
        float4 gg = *(const float4*)&p->final_g[c];
        float4 o = make_float4(v[rr][i].x * rstd * gg.x, v[rr][i].y * rstd * gg.y, v[rr][i].z * rstd * gg.z, v[rr][i].w * rstd * gg.w);
        *(float4*)&p->out[(size_t)(r0 + rr) * 2048 + c] = o;
      }
    }
  }
}

enum { EPI_S1 = 0, EPI_S3 = 1, EPI_RES = 2, EPI_KV = 3, EPI_QG = 4 };

__device__ __forceinline__ uint2 pack4(float a, float b, float c, float d) { uint2 o; o.x = pk_bf16(a, b); o.y = pk_bf16(c, d); return o; }
__device__ __forceinline__ float bflo(unsigned u) { return __uint_as_float(u << 16); }
__device__ __forceinline__ float bfhi(unsigned u) { return __uint_as_float(u & 0xffff0000u); }

struct EpiPre { float4 x; uint2 a, b; };
template <int EPI>
__device__ __forceinline__ EpiPre epi_pre(PP p, int row, int col, int aux) {
  EpiPre r; r.x = make_float4(0.f, 0.f, 0.f, 0.f); r.a = make_uint2(0u, 0u); r.b = r.a;
  char* ws = p->ws;
  if constexpr (EPI == EPI_S3) {
    const u16* uz = (const u16*)(ws + OFF_UZ); const u16* y = (const u16*)(ws + OFF_Y);
    r.a = *(const uint2*)&y[(size_t)row * 2048 + col];
    r.b = *(const uint2*)&uz[(size_t)row * 4096 + 2048 + col];
  } else if constexpr (EPI == EPI_RES) {
    const float* xo = (aux == 0) ? p->x : (const float*)(ws + OFF_XBUF);
    r.x = *(const float4*)&xo[(size_t)row * 2048 + col];
  }
  return r;
}
template <int EPI>
__device__ __forceinline__ void epi_row(PP p, int row, int col, f32x4 v, int aux, const EpiPre& pre) {
  char* ws = p->ws;
  if constexpr (EPI == EPI_S1) {
    u16* uz = (u16*)(ws + OFF_UZ);
    if (col >= 2048) { v[0] = siluf_(v[0]); v[1] = siluf_(v[1]); v[2] = siluf_(v[2]); v[3] = siluf_(v[3]); }
    *(uint2*)&uz[(size_t)row * 4096 + col] = pack4(v[0], v[1], v[2], v[3]);
  } else if constexpr (EPI == EPI_S3) {
    const u16* uz = (const u16*)(ws + OFF_UZ); const u16* y = (const u16*)(ws + OFF_Y); u16* vo = (u16*)(ws + OFF_V);
    float4 bg = *(const float4*)&p->b_glu[aux * 2048 + col];
    uint2 yy = pre.a;
    uint2 ss = pre.b;
    *(uint2*)&vo[(size_t)row * 2048 + col] = pack4(bflo(yy.x) * sigmoidf_(v[0] + bg.x) * bflo(ss.x), bfhi(yy.x) * sigmoidf_(v[1] + bg.y) * bfhi(ss.x),
                                                   bflo(yy.y) * sigmoidf_(v[2] + bg.z) * bflo(ss.y), bfhi(yy.y) * sigmoidf_(v[3] + bg.w) * bfhi(ss.y));
  } else if constexpr (EPI == EPI_RES) {
    const float* modv = (const float*)(ws + OFF_MODV);
    float* xb = (float*)(ws + OFF_XBUF);
    const float* xo = (aux == 0) ? p->x : xb;
    int b = row >> 12;
    float4 gate = *(const float4*)&modv[(size_t)(aux * 4 + b) * 6144 + 4096 + col];
    size_t idx = (size_t)row * 2048 + col;
    float4 xv = pre.x;
    *(float4*)&xb[idx] = make_float4(xv.x + gate.x * v[0], xv.y + gate.y * v[1], xv.z + gate.z * v[2], xv.w + gate.w * v[3]);
  } else if constexpr (EPI == EPI_KV) {
    u16* kvb = (u16*)(ws + OFF_KVB);
    *(uint2*)&kvb[(size_t)row * 3072 + col] = pack4(v[0], v[1], v[2], v[3]);
  } else if constexpr (EPI == EPI_QG) {
    if (col < 2048) {
      u16* q = (u16*)(ws + OFF_Q);
      const float sc = 0.08838834764831845f * 1.4426950408889634f;
      *(uint2*)&q[(size_t)row * 2048 + col] = pack4(v[0] * sc, v[1] * sc, v[2] * sc, v[3] * sc);
    } else if (col < 8192) {
      u16* sz3 = (u16*)(ws + OFF_SZ3);
      *(uint2*)&sz3[(size_t)row * 6144 + (col - 2048)] = pack4(siluf_(v[0]), siluf_(v[1]), siluf_(v[2]), siluf_(v[3]));
    } else if (col < 8240) {
      float* gates = (float*)(ws + OFF_GATES);
      *(float4*)&gates[(size_t)row * 48 + (col - 8192)] = make_float4(sigmoidf_(v[0]), sigmoidf_(v[1]), sigmoidf_(v[2]), sigmoidf_(v[3]));
    }
  }
}
__device__ __forceinline__ void epi_vt(PP p, int row0, int col, f32x4 v) {
  int br = col >> 9;
  int which = (br == 5) ? 1 : 0;
  int gg = (col >> 7) & 3, d = col & 127;
  int b = row0 >> 12, t = row0 & 4095;
  u16* vt = (u16*)(p->ws + OFF_VT);
  *(uint2*)&vt[((size_t)((which * 4 + b) * 4 + gg) * 128 + d) * 4096 + t] = pack4(v[0], v[1], v[2], v[3]);
}

typedef const __attribute__((address_space(1))) char* gptr_t;
constexpr int G_BM = 256, G_BK = 64, G_HALF = 128, G_NXCD = 8, G_WGM = 8, G_HT = G_HALF * G_BK;

__device__ __forceinline__ int lds_byte(int r, int c) {
  int st = (r >> 4) * 2 + (c >> 5), rr = r & 15, cc = c & 31, ob = rr * 64 + cc * 2;
  return st * 1024 + (ob ^ (((ob >> 9) & 1) << 5));
}
__device__ __forceinline__ void stage_rc(int b, int& R, int& C) {
  int st = b / 1024, sb = b % 1024, swz = sb ^ (((sb >> 9) & 1) << 5);
  R = (st >> 1) * 16 + swz / 64; C = (st & 1) * 32 + (swz % 64) / 2;
}

template <int EPI>
DEVFN void gemm_phase(const int WID, PP p, const u16* __restrict__ A, const u16* __restrict__ Bt, const int N, const int aux) {
  const int BID = opaque_bid();
  constexpr int K = 2048;
  u16* shm = (u16*)smem;
#define SA(b, h) (shm + ((b) * 2 + (h)) * G_HT)
#define SB(b, h) (shm + (4 + (b) * 2 + (h)) * G_HT)
#define STAGE(P, BASE, br, kt) do { const char* _ub = (const char*)(BASE + (long)(br) * K + (long)(kt) * G_BK); \
    unsigned _l0 = lds0 + (unsigned)((char*)(P) - smem) + wbase; \
    asm volatile("s_mov_b32 m0, %2\n\ts_nop 0\n\tglobal_load_lds_dwordx4 %0, %1" :: "v"(svoff[0]), "s"(_ub), "s"(_l0) : "memory"); \
    asm volatile("s_mov_b32 m0, %2\n\ts_nop 0\n\tglobal_load_lds_dwordx4 %0, %1" :: "v"(svoff[1]), "s"(_ub), "s"(_l0 + 8192u) : "memory"); } while (0)
#define LDA(dst, b, h) for (int m = 0; m < 4; ++m) for (int k = 0; k < 2; ++k) \
    dst[m][k] = *reinterpret_cast<const bf16x8*>((char*)SA(b, h) + lds_byte(wr * 64 + m * 16 + fr, k * 32 + fq * 8))
#define LDB(dst, b, h) for (int n = 0; n < 2; ++n) for (int k = 0; k < 2; ++k) \
    dst[n][k] = *reinterpret_cast<const bf16x8*>((char*)SB(b, h) + lds_byte(wc * 32 + n * 16 + fr, k * 32 + fq * 8))
#define MMA(ai, bj, At, Bt_) do { __builtin_amdgcn_s_setprio(1); \
    for (int m = 0; m < 4; ++m) for (int n = 0; n < 2; ++n) for (int k = 0; k < 2; ++k) \
      acc[ai][bj][m][n] = __builtin_amdgcn_mfma_f32_16x16x32_bf16(At[m][k], Bt_[n][k], acc[ai][bj][m][n], 0, 0, 0); \
    __builtin_amdgcn_s_setprio(0); } while (0)
#define WAIT_V(n) asm volatile("s_waitcnt vmcnt(" #n ")" ::: "memory")
#define WAIT_L(n) asm volatile("s_waitcnt lgkmcnt(" #n ")" ::: "memory")
#define BAR __builtin_amdgcn_s_barrier()
#define SCHED __builtin_amdgcn_sched_barrier(0)

  const int nM = T_ / G_BM, nN = N / G_BM, nwg = nM * nN;
  const int gtid = opaque_tid(WID);
  const int wid = gtid >> 6, lane = gtid & 63, wr = wid >> 2, wc = wid & 3, fr = lane & 15, fq = lane >> 4;
  constexpr int nt = K / G_BK;
  const int wbase = __builtin_amdgcn_readfirstlane((gtid >> 6) << 10);
  const unsigned lds0 = (unsigned)(unsigned long)(__attribute__((address_space(3))) char*)smem;
  unsigned svoff[2];
#pragma unroll
  for (int i = 0; i < 2; ++i) { int r_, c_; stage_rc(gtid * 16 + i * 8192, r_, c_); svoff[i] = (unsigned)(r_ * K + c_) * 2u; }
  for (int vt = BID; vt < nwg; vt += gridDim.x) {
    int wgid = vt;
    { int q = nwg / G_NXCD, r = nwg % G_NXCD, xcd = wgid % G_NXCD, off = wgid / G_NXCD;
      wgid = (xcd < r ? xcd * (q + 1) : r * (q + 1) + (xcd - r) * q) + off; }
    int nig = G_WGM * nN, gid = wgid / nig, fm = gid * G_WGM, gsz = min(nM - fm, G_WGM);
    int pm = fm + ((wgid % nig) % gsz), pn = (wgid % nig) / gsz, brow = pm * G_BM, bcol = pn * G_BM;
    f32x4 acc[2][2][4][2] = {};
    bf16x8 At[4][2], B0[2][2], B1[2][2];
    asm volatile("s_waitcnt vmcnt(0)" ::: "memory");
    STAGE(SB(0, 0), Bt, bcol, 0); STAGE(SA(0, 0), A, brow, 0);
    STAGE(SB(0, 1), Bt, bcol + G_HALF, 0); STAGE(SA(0, 1), A, brow + G_HALF, 0);
    if (wr == 1) BAR;
    WAIT_V(4); BAR;
    STAGE(SB(1, 0), Bt, bcol, 1); STAGE(SA(1, 0), A, brow, 1); STAGE(SB(1, 1), Bt, bcol + G_HALF, 1);
    WAIT_V(6); BAR;
#pragma nounroll
    for (int t = 0; t < nt - 2; t += 2) {
      LDB(B0, 0, 0); SCHED; LDA(At, 0, 0); STAGE(SA(1, 1), A, brow + G_HALF, t + 1);
      WAIT_L(8); BAR; WAIT_L(0); MMA(0, 0, At, B0); BAR; SCHED;
      LDB(B1, 0, 1); STAGE(SB(0, 0), Bt, bcol, t + 2);
      BAR; WAIT_L(0); MMA(0, 1, At, B1); BAR;
      LDA(At, 0, 1); STAGE(SA(0, 0), A, brow, t + 2);
      BAR; WAIT_L(0); MMA(1, 0, At, B0); BAR; SCHED;
      STAGE(SB(0, 1), Bt, bcol + G_HALF, t + 2);
      WAIT_V(6); BAR; MMA(1, 1, At, B1); BAR;
      LDB(B0, 1, 0); SCHED; LDA(At, 1, 0); STAGE(SA(0, 1), A, brow + G_HALF, t + 2);
      WAIT_L(8); BAR; WAIT_L(0); MMA(0, 0, At, B0); BAR; SCHED;
      LDB(B1, 1, 1); STAGE(SB(1, 0), Bt, bcol, t + 3);
      BAR; WAIT_L(0); MMA(0, 1, At, B1); BAR;
      LDA(At, 1, 1); STAGE(SA(1, 0), A, brow, t + 3);
      BAR; WAIT_L(0); MMA(1, 0, At, B0); BAR; SCHED;
      STAGE(SB(1, 1), Bt, bcol + G_HALF, t + 3);
      WAIT_V(6); BAR; MMA(1, 1, At, B1); BAR;
    }
    { LDB(B0, 0, 0); LDA(At, 0, 0); STAGE(SA(1, 1), A, brow + G_HALF, nt - 1);
      BAR; WAIT_L(0); MMA(0, 0, At, B0); BAR;
      LDB(B1, 0, 1); BAR; WAIT_L(0); MMA(0, 1, At, B1); BAR;
      LDA(At, 0, 1); WAIT_V(4); BAR; WAIT_L(0); MMA(1, 0, At, B0); MMA(1, 1, At, B1); BAR; }
    { LDB(B0, 1, 0); LDA(At, 1, 0); WAIT_V(2); BAR; WAIT_L(0); MMA(0, 0, At, B0); BAR;
      LDB(B1, 1, 1); WAIT_V(0); BAR; WAIT_L(0); MMA(0, 1, At, B1); BAR;
      LDA(At, 1, 1); BAR; WAIT_L(0); MMA(1, 0, At, B0); MMA(1, 1, At, B1); BAR; }
    if (wr == 0) BAR;
    {
      float* et = (float*)(smem + wid * 16384);
      const int te = opaque_tid(WID);
      const int fr = te & 15, fq = (te >> 4) & 3, wr = te >> 8, wc = (te >> 6) & 3;
      bool vtb = false;
      if constexpr (EPI == EPI_KV) { int br = bcol >> 9; vtb = (br == 3) || (br == 5); }
#pragma unroll
      for (int ai = 0; ai < 2; ++ai) {
#pragma unroll
        for (int bj = 0; bj < 2; ++bj)
#pragma unroll
          for (int m = 0; m < 4; ++m)
#pragma unroll
            for (int n = 0; n < 2; ++n)
#pragma unroll
              for (int j = 0; j < 4; ++j)
                et[(m * 16 + fq * 4 + j) * 64 + ((bj * 32 + n * 16 + fr) ^ (fq << 4))] = acc[ai][bj][m][n][j];
        const int rbase = brow + ai * G_HALF + wr * 64;
        if (!vtb) {
#pragma unroll 1
          for (int it0 = 0; it0 < 16; it0 += 4) {
            const int c4 = fr * 4;
            const int gcol = bcol + (c4 >> 5) * G_HALF + wc * 32 + (c4 & 31);
            EpiPre pre[4];
#pragma unroll
            for (int u = 0; u < 4; ++u) pre[u] = epi_pre<EPI>(p, rbase + (it0 + u) * 4 + fq, gcol, aux);
#pragma unroll
            for (int u = 0; u < 4; ++u) {
              int row = (it0 + u) * 4 + fq;
              f32x4 v = *(const f32x4*)&et[row * 64 + (c4 ^ (((row >> 2) & 3) << 4))];
              epi_row<EPI>(p, rbase + row, gcol, v, aux, pre[u]);
            }
          }
        } else {
#pragma unroll 1
          for (int it = 0; it < 16; ++it) {
            int c = it * 4 + fq, r4 = fr * 4;
            int sw = (fr & 3) << 4;
            f32x4 v;
            v[0] = et[(r4 + 0) * 64 + (c ^ sw)]; v[1] = et[(r4 + 1) * 64 + (c ^ sw)];
            v[2] = et[(r4 + 2) * 64 + (c ^ sw)]; v[3] = et[(r4 + 3) * 64 + (c ^ sw)];
            int gcol = bcol + (c >> 5) * G_HALF + wc * 32 + (c & 31);
            epi_vt(p, rbase + r4, gcol, v);
          }
        }
      }
    }
    __syncthreads();
  }
#undef SA
#undef SB
#undef STAGE
#undef LDA
#undef LDB
#undef MMA
}

DEVFN void phase_ssm_a(const int WID, PP p, int layer) {
  const int BID = opaque_bid();
  const int tid = opaque_tid(WID), lane = tid & 63, wave = tid >> 6;
  char* ws = p->ws;
  const u16* uz = (const u16*)(ws + OFF_UZ);
  const float2* abar = (const float2*)(ws + OFF_ABAR);
  const float* bbre = (const float*)(ws + OFF_BBRE); const float* bbim = (const float*)(ws + OFF_BBIM);
  float2* st = (float2*)(ws + OFF_ST);
  float* uw = (float*)smem + wave * 1024;
  for (int task = BID; task < 4096; task += gridDim.x) {
    int bg = task >> 3, co = task & 7; int b = bg >> 7, g = bg & 127;
    int c = co * 8 + wave;
    {
      int t = c * 64 + lane;
      const u16* up = uz + (size_t)(b * 4096 + t) * 4096 + g * 16;
      bf16x8 u0 = *(const bf16x8*)up, u1 = *(const bf16x8*)(up + 8);
#pragma unroll
      for (int j = 0; j < 8; j++) { uw[lane * 16 + j] = bf2f((u16)u0[j]); uw[lane * 16 + 8 + j] = bf2f((u16)u1[j]); }
    }
    int gi = (layer * 128 + g) * 64 + lane;
    float br[16], bi[16];
#pragma unroll
    for (int k = 0; k < 16; k++) { br[k] = bbre[(size_t)gi * 16 + k]; bi[k] = bbim[(size_t)gi * 16 + k]; }
    float2 a = abar[gi];
    __syncthreads();
    float xr = 0, xi = 0;
    for (int s = 0; s < 64; s++) {
      float bur = 0, bui = 0;
#pragma unroll
      for (int k4 = 0; k4 < 4; k4++) {
        float4 u = *(const float4*)&uw[s * 16 + k4 * 4];
        bur += br[k4 * 4 + 0] * u.x + br[k4 * 4 + 1] * u.y + br[k4 * 4 + 2] * u.z + br[k4 * 4 + 3] * u.w;
        bui += bi[k4 * 4 + 0] * u.x + bi[k4 * 4 + 1] * u.y + bi[k4 * 4 + 2] * u.z + bi[k4 * 4 + 3] * u.w;
      }
      float nr = a.x * xr - a.y * xi + bur;
      float ni = a.x * xi + a.y * xr + bui;
      xr = nr; xi = ni;
    }
    st[((size_t)bg * 64 + c) * 64 + lane] = make_float2(xr, xi);
    __syncthreads();
  }
}


DEVFN void phase_ssm_gen(const int WID, PP p, int layer) {
  const int BID = opaque_bid();
  const int tid = opaque_tid(WID);
  char* ws = p->ws;
  float2* pwr = (float2*)smem;
  float2* Cc = (float2*)(smem + 33280);
  float2* Bb = (float2*)(smem + 41472);
  const float* bbre = (const float*)(ws + OFF_BBRE); const float* bbim = (const float*)(ws + OFF_BBIM);
  for (int task = BID; task < 256; task += gridDim.x) {
    const int g = task >> 1, hf = task & 1;
    const int lg = layer * 128 + g;
    for (int i = tid; i < 1024; i += 512) {
      Cc[i] = make_float2(p->c_re[(size_t)lg * 1024 + i], p->c_im[(size_t)lg * 1024 + i]);
      Bb[i] = make_float2(bbre[(size_t)lg * 1024 + i], bbim[(size_t)lg * 1024 + i]);
    }
    {
      float dt = expf(p->log_step[lg]);
      for (int i = tid; i < 65 * 64; i += 512) {
        int d = i >> 6, n = i & 63;
        float lr = p->lam_re[lg * 64 + n], li = p->lam_im[lg * 64 + n];
        float mag = expf(lr * dt * (float)d);
        float sn, cs; sincosf(li * dt * (float)d, &sn, &cs);
        pwr[i] = make_float2(mag * cs, mag * sn);
      }
    }
    __syncthreads();
    {
      u16* kt = (u16*)(ws + OFF_SSM_KT) + (size_t)g * 16384;
      int d = hf * 32 + (tid >> 4), cp = tid & 15;
      float acc[16];
#pragma unroll
      for (int c = 0; c < 16; c++) acc[c] = 0.f;
      for (int n = 0; n < 64; n++) {
        float2 C = Cc[cp * 64 + n], P = pwr[d * 64 + n];
        float tr = C.x * P.x - C.y * P.y, ti = C.x * P.y + C.y * P.x;
#pragma unroll
        for (int c = 0; c < 16; c++) { float2 B = Bb[n * 16 + c]; acc[c] += tr * B.x - ti * B.y; }
      }
      uint4 o0, o1;
      o0.x = pk_bf16(acc[0], acc[1]); o0.y = pk_bf16(acc[2], acc[3]); o0.z = pk_bf16(acc[4], acc[5]); o0.w = pk_bf16(acc[6], acc[7]);
      o1.x = pk_bf16(acc[8], acc[9]); o1.y = pk_bf16(acc[10], acc[11]); o1.z = pk_bf16(acc[12], acc[13]); o1.w = pk_bf16(acc[14], acc[15]);
      *(uint4*)&kt[(d * 16 + cp) * 16] = o0;
      *(uint4*)&kt[(d * 16 + cp) * 16 + 8] = o1;
    }
    unsigned* w1 = (unsigned*)((u16*)(ws + OFF_SSM_W1) + (size_t)g * 131072);
    for (int e2 = hf * 32768 + tid; e2 < hf * 32768 + 32768; e2 += 512) {
      int e = e2 * 2; int row = e >> 10, k = e & 1023; int sidx = k >> 4, c = k & 15, n = row & 63;
      float2 P = pwr[(63 - sidx) * 64 + n];
      float2 B0 = Bb[n * 16 + c], B1 = Bb[n * 16 + c + 1];
      float v0, v1;
      if (row < 64) { v0 = P.x * B0.x - P.y * B0.y; v1 = P.x * B1.x - P.y * B1.y; }
      else { v0 = P.x * B0.y + P.y * B0.x; v1 = P.x * B1.y + P.y * B1.x; }
      w1[e2] = pk_bf16(v0, v1);
    }
    unsigned* w2 = (unsigned*)((u16*)(ws + OFF_SSM_W2) + (size_t)g * 131072);
    for (int e2 = hf * 32768 + tid; e2 < hf * 32768 + 32768; e2 += 512) {
      int e = e2 * 2; int row = e >> 7, k2 = e & 127; int sidx = row >> 4, cp = row & 15, n = k2 & 63;
      float2 C0 = Cc[cp * 64 + n], C1 = Cc[cp * 64 + n + 1];
      float2 P0 = pwr[(sidx + 1) * 64 + n], P1 = pwr[(sidx + 1) * 64 + n + 1];
      float v0, v1;
      if (k2 < 64) { v0 = C0.x * P0.x - C0.y * P0.y; v1 = C1.x * P1.x - C1.y * P1.y; }
      else { v0 = -(C0.x * P0.y + C0.y * P0.x); v1 = -(C1.x * P1.y + C1.y * P1.x); }
      w2[e2] = pk_bf16(v0, v1);
    }
    __syncthreads();
  }
}

DEVFN void phase_ssm_x1(const int WID, PP p, int layer) {
  const int BID = opaque_bid();
  const int tid = opaque_tid(WID), lane = tid & 63, wave = tid >> 6;
  char* ws = p->ws;
  const u16* uz = (const u16*)(ws + OFF_UZ);
  float* st = (float*)(ws + OFF_ST);
  const int l15 = lane & 15, l4 = lane >> 4;
  for (int bt = BID; bt < 256; bt += gridDim.x) {
    int wt = bt * 8 + wave; int g = wt >> 4, ct = wt & 15;
    int col = ct * 16 + l15; int b = col >> 6, chunk = col & 63;
    const u16* ub = uz + (size_t)(b * 4096 + chunk * 64) * 4096 + g * 16;
    const u16* w1 = (const u16*)(ws + OFF_SSM_W1) + (size_t)g * 131072;
    f32x4 acc[8];
#pragma unroll
    for (int mt = 0; mt < 8; mt++) acc[mt] = f32x4{0.f, 0.f, 0.f, 0.f};
#pragma unroll 4
    for (int ks = 0; ks < 32; ks++) {
      int sidx = ks * 2 + (l4 >> 1), c0 = (l4 & 1) * 8;
      bf16x8 bfr = *(const bf16x8*)&ub[(size_t)sidx * 4096 + c0];
#pragma unroll
      for (int mt = 0; mt < 8; mt++) {
        bf16x8 afr = *(const bf16x8*)&w1[(size_t)(mt * 16 + l15) * 1024 + ks * 32 + l4 * 8];
        acc[mt] = __builtin_amdgcn_mfma_f32_16x16x32_bf16(afr, bfr, acc[mt], 0, 0, 0);
      }
    }
    float* sb = st + (((size_t)(b * 128 + g) * 64 + chunk) * 64) * 2;
#pragma unroll
    for (int mt = 0; mt < 8; mt++)
#pragma unroll
      for (int j = 0; j < 4; j++) {
        int n2 = mt * 16 + l4 * 4 + j;
        sb[(n2 & 63) * 2 + (n2 >> 6)] = acc[mt][j];
      }
  }
}


DEVFN void phase_ssm_x3(const int WID, PP p, int layer) {
  const int BID = opaque_bid();
  const int tid = opaque_tid(WID), lane = tid & 63, wave = tid >> 6;
  char* ws = p->ws;
  const u16* uz = (const u16*)(ws + OFF_UZ);
  u16* yb = (u16*)(ws + OFF_Y);
  char* Kl = smem + 512;
  char* Wl = smem + 33280;
  const int l15 = lane & 15, l4 = lane >> 4;
  for (int bt = BID; bt < 256; bt += gridDim.x) {
    int wt = bt * 8 + wave; int g = wt >> 4, ct = wt & 15;
    int col = ct * 16 + l15; int b = col >> 6, chunk = col & 63;
    const u16* ub = uz + (size_t)(b * 4096 + chunk * 64) * 4096 + g * 16;
    const u16* kt = (const u16*)(ws + OFF_SSM_KT) + (size_t)g * 16384;
    const u16* w2 = (const u16*)(ws + OFF_SSM_W2) + (size_t)g * 131072;
    const u16* xpb = (const u16*)(ws + OFF_SSM_XP) + ((size_t)(b * 128 + g) * 64 + chunk) * 128;
    const int c0 = (l4 & 1) * 8;
    const char* kbase_l = Kl + (l15 - (l4 >> 1) * 16) * 32 + c0 * 2;
    float4 dsk = *(const float4*)&p->dskip[layer * 2048 + g * 16 + l4 * 4];
    __syncthreads();
#pragma unroll
    for (int i = 0; i < 4; i++) {
      int ci = tid + 512 * i;
      *(uint4*)(Kl + ci * 16) = *(const uint4*)&kt[ci * 8];
    }
    if (tid < 32) { unsigned zz = 0; asm volatile("" : "+v"(zz)); *(uint4*)(smem + tid * 16) = make_uint4(zz, zz, zz, zz); }
#pragma unroll 1
    for (int qd = 0; qd < 4; qd++) {
      if (qd) __syncthreads();
#pragma unroll
      for (int i = 0; i < 8; i++) {
        int ci = tid + 512 * i; int row = ci >> 4, c16 = ci & 15;
        *(uint4*)(Wl + row * 272 + c16 * 16) = *(const uint4*)&w2[(size_t)(qd * 256 + row) * 128 + c16 * 8];
      }
      __syncthreads();
      f32x4 acc[16];
#pragma unroll
      for (int sl = 0; sl < 16; sl++) acc[sl] = f32x4{0.f, 0.f, 0.f, 0.f};
      const int nks = 8 * qd + 8;
      bf16x8 ucur[4], unxt[4];
#pragma unroll
      for (int i = 0; i < 4; i++) ucur[i] = *(const bf16x8*)&ub[(size_t)(2 * i + (l4 >> 1)) * 4096 + c0];
#pragma unroll 1
      for (int ks0 = 0; ks0 < nks; ks0 += 4) {
#pragma unroll
        for (int i = 0; i < 4; i++) {
          int ksn = min(ks0 + 4 + i, nks - 1);
          unxt[i] = *(const bf16x8*)&ub[(size_t)(2 * ksn + (l4 >> 1)) * 4096 + c0];
        }
#pragma unroll
        for (int i = 0; i < 4; i++) {
          const int ks = ks0 + i;
#pragma unroll
          for (int sl = 0; sl < 16; sl++) {
            int sidx = qd * 16 + sl;
            if (sidx >= 2 * ks) {
              bf16x8 afr = *(const bf16x8*)(kbase_l + (sidx - 2 * ks) * 512);
              acc[sl] = __builtin_amdgcn_mfma_f32_16x16x32_bf16(afr, ucur[i], acc[sl], 0, 0, 0);
            }
          }
        }
#pragma unroll
        for (int i = 0; i < 4; i++) ucur[i] = unxt[i];
      }
#pragma unroll
      for (int kk = 0; kk < 4; kk++) {
        bf16x8 bfr = *(const bf16x8*)&xpb[kk * 32 + l4 * 8];
#pragma unroll
        for (int sl = 0; sl < 16; sl++) {
          bf16x8 afr = *(const bf16x8*)(Wl + (sl * 16 + l15) * 272 + (kk * 32 + l4 * 8) * 2);
          acc[sl] = __builtin_amdgcn_mfma_f32_16x16x32_bf16(afr, bfr, acc[sl], 0, 0, 0);
        }
      }
      {
        uint2 uuv[16];
#pragma unroll
        for (int sl = 0; sl < 16; sl++) {
          int t = chunk * 64 + qd * 16 + sl;
          uuv[sl] = *(const uint2*)&uz[(size_t)(b * 4096 + t) * 4096 + g * 16 + l4 * 4];
        }
#pragma unroll
        for (int sl = 0; sl < 16; sl++) {
          int t = chunk * 64 + qd * 16 + sl;
          uint2 uu = uuv[sl];
          float y0 = gelu_tanh(acc[sl][0] + dsk.x * __uint_as_float(uu.x << 16));
          float y1 = gelu_tanh(acc[sl][1] + dsk.y * __uint_as_float(uu.x & 0xffff0000u));
          float y2 = gelu_tanh(acc[sl][2] + dsk.z * __uint_as_float(uu.y << 16));
          float y3 = gelu_tanh(acc[sl][3] + dsk.w * __uint_as_float(uu.y & 0xffff0000u));
          uint2 o;
          o.x = pk_bf16(y0, y1);
          o.y = pk_bf16(y2, y3);
          *(uint2*)&yb[(size_t)(b * 4096 + t) * 2048 + g * 16 + l4 * 4] = o;
        }
      }
    }
  }
}

DEVFN void phase_ssm_b(const int WID, PP p, int layer) {
  const int BID = opaque_bid();
  const int tid = opaque_tid(WID);
  char* ws = p->ws;
  const float2* aq = (const float2*)(ws + OFF_AQ);
  float2* st = (float2*)(ws + OFF_ST);
  u16* xp = (u16*)(ws + OFF_SSM_XP);
  for (int i = BID * 512 + tid; i < 4 * 128 * 64; i += gridDim.x * 512) {
    int n = i & 63, bg = i >> 6, g = bg & 127;
    float2 a = aq[(layer * 128 + g) * 64 + n];
    float xr = 0, xi = 0;
#pragma unroll 1
    for (int c0 = 0; c0 < 64; c0 += 32) {
      float2 sv[32];
#pragma unroll
      for (int k = 0; k < 32; k++) sv[k] = st[((size_t)bg * 64 + c0 + k) * 64 + n];
#pragma unroll
      for (int k = 0; k < 32; k++) {
        size_t idx = ((size_t)bg * 64 + c0 + k) * 64 + n;
        st[idx] = make_float2(xr, xi);
        xp[((size_t)bg * 64 + c0 + k) * 128 + n] = f2bf(xr);
        xp[((size_t)bg * 64 + c0 + k) * 128 + 64 + n] = f2bf(xi);
        float nr = a.x * xr - a.y * xi + sv[k].x;
        float ni = a.x * xi + a.y * xr + sv[k].y;
        xr = nr; xi = ni;
      }
    }
  }
}

DEVFN void phase_ssm_c(const int WID, PP p, int layer) {
  const int BID = opaque_bid();
  const int tid = opaque_tid(WID), lane = tid & 63, wave = tid >> 6;
  char* ws = p->ws;
  const u16* uz = (const u16*)(ws + OFF_UZ);
  u16* yb = (u16*)(ws + OFF_Y);
  const float2* abar = (const float2*)(ws + OFF_ABAR);
  const float* bbre = (const float*)(ws + OFF_BBRE); const float* bbim = (const float*)(ws + OFF_BBIM);
  const float2* st = (const float2*)(ws + OFF_ST);
  float* Cs = (float*)smem;
  float* uw = (float*)(smem + 8192 + wave * 12416);
  float* xs = uw + 1024;
  for (int task = BID; task < 4096; task += gridDim.x) {
    int bg = task >> 3, co = task & 7; int b = bg >> 7, g = bg & 127;
    int c = co * 8 + wave;
    for (int i = tid; i < 2048; i += 512) {
      int im = i >> 10, cp = (i >> 6) & 15, n = i & 63;
      const float* src = im ? p->c_im : p->c_re;
      Cs[n * 32 + im * 16 + cp] = src[((size_t)(layer * 128 + g) * 16 + cp) * 64 + n];
    }
    {
      int t = c * 64 + lane;
      const u16* up = uz + (size_t)(b * 4096 + t) * 4096 + g * 16;
      bf16x8 u0 = *(const bf16x8*)up, u1 = *(const bf16x8*)(up + 8);
#pragma unroll
      for (int j = 0; j < 8; j++) { uw[lane * 16 + j] = bf2f((u16)u0[j]); uw[lane * 16 + 8 + j] = bf2f((u16)u1[j]); }
    }
    int gi = (layer * 128 + g) * 64 + lane;
    float br[16], bi[16];
#pragma unroll
    for (int k = 0; k < 16; k++) { br[k] = bbre[(size_t)gi * 16 + k]; bi[k] = bbim[(size_t)gi * 16 + k]; }
    float2 a = abar[gi];
    float2 x0 = st[((size_t)bg * 64 + c) * 64 + lane];
    float xr = x0.x, xi = x0.y;
    const int s16 = lane >> 2, cq = lane & 3;
    float4 dsk = *(const float4*)&p->dskip[layer * 2048 + g * 16 + cq * 4];
    __syncthreads();
    for (int sub = 0; sub < 4; sub++) {
      for (int s = 0; s < 16; s++) {
        int sg = sub * 16 + s;
        float bur = 0, bui = 0;
#pragma unroll
        for (int k4 = 0; k4 < 4; k4++) {
          float4 u = *(const float4*)&uw[sg * 16 + k4 * 4];
          bur += br[k4 * 4 + 0] * u.x + br[k4 * 4 + 1] * u.y + br[k4 * 4 + 2] * u.z + br[k4 * 4 + 3] * u.w;
          bui += bi[k4 * 4 + 0] * u.x + bi[k4 * 4 + 1] * u.y + bi[k4 * 4 + 2] * u.z + bi[k4 * 4 + 3] * u.w;
        }
        float nr = a.x * xr - a.y * xi + bur;
        float ni = a.x * xi + a.y * xr + bui;
        xr = nr; xi = ni;
        *(float2*)&xs[s * 130 + 2 * lane] = make_float2(xr, xi);
      }
      __syncthreads();
      float y0 = 0, y1 = 0, y2 = 0, y3 = 0;
#pragma unroll 8
      for (int n = 0; n < 64; n++) {
        float2 xv = *(const float2*)&xs[s16 * 130 + 2 * n];
        float4 cr = *(const float4*)&Cs[n * 32 + cq * 4];
        float4 ci = *(const float4*)&Cs[n * 32 + 16 + cq * 4];
        y0 += cr.x * xv.x - ci.x * xv.y; y1 += cr.y * xv.x - ci.y * xv.y;
        y2 += cr.z * xv.x - ci.z * xv.y; y3 += cr.w * xv.x - ci.w * xv.y;
      }
      int sg = sub * 16 + s16;
      float4 u = *(const float4*)&uw[sg * 16 + cq * 4];
      y0 = gelu_tanh(y0 + dsk.x * u.x); y1 = gelu_tanh(y1 + dsk.y * u.y);
      y2 = gelu_tanh(y2 + dsk.z * u.z); y3 = gelu_tanh(y3 + dsk.w * u.w);
      int t = c * 64 + sg;
      uint2 o;
      o.x = (unsigned)f2bf(y0) | ((unsigned)f2bf(y1) << 16);
      o.y = (unsigned)f2bf(y2) | ((unsigned)f2bf(y3) << 16);
      *(uint2*)&yb[(size_t)(b * 4096 + t) * 2048 + g * 16 + cq * 4] = o;
      __syncthreads();
    }
  }
}

DEVFN void phase_compress(const int WID, PP p) {
  const int BID = opaque_bid();
  const int tid = opaque_tid(WID), lane = tid & 63, wave = tid >> 6;
  char* ws = p->ws;
  const u16* kvb = (const u16*)(ws + OFF_KVB);
  const float* peb = (const float*)(ws + OFF_PEB);
  u16* kc = (u16*)(ws + OFF_KC); u16* vct = (u16*)(ws + OFF_VCT);
  float* red = (float*)smem;
  float* hm = red + 8 * 2048;
  for (int task = BID; task < 510; task += gridDim.x) {
    int kvi = task / 255, tile = task % 255;
    const u16* w1t = (const u16*)(ws + OFF_W1T) + (size_t)kvi * 128 * 4096;
    int R = tile * 16 + (lane & 15);
    int b = R / 1020, rem = R % 1020, n = rem >> 2, g = rem & 3;
    const u16* arow = kvb + (size_t)(b * 4096 + 16 * n) * 3072 + kvi * 512 + g * 128;
    f32x4 acc[8] = {};
#pragma unroll 4
    for (int ks = 0; ks < 16; ks++) {
      int s = wave * 4 + (ks >> 2), d = (ks & 3) * 32 + (lane >> 4) * 8;
      bf16x8 af = *(const bf16x8*)&arow[(size_t)s * 3072 + d];
      int k = wave * 512 + ks * 32 + (lane >> 4) * 8;
#pragma unroll
      for (int nt = 0; nt < 8; nt++) {
        bf16x8 bfr = *(const bf16x8*)&w1t[(size_t)(nt * 16 + (lane & 15)) * 4096 + k];
        acc[nt] = __builtin_amdgcn_mfma_f32_16x16x32_bf16(af, bfr, acc[nt], 0, 0, 0);
      }
    }
#pragma unroll
    for (int nt = 0; nt < 8; nt++)
#pragma unroll
      for (int j = 0; j < 4; j++) red[wave * 2048 + ((lane >> 4) * 4 + j) * 128 + nt * 16 + (lane & 15)] = acc[nt][j];
    __syncthreads();
    for (int i = tid; i < 2048; i += 512) {
      float s = 0;
#pragma unroll
      for (int w = 0; w < 8; w++) s += red[w * 2048 + i];
      hm[i] = gelu_tanh(s + peb[kvi * 128 + (i & 127)]);
    }
    __syncthreads();
    {
      int r = tid >> 5, c0 = (tid & 31) * 4;
      const float* w2 = p->cmp_w2 + (size_t)kvi * 128 * 128;
      float4 o = *(const float4*)&p->cmp_b2[kvi * 128 + c0];
#pragma unroll 16
      for (int k = 0; k < 128; k++) {
        float hv = hm[r * 128 + k];
        float4 w = *(const float4*)&w2[k * 128 + c0];
        o.x += hv * w.x; o.y += hv * w.y; o.z += hv * w.z; o.w += hv * w.w;
      }
      int R2 = tile * 16 + r;
      int b2 = R2 / 1020, rem2 = R2 % 1020, n2 = rem2 >> 2, g2 = rem2 & 3;
      if (kvi == 0) {
        u16* dst = kc + ((size_t)((b2 * 4 + g2) * 256 + n2)) * 128 + c0;
        uint2 pk;
        pk.x = (unsigned)f2bf(o.x) | ((unsigned)f2bf(o.y) << 16);
        pk.y = (unsigned)f2bf(o.z) | ((unsigned)f2bf(o.w) << 16);
        *(uint2*)dst = pk;
      } else {
        u16* dst = vct + ((size_t)((b2 * 4 + g2) * 128 + c0)) * 256 + n2;
        dst[0] = f2bf(o.x); dst[256] = f2bf(o.y); dst[512] = f2bf(o.z); dst[768] = f2bf(o.w);
      }
    }
    __syncthreads();
  }
}

__device__ __forceinline__ float quad_sum(float v) {
  float a = v + __int_as_float(__builtin_amdgcn_update_dpp(0, __float_as_int(v), 0xB1, 0xF, 0xF, false));
  return a + __int_as_float(__builtin_amdgcn_update_dpp(0, __float_as_int(a), 0x4E, 0xF, 0xF, false));
}

DEVFN void phase_n2(const int WID, PP p) {
  const int BID = opaque_bid();
  const int tid = opaque_tid(WID), lane = tid & 63, wave = tid >> 6;
  char* ws = p->ws;
  const u16* q = (const u16*)(ws + OFF_Q);
  const u16* kc = (const u16*)(ws + OFF_KC); const u16* vct = (const u16*)(ws + OFF_VCT);
  u16* sz3 = (u16*)(ws + OFF_SZ3);
  const float* gates = (const float*)(ws + OFF_GATES);
  u64* selm = (u64*)(ws + OFF_SELM);
  char* Kl = smem;
  char* Vl = smem + 69632;
  float* psl = (float*)(smem + 137216) + wave * 256;
  const int l15 = lane & 15, l4 = lane >> 4;
  for (int task = BID; task < 256; task += gridDim.x) {
    const int bg = task >> 4, rr = task & 15;
    const int b = bg >> 2, g = bg & 3;
    const int thi = (31 - rr) * 128;
    const int NTb = min(16, (((thi + 127 - 31) >> 4) + 1 + 15) >> 4);
    __syncthreads();
#pragma unroll 4
    for (int ci = tid; ci < ((NTb + 1) & ~1) * 256; ci += 512) {
      int row = ci >> 4, c16 = ci & 15;
      *(uint4*)(Kl + row * 272 + c16 * 16) = *(const uint4*)&kc[((size_t)bg * 256 + row) * 128 + c16 * 8];
    }
    {
      const int cpr = ((NTb + 1) >> 1) * 4;
#pragma unroll 4
      for (int ci = tid; ci < 128 * cpr; ci += 512) {
        int row = ci / cpr, ch = ci - row * cpr;
        *(uint4*)(Vl + row * 528 + ch * 16) = *(const uint4*)&vct[((size_t)bg * 128 + row) * 256 + ch * 8];
      }
    }
    __syncthreads();
    const int head = g * 4 + (l15 & 3);
    bf16x8 Qf[4];
    {
      const int tl0 = thi + wave * 16 + (l15 >> 2);
#pragma unroll
      for (int kk = 0; kk < 4; kk++)
        Qf[kk] = *(const bf16x8*)&q[(size_t)(b * 4096 + tl0) * 2048 + head * 128 + kk * 32 + l4 * 8];
    }
#pragma unroll 1
    for (int it = 0; it < 8; it++) {
      const int t0 = ((it < 4) ? thi : rr * 128) + wave * 16 + (it & 3) * 4;
      const int tl = t0 + (l15 >> 2);
      const int tmax = t0 + 3;
      const int nvmax = (tmax >= 31) ? ((tmax - 31) >> 4) + 1 : 0;
      const int NT = (nvmax + 15) >> 4;
      const int nvalid = (tl >= 31) ? ((tl - 31) >> 4) + 1 : 0;
      f32x4 S[16];
#pragma unroll
      for (int kt = 0; kt < 16; kt++) S[kt] = f32x4{0.f, 0.f, 0.f, 0.f};
#pragma unroll
      for (int kp = 0; kp < 8; kp++) {
        if (2 * kp < NT) {
          bf16x8 kf[2][4];
#pragma unroll
          for (int h = 0; h < 2; h++)
#pragma unroll
            for (int kk = 0; kk < 4; kk++)
              kf[h][kk] = *(const bf16x8*)(Kl + ((2 * kp + h) * 16 + l15) * 272 + (kk * 32 + l4 * 8) * 2);
          asm volatile("" ::: "memory");
#pragma unroll
          for (int kk = 0; kk < 4; kk++)
#pragma unroll
            for (int h = 0; h < 2; h++)
              S[2 * kp + h] = __builtin_amdgcn_mfma_f32_16x16x32_bf16(kf[h][kk], Qf[kk], S[2 * kp + h], 0, 0, 0);
        }
      }
      {
        const int itn = (it < 7) ? it + 1 : 7;
        const int tln = ((itn < 4) ? thi : rr * 128) + wave * 16 + (itn & 3) * 4 + (l15 >> 2);
#pragma unroll
        for (int kk = 0; kk < 4; kk++)
          Qf[kk] = *(const bf16x8*)&q[(size_t)(b * 4096 + tln) * 2048 + head * 128 + kk * 32 + l4 * 8];
      }
      float mx = -1e30f;
#pragma unroll
      for (int kt = 0; kt < 16; kt++)
#pragma unroll
        for (int j = 0; j < 4; j++) { bool ok = (kt * 16 + l4 * 4 + j) < nvalid; mx = fmaxf(mx, ok ? S[kt][j] : -1e30f); }
      mx = fmaxf(mx, shx(mx, 16, lane));
      mx = fmaxf(mx, shx(mx, 32, lane));
      float sm = 0.f;
#pragma unroll
      for (int kt = 0; kt < 16; kt++)
#pragma unroll
        for (int j = 0; j < 4; j++) {
          bool ok = (kt * 16 + l4 * 4 + j) < nvalid;
          float e = ok ? __builtin_amdgcn_exp2f(S[kt][j] - mx) : 0.f; S[kt][j] = e; sm += e;
        }
      sm += shx(sm, 16, lane);
      sm += shx(sm, 32, lane);
      const float inv = (sm > 0.f) ? 1.f / sm : 0.f;
#pragma unroll
      for (int kt = 0; kt < 16; kt++)
#pragma unroll
        for (int j = 0; j < 4; j++) S[kt][j] *= inv;
      {
        float v3q[16], wq[16];
#pragma unroll
        for (int kt = 0; kt < 16; kt++) {
          wq[kt] = quad_sum(2.f * (S[kt][0] + S[kt][1] + S[kt][2]) + S[kt][3]);
          v3q[kt] = quad_sum(S[kt][3]);
        }
        const int srcl = (l4 > 0) ? lane - 16 : lane + 48;
#pragma unroll
        for (int kt = 0; kt < 16; kt++) {
          float pub = (l4 == 3) ? ((kt > 0) ? v3q[kt > 0 ? kt - 1 : 0] : 0.f) : v3q[kt];
          float prev = __int_as_float(__builtin_amdgcn_ds_bpermute(srcl << 2, __float_as_int(pub)));
          if ((l15 & 3) == 0) psl[(l15 >> 2) * 64 + kt * 4 + l4] = wq[kt] + prev;
        }
      }
      f32x4 O[8];
#pragma unroll
      for (int dt = 0; dt < 8; dt++) O[dt] = f32x4{0.f, 0.f, 0.f, 0.f};
      const int nks = (NT + 1) >> 1;
      const size_t tok = (size_t)(b * 4096 + tl);
      const float gate = gates[tok * 48 + head];
      uint2 zz[8];
#pragma unroll
      for (int dt = 0; dt < 8; dt++) zz[dt] = *(const uint2*)&sz3[tok * 6144 + head * 128 + dt * 16 + l4 * 4];
#pragma unroll
      for (int ks = 0; ks < 8; ks++) {
        if (ks < nks) {
          bf16x8 pf = mk8(pk_bf16(S[2 * ks][0], S[2 * ks][1]), pk_bf16(S[2 * ks][2], S[2 * ks][3]),
                          pk_bf16(S[2 * ks + 1][0], S[2 * ks + 1][1]), pk_bf16(S[2 * ks + 1][2], S[2 * ks + 1][3]));
          bf16x8 vf[8];
#pragma unroll
          for (int dt = 0; dt < 8; dt++) {
            const char* vrow = Vl + (dt * 16 + l15) * 528 + (ks * 32 + l4 * 4) * 2;
            uint2 h0 = *(const uint2*)(vrow);
            uint2 h1 = *(const uint2*)(vrow + 32);
            vf[dt] = mk8(h0.x, h0.y, h1.x, h1.y);
          }
          asm volatile("" ::: "memory");
#pragma unroll
          for (int dt = 0; dt < 8; dt++) O[dt] = __builtin_amdgcn_mfma_f32_16x16x32_bf16(vf[dt], pf, O[dt], 0, 0, 0);
        }
      }
      {
#pragma unroll
        for (int dt = 0; dt < 8; dt++) {
          size_t zi = tok * 6144 + head * 128 + dt * 16 + l4 * 4;
          uint2 o;
          o.x = pk_bf16(O[dt][0] * gate * __uint_as_float(zz[dt].x << 16), O[dt][1] * gate * __uint_as_float(zz[dt].x & 0xffff0000u));
          o.y = pk_bf16(O[dt][2] * gate * __uint_as_float(zz[dt].y << 16), O[dt][3] * gate * __uint_as_float(zz[dt].y & 0xffff0000u));
          *(uint2*)&sz3[zi] = o;
        }
      }
      __builtin_amdgcn_fence(__ATOMIC_SEQ_CST, "wavefront");
      __builtin_amdgcn_wave_barrier();
#pragma unroll 1
      for (int tk = 0; tk < 4; tk++) {
        int t = t0 + tk, cur = t >> 6;
        float pslv = psl[tk * 64 + lane];
        bool valid = lane <= cur;
        bool forced = (lane == 0) || (lane == cur) || (lane == cur - 1);
        float key = valid ? (forced ? 3e38f : pslv) : -1.f;
        int cnt = 0;
#pragma unroll 4
        for (int jp = 0; jp < 64; jp++) {
          float kp = __int_as_float(__builtin_amdgcn_readlane(__float_as_int(key), jp));
          cnt += ((kp > key) || (kp == key && jp < lane)) ? 1 : 0;
        }
        bool sel = valid && (cnt < 16);
        u64 m = __ballot(sel);
        if (lane == 0) selm[(size_t)bg * 4096 + t] = m;
      }
      __builtin_amdgcn_fence(__ATOMIC_SEQ_CST, "wavefront");
      __builtin_amdgcn_wave_barrier();
    }
  }
}


DEVFN void phase_gates(const int WID, PP p, int j) {
  const int BID = opaque_bid();
  const int tid = opaque_tid(WID), lane = tid & 63, wave = tid >> 6;
  char* ws = p->ws;
  const u16* h = (const u16*)(ws + OFF_HBUF);
  const u16* wg = (const u16*)(ws + OFF_WT_QG) + (size_t)j * 8448 * 2048 + (size_t)8192 * 2048;
  float* gates = (float*)(ws + OFF_GATES);
  float* red = (float*)smem;
  const int l15 = lane & 15, l4 = lane >> 4;
  const int mt = wave & 3, kh = wave >> 2;
  for (int bt = BID; bt < 256; bt += gridDim.x) {
    const int row0 = bt * 64 + mt * 16;
    f32x4 acc[3];
#pragma unroll
    for (int nt = 0; nt < 3; nt++) acc[nt] = f32x4{0.f, 0.f, 0.f, 0.f};
    const u16* ap = h + (size_t)(row0 + l15) * 2048 + kh * 1024 + l4 * 8;
    const u16* bp = wg + (size_t)l15 * 2048 + kh * 1024 + l4 * 8;
#pragma unroll 8
    for (int ks = 0; ks < 32; ks++) {
      bf16x8 af = *(const bf16x8*)&ap[ks * 32];
#pragma unroll
      for (int nt = 0; nt < 3; nt++) {
        bf16x8 bfr = *(const bf16x8*)&bp[(size_t)nt * 16 * 2048 + ks * 32];
        acc[nt] = __builtin_amdgcn_mfma_f32_16x16x32_bf16(af, bfr, acc[nt], 0, 0, 0);
      }
    }
    __syncthreads();
    if (kh == 1) {
#pragma unroll
      for (int nt = 0; nt < 3; nt++)
#pragma unroll
        for (int jj = 0; jj < 4; jj++) red[(mt * 16 + l4 * 4 + jj) * 48 + nt * 16 + l15] = acc[nt][jj];
    }
    __syncthreads();
    if (kh == 0) {
#pragma unroll
      for (int nt = 0; nt < 3; nt++)
#pragma unroll
        for (int jj = 0; jj < 4; jj++) {
          float v = acc[nt][jj] + red[(mt * 16 + l4 * 4 + jj) * 48 + nt * 16 + l15];
          gates[(size_t)(row0 + l4 * 4 + jj) * 48 + nt * 16 + l15] = sigmoidf_(v);
        }
    }
  }
}


DEVFN void phase_n3(const int WID, PP p) {
  const int BID = opaque_bid();
  const int tid = opaque_tid(WID), lane = tid & 63, wave = tid >> 6;
  char* ws = p->ws;
  const u16* q = (const u16*)(ws + OFF_Q);
  const u16* kvb = (const u16*)(ws + OFF_KVB);
  const u16* vt = (const u16*)(ws + OFF_VT);
  u16* sz3 = (u16*)(ws + OFF_SZ3);
  u16* ocomb = (u16*)(ws + OFF_HBUF);
  const float* gates = (const float*)(ws + OFF_GATES);
  const u64* selm = (const u64*)(ws + OFF_SELM);
  char* Ks = smem;
  char* Vs = smem + 32768;
  char* Qs = smem + 65536 + wave * 8704;
  const unsigned lds0 = (unsigned)(unsigned long)(__attribute__((address_space(3))) char*)smem;
  const int l15 = lane & 15, l4 = lane >> 4;
  unsigned koff[2], voff[2];
#pragma unroll
  for (int i = 0; i < 2; i++) {
    int slab = i * 8 + wave;
    int rk = slab * 4 + (lane >> 4), ck = (lane & 15) ^ (rk & 15);
    koff[i] = (unsigned)(rk * 3072 + ck * 8) * 2u;
    int rv = slab * 8 + (lane >> 3), cv = (lane & 7) ^ ((rv >> 1) & 7);
    voff[i] = (unsigned)(rv * 4096 + cv * 8) * 2u;
  }
  const unsigned slab0 = (unsigned)__builtin_amdgcn_readfirstlane(wave * 1024);
#define N3_DMA(voffv, sbase, ldsa) asm volatile("s_mov_b32 m0, %2\n\ts_nop 0\n\tglobal_load_lds_dwordx4 %0, %1" :: "v"(voffv), "s"(sbase), "s"(ldsa) : "memory")
  int kofs[4], vofs[4];
#pragma unroll
  for (int kk = 0; kk < 4; kk++) kofs[kk] = l15 * 256 + (((kk * 4 + l4) ^ l15) & 15) * 16;
#pragma unroll
  for (int c = 0; c < 4; c++) {
    int logical = (c >> 1) * 4 + (l4 >> 1) + (c & 1) * 2;
    vofs[c] = l15 * 128 + ((logical ^ ((l15 >> 1) & 7)) & 7) * 16 + (l4 & 1) * 8;
  }
  const int qofs = l15 * 272 + l4 * 16;
  for (int task = BID; task < 512; task += gridDim.x) {
    int bg = task >> 5, pp = task & 31; int b = bg >> 2, g = bg & 3;
#pragma unroll 1
    for (int half = 0; half < 2; half++) {
      int cur = half ? pp : 63 - pp;
      int tq0 = cur * 64 + wave * 8;
#pragma unroll
      for (int i = 0; i < 8; i++) {
        int ci = lane + 64 * i; int row = ci >> 4, c16 = ci & 15;
        uint4 v = *(const uint4*)&q[(size_t)(b * 4096 + tq0 + (row >> 2)) * 2048 + (g * 4 + (row & 3)) * 128 + c16 * 8];
        *(uint4*)(Qs + row * 272 + c16 * 16) = v;
      }
      __builtin_amdgcn_fence(__ATOMIC_SEQ_CST, "wavefront");
      __builtin_amdgcn_wave_barrier();
      int tokL[2]; u64 sm_[2];
#pragma unroll
      for (int mt = 0; mt < 2; mt++) { tokL[mt] = tq0 + mt * 4 + (l15 >> 2); sm_[mt] = selm[(size_t)bg * 4096 + tokL[mt]]; }
      u64 wm = 0;
#pragma unroll
      for (int i = 0; i < 8; i++) wm |= selm[(size_t)bg * 4096 + tq0 + i];
      const int head = g * 4 + (l15 & 3);
#pragma unroll 1
      for (int mode = 0; mode < 2; mode++) {
        int jb0 = (mode == 0) ? 0 : max(0, cur - 8);
        int ntile = cur - jb0 + 1;
        int kbr = (mode == 0) ? 2 : 4;
        const u16* kbase = kvb + (size_t)b * 4096 * 3072 + kbr * 512 + g * 128;
        const u16* vbase = vt + (size_t)((mode * 4 + b) * 4 + g) * 128 * 4096;
        f32x4 O[8][2];
        float mrow[2], ls[2];
#pragma unroll
        for (int mt = 0; mt < 2; mt++) {
#pragma unroll
          for (int dt = 0; dt < 8; dt++) O[dt][mt] = f32x4{0.f, 0.f, 0.f, 0.f};
          mrow[mt] = -1e30f; ls[mt] = 0.f;
        }
        __syncthreads();
        {
          const char* kb_ = (const char*)(kbase + (size_t)jb0 * 64 * 3072);
          const char* vb_ = (const char*)(vbase + (size_t)jb0 * 64);
          N3_DMA(koff[0], kb_, lds0 + slab0);
          N3_DMA(koff[1], kb_, lds0 + slab0 + 8192u);
          N3_DMA(voff[0], vb_, lds0 + 32768u + slab0);
          N3_DMA(voff[1], vb_, lds0 + 32768u + slab0 + 8192u);
        }
        asm volatile("s_waitcnt vmcnt(0)" ::: "memory");
        __syncthreads();
        for (int it = 0; it < ntile; it++) {
          int jb = jb0 + it;
          const int jn = (it + 1 < ntile) ? jb + 1 : jb;
          {
            const unsigned nb = (unsigned)((it + 1) & 1) * 16384u;
            const char* kb_ = (const char*)(kbase + (size_t)jn * 64 * 3072);
            const char* vb_ = (const char*)(vbase + (size_t)jn * 64);
            N3_DMA(koff[0], kb_, lds0 + nb + slab0);
            N3_DMA(koff[1], kb_, lds0 + nb + slab0 + 8192u);
            N3_DMA(voff[0], vb_, lds0 + 32768u + nb + slab0);
            N3_DMA(voff[1], vb_, lds0 + 32768u + nb + slab0 + 8192u);
          }
          const char* Kc = Ks + (it & 1) * 16384;
          const char* Vc = Vs + (it & 1) * 16384;
          bool act = (mode == 1) || ((wm >> jb) & 1ull);
          if (act) {
            f32x4 S[4][2];
#pragma unroll
            for (int nt = 0; nt < 4; nt++)
#pragma unroll
              for (int mt = 0; mt < 2; mt++) S[nt][mt] = f32x4{0.f, 0.f, 0.f, 0.f};
#define N3_LOADKQ(kk, qf, kf) do { \
              _Pragma("unroll") for (int mt = 0; mt < 2; mt++) qf[mt] = *(const bf16x8*)(Qs + qofs + mt * 4352 + (kk) * 64); \
              _Pragma("unroll") for (int nt = 0; nt < 4; nt++) kf[nt] = *(const bf16x8*)(Kc + kofs[kk] + nt * 4096); } while (0)
#define N3_MMAS(qf, kf) do { \
              _Pragma("unroll") for (int nt = 0; nt < 4; nt++) \
              _Pragma("unroll") for (int mt = 0; mt < 2; mt++) S[nt][mt] = __builtin_amdgcn_mfma_f32_16x16x32_bf16(kf[nt], qf[mt], S[nt][mt], 0, 0, 0); } while (0)
#define CBAR asm volatile("" ::: "memory")
            {
              bf16x8 qa[2], ka[4], qb[2], kb[4];
              N3_LOADKQ(0, qa, ka); CBAR;
              N3_LOADKQ(1, qb, kb); CBAR;
              N3_MMAS(qa, ka);
              N3_LOADKQ(2, qa, ka); CBAR;
              N3_MMAS(qb, kb);
              N3_LOADKQ(3, qb, kb); CBAR;
              N3_MMAS(qa, ka);
              N3_MMAS(qb, kb);
            }
            const bool interior = (mode == 0) ? (jb < cur) : (jb < cur && jb > cur - 8);
            bf16x8 Pf[2][2];
            float alpha[2];
#pragma unroll
            for (int mt = 0; mt < 2; mt++) {
              const bool rowok = (mode == 1) || ((sm_[mt] >> jb) & 1ull);
              const int tt = tokL[mt];
              float mx = -1e30f;
              float psum = 0.f;
              if (interior) {
#pragma unroll
                for (int nt = 0; nt < 4; nt++)
#pragma unroll
                  for (int j = 0; j < 4; j++) mx = fmaxf(mx, S[nt][mt][j]);
                mx = rowok ? mx : -1e30f;
                mx = fmaxf(mx, shx(mx, 16, lane));
                mx = fmaxf(mx, shx(mx, 32, lane));
                float mnew = fmaxf(mrow[mt], mx);
                alpha[mt] = __builtin_amdgcn_exp2f(mrow[mt] - mnew);
                mrow[mt] = mnew;
                const float msub = rowok ? mnew : 1e30f;
#pragma unroll
                for (int nt = 0; nt < 4; nt++)
#pragma unroll
                  for (int j = 0; j < 4; j++) { float pv = __builtin_amdgcn_exp2f(S[nt][mt][j] - msub); S[nt][mt][j] = pv; psum += pv; }
              } else {
#pragma unroll
                for (int nt = 0; nt < 4; nt++)
#pragma unroll
                  for (int j = 0; j < 4; j++) {
                    int kp = jb * 64 + nt * 16 + l4 * 4 + j;
                    bool ok = rowok && (kp <= tt) && ((mode == 0) || (kp + 512 > tt));
                    float sv = ok ? S[nt][mt][j] : -1e30f; S[nt][mt][j] = sv; mx = fmaxf(mx, sv);
                  }
                mx = fmaxf(mx, shx(mx, 16, lane));
                mx = fmaxf(mx, shx(mx, 32, lane));
                float mnew = fmaxf(mrow[mt], mx);
                alpha[mt] = __builtin_amdgcn_exp2f(mrow[mt] - mnew);
                mrow[mt] = mnew;
#pragma unroll
                for (int nt = 0; nt < 4; nt++)
#pragma unroll
                  for (int j = 0; j < 4; j++) {
                    float sv = S[nt][mt][j];
                    float pv = (sv > -1e29f) ? __builtin_amdgcn_exp2f(sv - mnew) : 0.f;
                    S[nt][mt][j] = pv; psum += pv;
                  }
              }
              ls[mt] = ls[mt] * alpha[mt] + psum;
#pragma unroll
              for (int ks = 0; ks < 2; ks++) {
                Pf[mt][ks] = mk8(pk_bf16(S[2 * ks][mt][0], S[2 * ks][mt][1]), pk_bf16(S[2 * ks][mt][2], S[2 * ks][mt][3]),
                                 pk_bf16(S[2 * ks + 1][mt][0], S[2 * ks + 1][mt][1]), pk_bf16(S[2 * ks + 1][mt][2], S[2 * ks + 1][mt][3]));
              }
            }
            if (__builtin_amdgcn_ballot_w64((alpha[0] != 1.f) || (alpha[1] != 1.f)) != 0ull) {
#pragma unroll
              for (int mt = 0; mt < 2; mt++)
#pragma unroll
                for (int dt = 0; dt < 8; dt++)
#pragma unroll
                  for (int j = 0; j < 4; j++) O[dt][mt][j] *= alpha[mt];
            }
#define N3_LOADV(ks, d0, vf) do { \
              _Pragma("unroll") for (int dd = 0; dd < 4; dd++) { \
                uint2 h0 = *(const uint2*)(Vc + vofs[(ks) * 2] + ((d0) + dd) * 2048); uint2 h1 = *(const uint2*)(Vc + vofs[(ks) * 2 + 1] + ((d0) + dd) * 2048); \
                vf[dd] = mk8(h0.x, h0.y, h1.x, h1.y); } } while (0)
#define N3_MMAV(ks, d0, vf) do { \
              _Pragma("unroll") for (int dd = 0; dd < 4; dd++) \
              _Pragma("unroll") for (int mt = 0; mt < 2; mt++) O[(d0) + dd][mt] = __builtin_amdgcn_mfma_f32_16x16x32_bf16(vf[dd], Pf[mt][ks], O[(d0) + dd][mt], 0, 0, 0); } while (0)
            {
              bf16x8 va[4], vb[4];
              N3_LOADV(0, 0, va); CBAR;
              N3_LOADV(0, 4, vb); CBAR;
              N3_MMAV(0, 0, va);
              N3_LOADV(1, 0, va); CBAR;
              N3_MMAV(0, 4, vb);
              N3_LOADV(1, 4, vb); CBAR;
              N3_MMAV(1, 0, va);
              N3_MMAV(1, 4, vb);
            }
          }
          asm volatile("s_waitcnt vmcnt(0)" ::: "memory");
          __syncthreads();
        }
#pragma unroll
        for (int mt = 0; mt < 2; mt++) {
          size_t tok = (size_t)(b * 4096 + tokL[mt]);
          float l = ls[mt];
          l += shx(l, 16, lane);
          l += shx(l, 32, lane);
          float inv = (l > 0.f) ? 1.f / l : 0.f;
          float gate = gates[tok * 48 + (mode + 1) * 16 + head] * inv;
#pragma unroll
          for (int dt = 0; dt < 8; dt++) {
            int d0 = dt * 16 + l4 * 4;
            size_t zi = tok * 6144 + (size_t)(mode + 1) * 2048 + head * 128 + d0;
            uint2 zz = *(const uint2*)&sz3[zi];
            float v0 = O[dt][mt][0] * gate * __uint_as_float(zz.x << 16);
            float v1 = O[dt][mt][1] * gate * __uint_as_float(zz.x & 0xffff0000u);
            float v2 = O[dt][mt][2] * gate * __uint_as_float(zz.y << 16);
            float v3 = O[dt][mt][3] * gate * __uint_as_float(zz.y & 0xffff0000u);
            if (mode == 0) {
              uint2 o; o.x = pk_bf16(v0, v1); o.y = pk_bf16(v2, v3);
              *(uint2*)&ocomb[tok * 2048 + head * 128 + d0] = o;
            } else {
              uint2 c0 = *(const uint2*)&sz3[tok * 6144 + head * 128 + d0];
              uint2 c1 = *(const uint2*)&ocomb[tok * 2048 + head * 128 + d0];
              v0 += __uint_as_float(c0.x << 16) + __uint_as_float(c1.x << 16);
              v1 += __uint_as_float(c0.x & 0xffff0000u) + __uint_as_float(c1.x & 0xffff0000u);
              v2 += __uint_as_float(c0.y << 16) + __uint_as_float(c1.y << 16);
              v3 += __uint_as_float(c0.y & 0xffff0000u) + __uint_as_float(c1.y & 0xffff0000u);
              uint2 o; o.x = pk_bf16(v0, v1); o.y = pk_bf16(v2, v3);
              *(uint2*)&ocomb[tok * 2048 + head * 128 + d0] = o;
            }
          }
        }
      }
    }
  }
}

constexpr int N_PHASES = 27;

DEVFN void decode_phase(int ph, int& kind, int& arg) {
  arg = 0;
  if (ph == 0) kind = 0;
  else if (ph <= 14) { arg = (ph - 1) / 7; kind = 1 + (ph - 1) % 7; }
  else {
    switch (ph) {
      case 15: kind = 1; arg = 2; break;
      case 16: kind = 8; break;
      case 17: kind = 10; arg = 0; break;
      case 18: kind = 11; break;
      case 19: kind = 12; break;
      case 20: kind = 7; arg = 2; break;
      case 21: kind = 1; arg = 3; break;
      case 22: kind = 10; arg = 1; break;
      case 23: kind = 11; break;
      case 24: kind = 12; break;
      case 25: kind = 7; arg = 3; break;
      default: kind = 13; break;
    }
  }
}
static void decode_phase_host(int ph, int& kind, int& arg) {
  arg = 0;
  if (ph == 0) kind = 0;
  else if (ph <= 14) { arg = (ph - 1) / 7; kind = 1 + (ph - 1) % 7; }
  else {
    const int kk[12] = {1, 8, 10, 11, 12, 7, 1, 10, 11, 12, 7, 13};
    const int aa[12] = {2, 0, 0, 0, 0, 2, 3, 1, 0, 0, 3, 0};
    kind = kk[ph - 15]; arg = aa[ph - 15];
  }
}

template <int KIND>
DEVFN void run_kind(const int WID, PP p, int arg) {
  char* ws = p->ws;
  if constexpr (KIND == 0) phase_prep(WID, p);
  else if constexpr (KIND == 1) { phase_prenorm(WID, p, arg, arg == 2); if (arg < 2) phase_ssm_gen(WID, p, arg); if (arg == 2) phase_peb_final(WID, p); }
  else if constexpr (KIND == 2) gemm_phase<EPI_S1>(WID, p, (const u16*)(ws + OFF_HBUF), (const u16*)(ws + OFF_WT_IN) + (size_t)arg * 4096 * 2048, 4096, arg);
  else if constexpr (KIND == 3) phase_ssm_x1(WID, p, arg);
  else if constexpr (KIND == 4) phase_ssm_b(WID, p, arg);
  else if constexpr (KIND == 5) phase_ssm_x3(WID, p, arg);
  else if constexpr (KIND == 6) gemm_phase<EPI_S3>(WID, p, (const u16*)(ws + OFF_Y), (const u16*)(ws + OFF_WT_GLU) + (size_t)arg * 2048 * 2048, 2048, arg);
  else if constexpr (KIND == 7) {
    const u16* A = (arg < 2) ? (const u16*)(ws + OFF_V) : (const u16*)(ws + OFF_HBUF);
    const u16* B = (arg < 2) ? (const u16*)(ws + OFF_WT_OUT) + (size_t)arg * 2048 * 2048
                             : (const u16*)(ws + OFF_WT_O) + (size_t)(arg - 2) * 2048 * 2048;
    gemm_phase<EPI_RES>(WID, p, A, B, 2048, arg);
  }
  else if constexpr (KIND == 8) gemm_phase<EPI_KV>(WID, p, (const u16*)(ws + OFF_HKV), (const u16*)(ws + OFF_WT_KV), 3072, 0);
  else if constexpr (KIND == 9) { }
  else if constexpr (KIND == 10) {
    if (arg == 0) phase_compress(WID, p);
    __syncthreads();
    phase_gates(WID, p, arg);
    __syncthreads();
    gemm_phase<EPI_QG>(WID, p, (const u16*)(ws + OFF_HBUF), (const u16*)(ws + OFF_WT_QG) + (size_t)arg * 8448 * 2048, 8192, arg);
  }
  else if constexpr (KIND == 11) phase_n2(WID, p);
  else if constexpr (KIND == 12) phase_n3(WID, p);
  else phase_final(WID, p);
}


#define XB_TMO      128
#define XB_XCNT(j)  (256  + 64 * (j))
#define XB_XSUB(j)  (1280 + 64 * (j))
#define XB_XGEN(j)  (2304 + 64 * (j))
#define XB_TOP      3328
#define XB_TOPGEN   3392
#define XCD_BAR_WORDS 3456
#define XB_SPIN_CAP (1u << 20)
#define LAS __attribute__((address_space(3)))
__device__ __forceinline__ unsigned xb_ld(unsigned* p)              { return __hip_atomic_load(p, __ATOMIC_RELAXED, __HIP_MEMORY_SCOPE_AGENT); }
__device__ __forceinline__ unsigned xb_add(unsigned* p, unsigned v) { return __hip_atomic_fetch_add(p, v, __ATOMIC_RELAXED, __HIP_MEMORY_SCOPE_AGENT); }
__device__ __forceinline__ unsigned xb_xcc_id() { return (unsigned)__builtin_amdgcn_s_getreg((3 << 11) | 20) & 0xFu; }
#define XB_SPIN(cond, bar) do { unsigned _sp = 0; while (cond) { __builtin_amdgcn_s_sleep(1); \
    if ((++_sp & 255u) == 0u) { if (xb_ld(&(bar)[XB_TMO])) break; if (_sp > XB_SPIN_CAP) { atomicAdd(&(bar)[XB_TMO], 1u); break; } } } } while (0)
struct XcdBarrier { unsigned* bar; unsigned x; volatile LAS unsigned* st; };
__device__ __forceinline__ XcdBarrier xcd_barrier_post(unsigned* bar, volatile LAS unsigned* st) {
  XcdBarrier b; b.bar = bar; b.x = xb_xcc_id(); b.st = st;
  if (threadIdx.x == 0) (void)xb_add(&bar[XB_XCNT(b.x)], 1u);
  return b;
}
__device__ __forceinline__ void xcd_barrier_complete(unsigned* bar, unsigned x, unsigned& nloc, unsigned& nx) {
  const unsigned G = gridDim.x * gridDim.y * gridDim.z;
  unsigned sum, cnt, mine, sp = 0u;
  for (;;) {
    sum = 0u; cnt = 0u; mine = 0u;
#pragma unroll
    for (unsigned j = 0; j < 16; ++j) { const unsigned c = xb_ld(&bar[XB_XCNT(j)]); sum += c; cnt += (c > 0u) ? 1u : 0u; mine = (j == x) ? c : mine; }
    if (sum == G) break;
    __builtin_amdgcn_s_sleep(1);
    if ((++sp & 255u) == 0u) { if (xb_ld(&bar[XB_TMO])) break; if (sp > XB_SPIN_CAP) { atomicAdd(&bar[XB_TMO], 1u); break; } }
  }
  nloc = mine > 0u ? mine : 1u; nx = cnt > 0u ? cnt : 1u;
}
__device__ __forceinline__ void xcd_barrier(const XcdBarrier& b, const int WID) {
  asm volatile("s_waitcnt vmcnt(0)" ::: "memory");
  __syncthreads();
  if (opaque_tid(WID) == 0) {
    unsigned* bar = b.bar; asm volatile("" : "+s"(bar));
    __builtin_amdgcn_s_waitcnt(0);
    unsigned nloc = b.st[0], nx = b.st[1];
    if (nloc == 0u) { xcd_barrier_complete(bar, b.x, nloc, nx); b.st[0] = nloc; b.st[1] = nx; }
    const unsigned old = xb_add(&bar[XB_XSUB(b.x)], 1u);
    const unsigned gen = old / nloc;
    if (old + 1u == (gen + 1u) * nloc) {
      __builtin_amdgcn_fence(__ATOMIC_RELEASE, "agent");
      asm volatile("s_waitcnt vmcnt(0)" ::: "memory");
      const unsigned og = xb_add(&bar[XB_TOP], 1u);
      const unsigned tg = og / nx;
      if (og + 1u == (tg + 1u) * nx) xb_add(&bar[XB_TOPGEN], 1u);
      else XB_SPIN(xb_ld(&bar[XB_TOPGEN]) == tg, bar);
      __builtin_amdgcn_fence(__ATOMIC_ACQUIRE, "agent");
      xb_add(&bar[XB_XGEN(b.x)], 1u);
      asm volatile("s_waitcnt vmcnt(0)" ::: "memory");
    } else {
      XB_SPIN(xb_ld(&bar[XB_XGEN(b.x)]) == gen, bar);
      __builtin_amdgcn_fence(__ATOMIC_ACQUIRE, "agent");
      asm volatile("s_waitcnt vmcnt(0)" ::: "memory");
    }
  }
  __syncthreads();
}

#if ONE_LAUNCH
__global__ void __launch_bounds__(512) mega(Params pv, int lo, int hi) {
  cg::grid_group grid = cg::this_grid();
  PP pp = (PP)__builtin_amdgcn_kernarg_segment_ptr();
  const int WID = __builtin_amdgcn_readfirstlane((int)(threadIdx.x >> 6));
  __shared__ uint4 xb_words;
  if (threadIdx.x == 0) xb_words = make_uint4(0u, 0u, 0u, 0u);
  __syncthreads();
  XcdBarrier xb = xcd_barrier_post((unsigned*)(pp->ws + OFF_BAR), (volatile LAS unsigned*)&xb_words);
  for (int ph = lo; ph < hi; ph++) {
    PP p = opaque_pp(pp);
    int kind, arg;
    decode_phase(ph, kind, arg);
#if REPEAT_MASK
    for (int rep = 0; rep < (((REPEAT_MASK >> kind) & 1) ? 2 : 1); rep++) {
    if (rep) xcd_barrier(xb, WID);
#endif
    switch (kind) {
      case 0: run_kind<0>(WID, p, arg); break;
      case 1: run_kind<1>(WID, p, arg); break;
      case 2: run_kind<2>(WID, p, arg); break;
      case 3: run_kind<3>(WID, p, arg); break;
      case 4: run_kind<4>(WID, p, arg); break;
      case 5: run_kind<5>(WID, p, arg); break;
      case 6: run_kind<6>(WID, p, arg); break;
      case 7: run_kind<7>(WID, p, arg); break;
      case 8: run_kind<8>(WID, p, arg); break;
      case 9: run_kind<9>(WID, p, arg); break;
      case 10: run_kind<10>(WID, p, arg); break;
      case 11: run_kind<11>(WID, p, arg); break;
      case 12: run_kind<12>(WID, p, arg); break;
      default: run_kind<13>(WID, p, arg); break;
    }
#if REPEAT_MASK
    }
#endif
    if (ph + 1 < hi) {
      if (hi > 1000) grid.sync();
      xcd_barrier(xb, WID);
    }
  }
}
#else
template <int KIND>
__global__ void __launch_bounds__(512) pk(Params pv, int arg) {
  PP p = opaque_pp((PP)__builtin_amdgcn_kernarg_segment_ptr());
  const int WID = __builtin_amdgcn_readfirstlane((int)(threadIdx.x >> 6));
  run_kind<KIND>(WID, p, arg);
}
template <int KIND>
static void launch_kind(const Params& p, int arg, int grid, hipStream_t stream) {
  static bool attr_set = false;
  if (!attr_set) { (void)hipFuncSetAttribute((const void*)pk<KIND>, hipFuncAttributeMaxDynamicSharedMemorySize, LDS_BYTES); attr_set = true; }
  hipLaunchKernelGGL(pk<KIND>, dim3(grid), dim3(512), LDS_BYTES, stream, p, arg);
}
#endif

extern "C" void kernel_launch(void* const* d_in, const int* in_sizes, int n_in, void* d_out, int out_size, void* d_ws,
                              size_t ws_size, hipStream_t stream) {
  Params p{};
  const float** f = (const float**)&p;
  for (int i = 0; i < 29; i++) f[i] = (const float*)d_in[i];
  p.out = (float*)d_out;
  p.ws = (char*)d_ws;
#if ONE_LAUNCH
  static int grid_blocks = 0;
  if (!grid_blocks) {
    (void)hipFuncSetAttribute((const void*)mega, hipFuncAttributeMaxDynamicSharedMemorySize, LDS_BYTES);
    int dev = 0, cus = 0, per_cu = 0;
    (void)hipGetDevice(&dev);
    (void)hipDeviceGetAttribute(&cus, hipDeviceAttributeMultiprocessorCount, dev);
    (void)hipOccupancyMaxActiveBlocksPerMultiprocessor(&per_cu, mega, 512, LDS_BYTES);
    if (per_cu < 1) per_cu = 1;
    grid_blocks = cus * per_cu;
    if (ws_size < WS_NEEDED) fprintf(stderr, "workspace too small: %zu < %zu\n", ws_size, (size_t)WS_NEEDED);
  }
  (void)hipMemsetAsync((char*)d_ws + OFF_BAR, 0, 16384, stream);
  int lo = 0, hi = N_PHASES;
  void* args[] = {&p, &lo, &hi};
  hipError_t e = hipLaunchCooperativeKernel((void*)mega, dim3(grid_blocks), dim3(512), args, LDS_BYTES, stream);
  if (e != hipSuccess) fprintf(stderr, "cooperative launch failed: %s (grid %d)\n", hipGetErrorString(e), grid_blocks);
#else
  const int grid = 256;
  for (int ph = 0; ph < N_PHASES; ph++) {
    int kind, arg;
    decode_phase_host(ph, kind, arg);
    for (int rep = 0; rep < (((REPEAT_MASK >> kind) & 1) ? 2 : 1); rep++)
    switch (kind) {
      case 0: launch_kind<0>(p, arg, grid, stream); break;
      case 1: launch_kind<1>(p, arg, grid, stream); break;
      case 2: launch_kind<2>(p, arg, grid, stream); break;
      case 3: launch_kind<3>(p, arg, grid, stream); break;
      case 4: launch_kind<4>(p, arg, grid, stream); break;
      case 5: launch_kind<5>(p, arg, grid, stream); break;
      case 6: launch_kind<6>(p, arg, grid, stream); break;
      case 7: launch_kind<7>(p, arg, grid, stream); break;
      case 8: launch_kind<8>(p, arg, grid, stream); break;
      case 9: launch_kind<9>(p, arg, grid, stream); break;
      case 10: launch_kind<10>(p, arg, grid, stream); break;
      case 11: launch_kind<11>(p, arg, grid, stream); break;
      case 12: launch_kind<12>(p, arg, grid, stream); break;
      default: launch_kind<13>(p, arg, grid, stream); break;
    }
  }
#endif
}
```

```cpp
#include <hip/hip_runtime.h>
#include <hip/hip_bf16.h>
#include <hip/hip_cooperative_groups.h>
#include <cstdio>
namespace cg = cooperative_groups;

typedef unsigned short u16;
typedef unsigned long long u64;
using bf16x8 = __attribute__((ext_vector_type(8))) short;
using f32x4 = __attribute__((ext_vector_type(4))) float;

#ifndef ONE_LAUNCH
#define ONE_LAUNCH 1
#endif
#ifndef REPEAT_MASK
#define REPEAT_MASK 0
#endif

constexpr int T_ = 16384, L_ = 4096, D_ = 2048;
constexpr size_t MB = 1ull << 20;
constexpr size_t OFF_WT_IN = 0;
constexpr size_t OFF_WT_GLU = 32 * MB;
constexpr size_t OFF_WT_OUT = 48 * MB;
constexpr size_t OFF_WT_KV = 64 * MB;
constexpr size_t OFF_WT_QG = 76 * MB;
constexpr size_t OFF_WT_O = 142 * MB;
constexpr size_t OFF_W1T = 158 * MB;
constexpr size_t OFF_SMALL = 160 * MB;
constexpr size_t OFF_MODV = OFF_SMALL;
constexpr size_t OFF_KVMOD = OFF_SMALL + 512 * 1024;
constexpr size_t OFF_ABAR = OFF_SMALL + 1 * MB;
constexpr size_t OFF_AQ = OFF_ABAR + 256 * 1024;
constexpr size_t OFF_PEB = OFF_AQ + 256 * 1024;
constexpr size_t OFF_PEBP = OFF_SMALL + 6 * MB;
constexpr size_t OFF_BBRE = OFF_SMALL + 2 * MB;
constexpr size_t OFF_BBIM = OFF_SMALL + 3 * MB;
constexpr size_t OFF_BAR = OFF_SMALL + 5 * MB;
constexpr size_t OFF_KC = 168 * MB;
constexpr size_t OFF_VCT = 169 * MB;
constexpr size_t OFF_SELM = 170 * MB;
constexpr size_t OFF_XBUF = 172 * MB;
constexpr size_t OFF_HBUF = 300 * MB;
constexpr size_t OFF_R = 364 * MB;
constexpr size_t OFF_UZ = OFF_R;
constexpr size_t OFF_Y = OFF_R + 128 * MB;
constexpr size_t OFF_V = OFF_R + 192 * MB;
constexpr size_t OFF_ST = OFF_R + 256 * MB;
constexpr size_t OFF_SSM_KT = OFF_R + 272 * MB;
constexpr size_t OFF_SSM_W1 = OFF_R + 276 * MB;
constexpr size_t OFF_SSM_W2 = OFF_R + 308 * MB;
constexpr size_t OFF_SSM_XP = OFF_R + 340 * MB;
constexpr size_t OFF_KVB = OFF_R;
constexpr size_t OFF_VT = OFF_R + 96 * MB;
constexpr size_t OFF_Q = OFF_R + 128 * MB;
constexpr size_t OFF_SZ3 = OFF_R + 192 * MB;
constexpr size_t OFF_HKV = OFF_SZ3;
constexpr size_t OFF_GATES = OFF_R + 384 * MB;
constexpr size_t WS_NEEDED = OFF_GATES + 4 * MB;

constexpr int LDS_BYTES = 145408;

struct Params {
  const float *x, *c, *norm_g, *mod_w, *mod_b, *w_in, *lam_re, *lam_im, *log_step, *b_re, *b_im, *c_re, *c_im,
      *dskip, *w_glu, *b_glu, *w_out, *kv_norm_g, *kv_mod_w, *kv_mod_b, *w_kv, *cmp_pe, *cmp_w1, *cmp_b1, *cmp_w2,
      *cmp_b2, *w_qg, *w_o, *final_g;
  float* out;
  char* ws;
};

typedef const __attribute__((address_space(4))) Params* PP;
#define DEVFN __device__ __attribute__((always_inline)) inline

extern __shared__ __attribute__((aligned(16))) char smem[];
__device__ __forceinline__ int opaque_tid(int wid) { unsigned z = 0; asm volatile("" : "+v"(z)); return wid * 64 + (int)__builtin_amdgcn_mbcnt_hi(~0u, __builtin_amdgcn_mbcnt_lo(~0u, z)); }
__device__ __forceinline__ int opaque_bid() { int v = blockIdx.x; asm volatile("" : "+s"(v)); return v; }
__device__ __forceinline__ float shx(float v, int mask, int lane) {
  return __int_as_float(__builtin_amdgcn_ds_bpermute((lane ^ mask) << 2, __float_as_int(v)));
}
__device__ __forceinline__ PP opaque_pp(PP p) { asm volatile("" : "+s"(p)); return p; }

__device__ __forceinline__ u16 f2bf(float f) {
  unsigned u = __float_as_uint(f);
  u += 0x7fffu + ((u >> 16) & 1u);
  return (u16)(u >> 16);
}
__device__ __forceinline__ unsigned pk_bf16(float lo, float hi) {
  unsigned r; asm("v_cvt_pk_bf16_f32 %0, %1, %2" : "=v"(r) : "v"(lo), "v"(hi)); return r;
}
typedef unsigned u32x4 __attribute__((ext_vector_type(4)));
__device__ __forceinline__ bf16x8 mk8(unsigned a, unsigned b, unsigned c, unsigned d) { u32x4 t = {a, b, c, d}; return __builtin_bit_cast(bf16x8, t); }
__device__ __forceinline__ float bf2f(u16 h) { return __uint_as_float(((unsigned)h) << 16); }
__device__ __forceinline__ float sigmoidf_(float x) { return 1.f / (1.f + __expf(-x)); }
__device__ __forceinline__ float siluf_(float x) { return x / (1.f + __expf(-x)); }
__device__ __forceinline__ float gelu_tanh(float x) {
  float u2 = 1.5957691216057308f * (x + 0.044715f * x * x * x);
  return x / (1.f + __expf(-u2));
}
__device__ __forceinline__ float wave_sum(float v, int lane) {
#pragma unroll
  for (int o = 32; o > 0; o >>= 1) v += shx(v, o, lane);
  return v;
}

DEVFN void xpose(const int WID, const float* __restrict__ src, u16* __restrict__ dst, int K, int Nsrc, int Ndst, int mode) {
  const int BID = opaque_bid();
  float* tile = (float*)smem;
  const int tid = opaque_tid(WID);
  const int tilesK = K / 64, nt = (Ndst / 64) * tilesK;
  const int kr = tid >> 4, nc = (tid & 15) * 4;
  const int n = tid >> 3, kc = (tid & 7) * 8;
  int t = BID;
  if (t >= nt) return;
  float4 cur0, cur1;
  {
    int tn = t / tilesK, tk = t - tn * tilesK; int n0 = tn * 64, k0 = tk * 64;
    int sc0 = n0, nvalid = 64;
    if (mode == 1) { if (n0 < 2048) sc0 = n0; else if (n0 < 8192) sc0 = n0 + 48; else if (n0 == 8192) { sc0 = 2048; nvalid = 48; } else { sc0 = 0; nvalid = 0; } }
    cur0 = make_float4(0.f, 0.f, 0.f, 0.f); cur1 = cur0;
    if (nc < nvalid) { cur0 = *(const float4*)&src[(size_t)(k0 + kr) * Nsrc + sc0 + nc]; cur1 = *(const float4*)&src[(size_t)(k0 + kr + 32) * Nsrc + sc0 + nc]; }
  }
  int it = 0;
  for (; t < nt; t += gridDim.x, ++it) {
    const int t2 = (t + (int)gridDim.x < nt) ? t + (int)gridDim.x : t;
    float4 nx0, nx1;
    {
      int tn = t2 / tilesK, tk = t2 - tn * tilesK; int n0 = tn * 64, k0 = tk * 64;
      int sc0 = n0, nvalid = 64;
      if (mode == 1) { if (n0 < 2048) sc0 = n0; else if (n0 < 8192) sc0 = n0 + 48; else if (n0 == 8192) { sc0 = 2048; nvalid = 48; } else { sc0 = 0; nvalid = 0; } }
      nx0 = make_float4(0.f, 0.f, 0.f, 0.f); nx1 = nx0;
      if (nc < nvalid) { nx0 = *(const float4*)&src[(size_t)(k0 + kr) * Nsrc + sc0 + nc]; nx1 = *(const float4*)&src[(size_t)(k0 + kr + 32) * Nsrc + sc0 + nc]; }
    }
    float* tb = tile + (it & 1) * (64 * 65);
    tb[kr * 65 + nc + 0] = cur0.x; tb[kr * 65 + nc + 1] = cur0.y; tb[kr * 65 + nc + 2] = cur0.z; tb[kr * 65 + nc + 3] = cur0.w;
    tb[(kr + 32) * 65 + nc + 0] = cur1.x; tb[(kr + 32) * 65 + nc + 1] = cur1.y; tb[(kr + 32) * 65 + nc + 2] = cur1.z; tb[(kr + 32) * 65 + nc + 3] = cur1.w;
    __syncthreads();
    {
      int tn = t / tilesK, tk = t - tn * tilesK; int n0 = tn * 64, k0 = tk * 64;
      uint4 o;
      o.x = pk_bf16(tb[(kc + 0) * 65 + n], tb[(kc + 1) * 65 + n]);
      o.y = pk_bf16(tb[(kc + 2) * 65 + n], tb[(kc + 3) * 65 + n]);
      o.z = pk_bf16(tb[(kc + 4) * 65 + n], tb[(kc + 5) * 65 + n]);
      o.w = pk_bf16(tb[(kc + 6) * 65 + n], tb[(kc + 7) * 65 + n]);
      *(uint4*)&dst[(size_t)(n0 + n) * K + k0 + kc] = o;
    }
    cur0 = nx0; cur1 = nx1;
  }
  __syncthreads();
}

DEVFN void phase_prep(const int WID, PP p) {
  const int BID = opaque_bid();
  const int tid = opaque_tid(WID), lane = tid & 63, wave = tid >> 6;
  char* ws = p->ws;
  for (int job = 0; job < 13; job++) {
    const float* src; u16* dst; int K = 2048, Nsrc, Ndst, mode = 0;
    int l = job & 1, kind = job >> 1;
    if (kind == 0) { src = p->w_in + (size_t)l * 2048 * 4096; dst = (u16*)(ws + OFF_WT_IN) + (size_t)l * 4096 * 2048; Nsrc = 4096; Ndst = 4096; }
    else if (kind == 1) { src = p->w_glu + (size_t)l * 2048 * 2048; dst = (u16*)(ws + OFF_WT_GLU) + (size_t)l * 2048 * 2048; Nsrc = 2048; Ndst = 2048; }
    else if (kind == 2) { src = p->w_out + (size_t)l * 2048 * 2048; dst = (u16*)(ws + OFF_WT_OUT) + (size_t)l * 2048 * 2048; Nsrc = 2048; Ndst = 2048; }
    else if (kind == 3) { src = p->w_qg + (size_t)l * 2048 * 8240; dst = (u16*)(ws + OFF_WT_QG) + (size_t)l * 8448 * 2048; Nsrc = 8240; Ndst = 8448; mode = 1; }
    else if (kind == 4) { src = p->w_o + (size_t)l * 2048 * 2048; dst = (u16*)(ws + OFF_WT_O) + (size_t)l * 2048 * 2048; Nsrc = 2048; Ndst = 2048; }
    else if (kind == 5) { src = p->cmp_w1 + (size_t)l * 4096 * 128; dst = (u16*)(ws + OFF_W1T) + (size_t)l * 128 * 4096; K = 4096; Nsrc = 128; Ndst = 128; }
    else { src = p->w_kv; dst = (u16*)(ws + OFF_WT_KV); Nsrc = 3072; Ndst = 3072; }
    xpose(WID, src, dst, K, Nsrc, Ndst, mode);
  }
  {
    uint4* z = (uint4*)(ws + OFF_KC);
    unsigned zz = 0; asm volatile("" : "+v"(zz));
    for (int i = BID * 512 + tid; i < (int)(2 * MB / 16); i += gridDim.x * 512) z[i] = make_uint4(zz, zz, zz, zz);
  }
  {
    float* cact = (float*)smem;
    float* red = cact + 8192;
    float* modv = (float*)(ws + OFF_MODV);
    float* kvmod = (float*)(ws + OFF_KVMOD);
    for (int i = tid; i < 8192; i += 512) { float v = p->c[i]; cact[i] = v / (1.f + expf(-v)); }
    __syncthreads();
    for (int task = BID; task < 448; task += gridDim.x) {
      const float* W; const float* bias; float* outp; int N; int col0;
      if (task < 384) {
        int l = task / 96; col0 = (task % 96) * 64; W = p->mod_w + (size_t)l * 2048 * 6144; N = 6144;
        bias = p->mod_b + l * 6144; outp = modv + l * 4 * 6144;
      } else {
        col0 = (task - 384) * 64; W = p->kv_mod_w; N = 4096; bias = p->kv_mod_b; outp = kvmod;
      }
      float a0 = 0, a1 = 0, a2 = 0, a3 = 0;
      int kb = wave * 256;
      const float* wp = W + (size_t)kb * N + col0 + lane;
#pragma unroll 1
      for (int k0 = 0; k0 < 256; k0 += 32) {
        float wv[32];
#pragma unroll
        for (int i = 0; i < 32; i++) wv[i] = wp[(size_t)(k0 + i) * N];
#pragma unroll
        for (int i = 0; i < 32; i++) {
          int k = kb + k0 + i;
          a0 += cact[k] * wv[i]; a1 += cact[2048 + k] * wv[i]; a2 += cact[4096 + k] * wv[i]; a3 += cact[6144 + k] * wv[i];
        }
      }
      red[(wave * 4 + 0) * 64 + lane] = a0; red[(wave * 4 + 1) * 64 + lane] = a1;
      red[(wave * 4 + 2) * 64 + lane] = a2; red[(wave * 4 + 3) * 64 + lane] = a3;
      __syncthreads();
      if (tid < 256) {
        int b = tid >> 6, ln = tid & 63; float s = 0;
#pragma unroll
        for (int w = 0; w < 8; w++) s += red[(w * 4 + b) * 64 + ln];
        outp[b * N + col0 + ln] = s + bias[col0 + ln];
      }
      __syncthreads();
    }
  }
  {
    float2* abar = (float2*)(ws + OFF_ABAR); float2* aq = (float2*)(ws + OFF_AQ);
    float* bbre = (float*)(ws + OFF_BBRE); float* bbim = (float*)(ws + OFF_BBIM);
    for (int i = BID * 512 + tid; i < 2 * 128 * 64; i += gridDim.x * 512) {
      int lg = i >> 6;
      float dt = expf(p->log_step[lg]);
      float lr = p->lam_re[i], li = p->lam_im[i];
      float zr = lr * dt, zi = li * dt;
      float em1 = expm1f(zr), cz = cosf(zi), sz = sinf(zi), sh = sinf(0.5f * zi);
      float mag = em1 + 1.f;
      float arm1 = em1 * cz - 2.f * sh * sh;
      float are = 1.f + arm1, aim = mag * sz;
      float den = lr * lr + li * li;
      float cre = (arm1 * lr + aim * li) / den, cim = (aim * lr - arm1 * li) / den;
      abar[i] = make_float2(are, aim);
      float m64 = expf(zr * 64.f), a64 = zi * 64.f;
      aq[i] = make_float2(m64 * cosf(a64), m64 * sinf(a64));
#pragma unroll
      for (int c = 0; c < 16; c++) {
        float br = p->b_re[(size_t)i * 16 + c], bi = p->b_im[(size_t)i * 16 + c];
        bbre[(size_t)i * 16 + c] = cre * br - cim * bi;
        bbim[(size_t)i * 16 + c] = cre * bi + cim * br;
      }
    }
  }
  {
    float* red = (float*)smem + 16384;
    float* pebp = (float*)(ws + OFF_PEBP);
    for (int task = BID; task < 256; task += gridDim.x) {
      int kvi = task >> 7, kq = task & 127;
      int j = tid & 127, sub = tid >> 7;
      const float* pe = p->cmp_pe + kvi * 4096 + kq * 32 + sub * 8; const float* w1 = p->cmp_w1 + ((size_t)kvi * 4096 + kq * 32 + sub * 8) * 128 + j;
      float a = 0;
#pragma unroll
      for (int k = 0; k < 8; k++) a += pe[k] * w1[(size_t)k * 128];
      red[tid] = a;
      __syncthreads();
      if (tid < 128) pebp[(size_t)task * 128 + tid] = red[tid] + red[tid + 128] + red[tid + 256] + red[tid + 384];
      __syncthreads();
    }
  }
}

DEVFN void phase_peb_final(const int WID, PP p) {
  const int BID = opaque_bid();
  const int tid = opaque_tid(WID);
  if (BID != 0 || tid >= 256) return;
  char* ws = p->ws;
  const float* pebp = (const float*)(ws + OFF_PEBP);
  float* peb = (float*)(ws + OFF_PEB);
  int kvi = tid >> 7, j = tid & 127;
  float s = p->cmp_b1[kvi * 128 + j];
#pragma unroll 1
  for (int k0 = 0; k0 < 128; k0 += 32) {
    float v[32];
#pragma unroll
    for (int i = 0; i < 32; i++) v[i] = pebp[(size_t)(kvi * 128 + k0 + i) * 128 + j];
#pragma unroll
    for (int i = 0; i < 32; i++) s += v[i];
  }
  peb[kvi * 128 + j] = s;
}

DEVFN void phase_prenorm(const int WID, PP p, int layer, bool dual) {
  const int BID = opaque_bid();
  const int tid = opaque_tid(WID), lane = tid & 63, wave = tid >> 6;
  char* ws = p->ws;
  const float* xin = (layer == 0) ? p->x : (const float*)(ws + OFF_XBUF);
  const float* modv = (const float*)(ws + OFF_MODV);
  const float* kvmod = (const float*)(ws + OFF_KVMOD);
  u16* hbuf = (u16*)(ws + OFF_HBUF);
  u16* hkv = (u16*)(ws + OFF_HKV);
  for (int r0 = (BID * 8 + wave) * 2; r0 < T_; r0 += gridDim.x * 16) {
    float4 v[2][8]; float ss[2] = {0.f, 0.f};
#pragma unroll
    for (int rr = 0; rr < 2; rr++) {
      const float* xr = xin + (size_t)(r0 + rr) * 2048;
#pragma unroll
      for (int i = 0; i < 8; i++) v[rr][i] = *(const float4*)&xr[(i * 64 + lane) * 4];
    }
#pragma unroll
    for (int rr = 0; rr < 2; rr++) {
#pragma unroll
      for (int i = 0; i < 8; i++) ss[rr] += v[rr][i].x * v[rr][i].x + v[rr][i].y * v[rr][i].y + v[rr][i].z * v[rr][i].z + v[rr][i].w * v[rr][i].w;
      ss[rr] = wave_sum(ss[rr], lane);
    }
    const int b = r0 >> 12;
    const float* g = p->norm_g + layer * 2048; const float* mv = modv + (size_t)(layer * 4 + b) * 6144;
#pragma unroll
    for (int rr = 0; rr < 2; rr++) {
      const int r = r0 + rr;
      const float rstd = rsqrtf(ss[rr] * (1.f / 2048.f) + 1e-6f);
#pragma unroll
      for (int i = 0; i < 8; i++) {
        int c = (i * 64 + lane) * 4;
        float4 gg = *(const float4*)&g[c], sh = *(const float4*)&mv[c], sc = *(const float4*)&mv[2048 + c];
        uint2 o;
        o.x = pk_bf16(v[rr][i].x * rstd * gg.x * (1.f + sc.x) + sh.x, v[rr][i].y * rstd * gg.y * (1.f + sc.y) + sh.y);
        o.y = pk_bf16(v[rr][i].z * rstd * gg.z * (1.f + sc.z) + sh.z, v[rr][i].w * rstd * gg.w * (1.f + sc.w) + sh.w);
        *(uint2*)&hbuf[(size_t)r * 2048 + c] = o;
      }
      if (dual) {
        const float* g2 = p->kv_norm_g; const float* mv2 = kvmod + (size_t)b * 4096;
#pragma unroll
        for (int i = 0; i < 8; i++) {
          int c = (i * 64 + lane) * 4;
          float4 gg = *(const float4*)&g2[c], sh = *(const float4*)&mv2[c], sc = *(const float4*)&mv2[2048 + c];
          uint2 o;
          o.x = pk_bf16(v[rr][i].x * rstd * gg.x * (1.f + sc.x) + sh.x, v[rr][i].y * rstd * gg.y * (1.f + sc.y) + sh.y);
          o.y = pk_bf16(v[rr][i].z * rstd * gg.z * (1.f + sc.z) + sh.z, v[rr][i].w * rstd * gg.w * (1.f + sc.w) + sh.w);
          *(uint2*)&hkv[(size_t)r * 2048 + c] = o;
        }
      }
    }
  }
}

DEVFN void phase_final(const int WID, PP p) {
  const int BID = opaque_bid();
  const int tid = opaque_tid(WID), lane = tid & 63, wave = tid >> 6;
  const float* xin = (const float*)(p->ws + OFF_XBUF);
  for (int r0 = (BID * 8 + wave) * 2; r0 < T_; r0 += gridDim.x * 16) {
    float4 v[2][8]; float ss[2] = {0.f, 0.f};
#pragma unroll
    for (int rr = 0; rr < 2; rr++) {
      const float* xr = xin + (size_t)(r0 + rr) * 2048;
#pragma unroll
      for (int i = 0; i < 8; i++) v[rr][i] = *(const float4*)&xr[(i * 64 + lane) * 4];
    }
#pragma unroll
    for (int rr = 0; rr < 2; rr++) {
#pragma unroll
      for (int i = 0; i < 8; i++) ss[rr] += v[rr][i].x * v[rr][i].x + v[rr][i].y * v[rr][i].y + v[rr][i].z * v[rr][i].z + v[rr][i].w * v[rr][i].w;
      ss[rr] = wave_sum(ss[rr], lane);
    }
#pragma unroll
    for (int rr = 0; rr < 2; rr++) {
      const float rstd = rsqrtf(ss[rr] * (1.f / 2048.f) + 1e-6f);
#pragma unroll
      for (int i = 0; i < 8; i++) {
        int c = (i * 64 + lane) * 4;
        float4 gg = *(const float4*)&p->final_g[c];
        float4 o = make_float4(v[rr][i].x * rstd * gg.x, v[rr][i].y * rstd * gg.y, v[rr][i].z * rstd * gg.z, v[rr][i].w * rstd * gg.w);
        *(float4*)&p->out[(size_t)(r0 + rr) * 2048 + c] = o;
      }
    }
  }
}

enum { EPI_S1 = 0, EPI_S3 = 1, EPI_RES = 2, EPI_KV = 3, EPI_QG = 4 };

__device__ __forceinline__ uint2 pack4(float a, float b, float c, float d) { uint2 o; o.x = pk_bf16(a, b); o.y = pk_bf16(c, d); return o; }
__device__ __forceinline__ float bflo(unsigned u) { return __uint_as_float(u << 16); }
__device__ __forceinline__ float bfhi(unsigned u) { return __uint_as_float(u & 0xffff0000u); }

struct EpiPre { float4 x; uint2 a, b; };
template <int EPI>
__device__ __forceinline__ EpiPre epi_pre(PP p, int row, int col, int aux) {
  EpiPre r; r.x = make_float4(0.f, 0.f, 0.f, 0.f); r.a = make_uint2(0u, 0u); r.b = r.a;
  char* ws = p->ws;
  if constexpr (EPI == EPI_S3) {
    const u16* uz = (const u16*)(ws + OFF_UZ); const u16* y = (const u16*)(ws + OFF_Y);
    r.a = *(const uint2*)&y[(size_t)row * 2048 + col];
    r.b = *(const uint2*)&uz[(size_t)row * 4096 + 2048 + col];
  } else if constexpr (EPI == EPI_RES) {
    const float* xo = (aux == 0) ? p->x : (const float*)(ws + OFF_XBUF);
    r.x = *(const float4*)&xo[(size_t)row * 2048 + col];
  }
  return r;
}
template <int EPI>
__device__ __forceinline__ void epi_row(PP p, int row, int col, f32x4 v, int aux, const EpiPre& pre) {
  char* ws = p->ws;
  if constexpr (EPI == EPI_S1) {
    u16* uz = (u16*)(ws + OFF_UZ);
    if (col >= 2048) { v[0] = siluf_(v[0]); v[1] = siluf_(v[1]); v[2] = siluf_(v[2]); v[3] = siluf_(v[3]); }
    *(uint2*)&uz[(size_t)row * 4096 + col] = pack4(v[0], v[1], v[2], v[3]);
  } else if constexpr (EPI == EPI_S3) {
    const u16* uz = (const u16*)(ws + OFF_UZ); const u16* y = (const u16*)(ws + OFF_Y); u16* vo = (u16*)(ws + OFF_V);
    float4 bg = *(const float4*)&p->b_glu[aux * 2048 + col];
    uint2 yy = pre.a;
    uint2 ss = pre.b;
    *(uint2*)&vo[(size_t)row * 2048 + col] = pack4(bflo(yy.x) * sigmoidf_(v[0] + bg.x) * bflo(ss.x), bfhi(yy.x) * sigmoidf_(v[1] + bg.y) * bfhi(ss.x),
                                                   bflo(yy.y) * sigmoidf_(v[2] + bg.z) * bflo(ss.y), bfhi(yy.y) * sigmoidf_(v[3] + bg.w) * bfhi(ss.y));
  } else if constexpr (EPI == EPI_RES) {
    const float* modv = (const float*)(ws + OFF_MODV);
    float* xb = (float*)(ws + OFF_XBUF);
    const float* xo = (aux == 0) ? p->x : xb;
    int b = row >> 12;
    float4 gate = *(const float4*)&modv[(size_t)(aux * 4 + b) * 6144 + 4096 + col];
    size_t idx = (size_t)row * 2048 + col;
    float4 xv = pre.x;
    *(float4*)&xb[idx] = make_float4(xv.x + gate.x * v[0], xv.y + gate.y * v[1], xv.z + gate.z * v[2], xv.w + gate.w * v[3]);
  } else if constexpr (EPI == EPI_KV) {
    u16* kvb = (u16*)(ws + OFF_KVB);
    *(uint2*)&kvb[(size_t)row * 3072 + col] = pack4(v[0], v[1], v[2], v[3]);
  } else if constexpr (EPI == EPI_QG) {
    if (col < 2048) {
      u16* q = (u16*)(ws + OFF_Q);
      const float sc = 0.08838834764831845f * 1.4426950408889634f;
      *(uint2*)&q[(size_t)row * 2048 + col] = pack4(v[0] * sc, v[1] * sc, v[2] * sc, v[3] * sc);
    } else if (col < 8192) {
      u16* sz3 = (u16*)(ws + OFF_SZ3);
      *(uint2*)&sz3[(size_t)row * 6144 + (col - 2048)] = pack4(siluf_(v[0]), siluf_(v[1]), siluf_(v[2]), siluf_(v[3]));
    } else if (col < 8240) {
      float* gates = (float*)(ws + OFF_GATES);
      *(float4*)&gates[(size_t)row * 48 + (col - 8192)] = make_float4(sigmoidf_(v[0]), sigmoidf_(v[1]), sigmoidf_(v[2]), sigmoidf_(v[3]));
    }
  }
}
__device__ __forceinline__ void epi_vt(PP p, int row0, int col, f32x4 v) {
  int br = col >> 9;
  int which = (br == 5) ? 1 : 0;
  int gg = (col >> 7) & 3, d = col & 127;
  int b = row0 >> 12, t = row0 & 4095;
  u16* vt = (u16*)(p->ws + OFF_VT);
  *(uint2*)&vt[((size_t)((which * 4 + b) * 4 + gg) * 128 + d) * 4096 + t] = pack4(v[0], v[1], v[2], v[3]);
}

typedef const __attribute__((address_space(1))) char* gptr_t;
constexpr int G_BM = 256, G_BK = 64, G_HALF = 128, G_NXCD = 8, G_WGM = 8, G_HT = G_HALF * G_BK;

__device__ __forceinline__ int lds_byte(int r, int c) {
  int st = (r >> 4) * 2 + (c >> 5), rr = r & 15, cc = c & 31, ob = rr * 64 + cc * 2;
  return st * 1024 + (ob ^ (((ob >> 9) & 1) << 5));
}
__device__ __forceinline__ void stage_rc(int b, int& R, int& C) {
  int st = b / 1024, sb = b % 1024, swz = sb ^ (((sb >> 9) & 1) << 5);
  R = (st >> 1) * 16 + swz / 64; C = (st & 1) * 32 + (swz % 64) / 2;
}

template <int EPI>
DEVFN void gemm_phase(const int WID, PP p, const u16* __restrict__ A, const u16* __restrict__ Bt, const int N, const int aux) {
  const int BID = opaque_bid();
  constexpr int K = 2048;
  u16* shm = (u16*)smem;
#define SA(b, h) (shm + ((b) * 2 + (h)) * G_HT)
#define SB(b, h) (shm + (4 + (b) * 2 + (h)) * G_HT)
#define STAGE(P, BASE, br, kt) do { const char* _ub = (const char*)(BASE + (long)(br) * K + (long)(kt) * G_BK); \
    unsigned _l0 = lds0 + (unsigned)((char*)(P) - smem) + wbase; \
    asm volatile("s_mov_b32 m0, %2\n\ts_nop 0\n\tglobal_load_lds_dwordx4 %0, %1" :: "v"(svoff[0]), "s"(_ub), "s"(_l0) : "memory"); \
    asm volatile("s_mov_b32 m0, %2\n\ts_nop 0\n\tglobal_load_lds_dwordx4 %0, %1" :: "v"(svoff[1]), "s"(_ub), "s"(_l0 + 8192u) : "memory"); } while (0)
#define LDA(dst, b, h) for (int m = 0; m < 4; ++m) for (int k = 0; k < 2; ++k) \
    dst[m][k] = *reinterpret_cast<const bf16x8*>((char*)SA(b, h) + lds_byte(wr * 64 + m * 16 + fr, k * 32 + fq * 8))
#define LDB(dst, b, h) for (int n = 0; n < 2; ++n) for (int k = 0; k < 2; ++k) \
    dst[n][k] = *reinterpret_cast<const bf16x8*>((char*)SB(b, h) + lds_byte(wc * 32 + n * 16 + fr, k * 32 + fq * 8))
#define MMA(ai, bj, At, Bt_) do { __builtin_amdgcn_s_setprio(1); \
    for (int m = 0; m < 4; ++m) for (int n = 0; n < 2; ++n) for (int k = 0; k < 2; ++k) \
      acc[ai][bj][m][n] = __builtin_amdgcn_mfma_f32_16x16x32_bf16(At[m][k], Bt_[n][k], acc[ai][bj][m][n], 0, 0, 0); \
    __builtin_amdgcn_s_setprio(0); } while (0)
#define WAIT_V(n) asm volatile("s_waitcnt vmcnt(" #n ")" ::: "memory")
#define WAIT_L(n) asm volatile("s_waitcnt lgkmcnt(" #n ")" ::: "memory")
#define BAR __builtin_amdgcn_s_barrier()
#define SCHED __builtin_amdgcn_sched_barrier(0)

  const int nM = T_ / G_BM, nN = N / G_BM, nwg = nM * nN;
  const int gtid = opaque_tid(WID);
  const int wid = gtid >> 6, lane = gtid & 63, wr = wid >> 2, wc = wid & 3, fr = lane & 15, fq = lane >> 4;
  constexpr int nt = K / G_BK;
  const int wbase = __builtin_amdgcn_readfirstlane((gtid >> 6) << 10);
  const unsigned lds0 = (unsigned)(unsigned long)(__attribute__((address_space(3))) char*)smem;
  unsigned svoff[2];
#pragma unroll
  for (int i = 0; i < 2; ++i) { int r_, c_; stage_rc(gtid * 16 + i * 8192, r_, c_); svoff[i] = (unsigned)(r_ * K + c_) * 2u; }
  for (int vt = BID; vt < nwg; vt += gridDim.x) {
    int wgid = vt;
    { int q = nwg / G_NXCD, r = nwg % G_NXCD, xcd = wgid % G_NXCD, off = wgid / G_NXCD;
      wgid = (xcd < r ? xcd * (q + 1) : r * (q + 1) + (xcd - r) * q) + off; }
    int nig = G_WGM * nN, gid = wgid / nig, fm = gid * G_WGM, gsz = min(nM - fm, G_WGM);
    int pm = fm + ((wgid % nig) % gsz), pn = (wgid % nig) / gsz, brow = pm * G_BM, bcol = pn * G_BM;
    f32x4 acc[2][2][4][2] = {};
    bf16x8 At[4][2], B0[2][2], B1[2][2];
    asm volatile("s_waitcnt vmcnt(0)" ::: "memory");
    STAGE(SB(0, 0), Bt, bcol, 0); STAGE(SA(0, 0), A, brow, 0);
    STAGE(SB(0, 1), Bt, bcol + G_HALF, 0); STAGE(SA(0, 1), A, brow + G_HALF, 0);
    if (wr == 1) BAR;
    WAIT_V(4); BAR;
    STAGE(SB(1, 0), Bt, bcol, 1); STAGE(SA(1, 0), A, brow, 1); STAGE(SB(1, 1), Bt, bcol + G_HALF, 1);
    WAIT_V(6); BAR;
#pragma nounroll
    for (int t = 0; t < nt - 2; t += 2) {
      LDB(B0, 0, 0); SCHED; LDA(At, 0, 0); STAGE(SA(1, 1), A, brow + G_HALF, t + 1);
      WAIT_L(8); BAR; WAIT_L(0); MMA(0, 0, At, B0); BAR; SCHED;
      LDB(B1, 0, 1); STAGE(SB(0, 0), Bt, bcol, t + 2);
      BAR; WAIT_L(0); MMA(0, 1, At, B1); BAR;
      LDA(At, 0, 1); STAGE(SA(0, 0), A, brow, t + 2);
      BAR; WAIT_L(0); MMA(1, 0, At, B0); BAR; SCHED;
      STAGE(SB(0, 1), Bt, bcol + G_HALF, t + 2);
      WAIT_V(6); BAR; MMA(1, 1, At, B1); BAR;
      LDB(B0, 1, 0); SCHED; LDA(At, 1, 0); STAGE(SA(0, 1), A, brow + G_HALF, t + 2);
      WAIT_L(8); BAR; WAIT_L(0); MMA(0, 0, At, B0); BAR; SCHED;
      LDB(B1, 1, 1); STAGE(SB(1, 0), Bt, bcol, t + 3);
      BAR; WAIT_L(0); MMA(0, 1, At, B1); BAR;
      LDA(At, 1, 1); STAGE(SA(1, 0), A, brow, t + 3);
      BAR; WAIT_L(0); MMA(1, 0, At, B0); BAR; SCHED;
      STAGE(SB(1, 1), Bt, bcol + G_HALF, t + 3);
      WAIT_V(6); BAR; MMA(1, 1, At, B1); BAR;
    }
    { LDB(B0, 0, 0); LDA(At, 0, 0); STAGE(SA(1, 1), A, brow + G_HALF, nt - 1);
      BAR; WAIT_L(0); MMA(0, 0, At, B0); BAR;
      LDB(B1, 0, 1); BAR; WAIT_L(0); MMA(0, 1, At, B1); BAR;
      LDA(At, 0, 1); WAIT_V(4); BAR; WAIT_L(0); MMA(1, 0, At, B0); MMA(1, 1, At, B1); BAR; }
    { LDB(B0, 1, 0); LDA(At, 1, 0); WAIT_V(2); BAR; WAIT_L(0); MMA(0, 0, At, B0); BAR;
      LDB(B1, 1, 1); WAIT_V(0); BAR; WAIT_L(0); MMA(0, 1, At, B1); BAR;
      LDA(At, 1, 1); BAR; WAIT_L(0); MMA(1, 0, At, B0); MMA(1, 1, At, B1); BAR; }
    if (wr == 0) BAR;
    {
      float* et = (float*)(smem + wid * 16384);
      const int te = opaque_tid(WID);
      const int fr = te & 15, fq = (te >> 4) & 3, wr = te >> 8, wc = (te >> 6) & 3;
      bool vtb = false;
      if constexpr (EPI == EPI_KV) { int br = bcol >> 9; vtb = (br == 3) || (br == 5); }
#pragma unroll
      for (int ai = 0; ai < 2; ++ai) {
#pragma unroll
        for (int bj = 0; bj < 2; ++bj)
#pragma unroll
          for (int m = 0; m < 4; ++m)
#pragma unroll
            for (int n = 0; n < 2; ++n)
#pragma unroll
              for (int j = 0; j < 4; ++j)
                et[(m * 16 + fq * 4 + j) * 64 + ((bj * 32 + n * 16 + fr) ^ (fq << 4))] = acc[ai][bj][m][n][j];
        const int rbase = brow + ai * G_HALF + wr * 64;
        if (!vtb) {
#pragma unroll 1
          for (int it0 = 0; it0 < 16; it0 += 4) {
            const int c4 = fr * 4;
            const int gcol = bcol + (c4 >> 5) * G_HALF + wc * 32 + (c4 & 31);
            EpiPre pre[4];
#pragma unroll
            for (int u = 0; u < 4; ++u) pre[u] = epi_pre<EPI>(p, rbase + (it0 + u) * 4 + fq, gcol, aux);
#pragma unroll
            for (int u = 0; u < 4; ++u) {
              int row = (it0 + u) * 4 + fq;
              f32x4 v = *(const f32x4*)&et[row * 64 + (c4 ^ (((row >> 2) & 3) << 4))];
              epi_row<EPI>(p, rbase + row, gcol, v, aux, pre[u]);
            }
          }
        } else {
#pragma unroll 1
          for (int it = 0; it < 16; ++it) {
            int c = it * 4 + fq, r4 = fr * 4;
            int sw = (fr & 3) << 4;
            f32x4 v;
            v[0] = et[(r4 + 0) * 64 + (c ^ sw)]; v[1] = et[(r4 + 1) * 64 + (c ^ sw)];
            v[2] = et[(r4 + 2) * 64 + (c ^ sw)]; v[3] = et[(r4 + 3) * 64 + (c ^ sw)];
            int gcol = bcol + (c >> 5) * G_HALF + wc * 32 + (c & 31);
            epi_vt(p, rbase + r4, gcol, v);
          }
        }
      }
    }
    __syncthreads();
  }
#undef SA
#undef SB
#undef STAGE
#undef LDA
#undef LDB
#undef MMA
}

DEVFN void phase_ssm_a(const int WID, PP p, int layer) {
  const int BID = opaque_bid();
  const int tid = opaque_tid(WID), lane = tid & 63, wave = tid >> 6;
  char* ws = p->ws;
  const u16* uz = (const u16*)(ws + OFF_UZ);
  const float2* abar = (const float2*)(ws + OFF_ABAR);
  const float* bbre = (const float*)(ws + OFF_BBRE); const float* bbim = (const float*)(ws + OFF_BBIM);
  float2* st = (float2*)(ws + OFF_ST);
  float* uw = (float*)smem + wave * 1024;
  for (int task = BID; task < 4096; task += gridDim.x) {
    int bg = task >> 3, co = task & 7; int b = bg >> 7, g = bg & 127;
    int c = co * 8 + wave;
    {
      int t = c * 64 + lane;
      const u16* up = uz + (size_t)(b * 4096 + t) * 4096 + g * 16;
      bf16x8 u0 = *(const bf16x8*)up, u1 = *(const bf16x8*)(up + 8);
#pragma unroll
      for (int j = 0; j < 8; j++) { uw[lane * 16 + j] = bf2f((u16)u0[j]); uw[lane * 16 + 8 + j] = bf2f((u16)u1[j]); }
    }
    int gi = (layer * 128 + g) * 64 + lane;
    float br[16], bi[16];
#pragma unroll
    for (int k = 0; k < 16; k++) { br[k] = bbre[(size_t)gi * 16 + k]; bi[k] = bbim[(size_t)gi * 16 + k]; }
    float2 a = abar[gi];
    __syncthreads();
    float xr = 0, xi = 0;
    for (int s = 0; s < 64; s++) {
      float bur = 0, bui = 0;
#pragma unroll
      for (int k4 = 0; k4 < 4; k4++) {
        float4 u = *(const float4*)&uw[s * 16 + k4 * 4];
        bur += br[k4 * 4 + 0] * u.x + br[k4 * 4 + 1] * u.y + br[k4 * 4 + 2] * u.z + br[k4 * 4 + 3] * u.w;
        bui += bi[k4 * 4 + 0] * u.x + bi[k4 * 4 + 1] * u.y + bi[k4 * 4 + 2] * u.z + bi[k4 * 4 + 3] * u.w;
      }
      float nr = a.x * xr - a.y * xi + bur;
      float ni = a.x * xi + a.y * xr + bui;
      xr = nr; xi = ni;
    }
    st[((size_t)bg * 64 + c) * 64 + lane] = make_float2(xr, xi);
    __syncthreads();
  }
}


DEVFN void phase_ssm_gen(const int WID, PP p, int layer) {
  const int BID = opaque_bid();
  const int tid = opaque_tid(WID);
  char* ws = p->ws;
  float2* pwr = (float2*)smem;
  float2* Cc = (float2*)(smem + 33280);
  float2* Bb = (float2*)(smem + 41472);
  const float* bbre = (const float*)(ws + OFF_BBRE); const float* bbim = (const float*)(ws + OFF_BBIM);
  for (int task = BID; task < 256; task += gridDim.x) {
    const int g = task >> 1, hf = task & 1;
    const int lg = layer * 128 + g;
    for (int i = tid; i < 1024; i += 512) {
      Cc[i] = make_float2(p->c_re[(size_t)lg * 1024 + i], p->c_im[(size_t)lg * 1024 + i]);
      Bb[i] = make_float2(bbre[(size_t)lg * 1024 + i], bbim[(size_t)lg * 1024 + i]);
    }
    {
      float dt = expf(p->log_step[lg]);
      for (int i = tid; i < 65 * 64; i += 512) {
        int d = i >> 6, n = i & 63;
        float lr = p->lam_re[lg * 64 + n], li = p->lam_im[lg * 64 + n];
        float mag = expf(lr * dt * (float)d);
        float sn, cs; sincosf(li * dt * (float)d, &sn, &cs);
        pwr[i] = make_float2(mag * cs, mag * sn);
      }
    }
    __syncthreads();
    {
      u16* kt = (u16*)(ws + OFF_SSM_KT) + (size_t)g * 16384;
      int d = hf * 32 + (tid >> 4), cp = tid & 15;
      float acc[16];
#pragma unroll
      for (int c = 0; c < 16; c++) acc[c] = 0.f;
      for (int n = 0; n < 64; n++) {
        float2 C = Cc[cp * 64 + n], P = pwr[d * 64 + n];
        float tr = C.x * P.x - C.y * P.y, ti = C.x * P.y + C.y * P.x;
#pragma unroll
        for (int c = 0; c < 16; c++) { float2 B = Bb[n * 16 + c]; acc[c] += tr * B.x - ti * B.y; }
      }
      uint4 o0, o1;
      o0.x = pk_bf16(acc[0], acc[1]); o0.y = pk_bf16(acc[2], acc[3]); o0.z = pk_bf16(acc[4], acc[5]); o0.w = pk_bf16(acc[6], acc[7]);
      o1.x = pk_bf16(acc[8], acc[9]); o1.y = pk_bf16(acc[10], acc[11]); o1.z = pk_bf16(acc[12], acc[13]); o1.w = pk_bf16(acc[14], acc[15]);
      *(uint4*)&kt[(d * 16 + cp) * 16] = o0;
      *(uint4*)&kt[(d * 16 + cp) * 16 + 8] = o1;
    }
    unsigned* w1 = (unsigned*)((u16*)(ws + OFF_SSM_W1) + (size_t)g * 131072);
    for (int e2 = hf * 32768 + tid; e2 < hf * 32768 + 32768; e2 += 512) {
      int e = e2 * 2; int row = e >> 10, k = e & 1023; int sidx = k >> 4, c = k & 15, n = row & 63;
      float2 P = pwr[(63 - sidx) * 64 + n];
      float2 B0 = Bb[n * 16 + c], B1 = Bb[n * 16 + c + 1];
      float v0, v1;
      if (row < 64) { v0 = P.x * B0.x - P.y * B0.y; v1 = P.x * B1.x - P.y * B1.y; }
      else { v0 = P.x * B0.y + P.y * B0.x; v1 = P.x * B1.y + P.y * B1.x; }
      w1[e2] = pk_bf16(v0, v1);
    }
    unsigned* w2 = (unsigned*)((u16*)(ws + OFF_SSM_W2) + (size_t)g * 131072);
    for (int e2 = hf * 32768 + tid; e2 < hf * 32768 + 32768; e2 += 512) {
      int e = e2 * 2; int row = e >> 7, k2 = e & 127; int sidx = row >> 4, cp = row & 15, n = k2 & 63;
      float2 C0 = Cc[cp * 64 + n], C1 = Cc[cp * 64 + n + 1];
      float2 P0 = pwr[(sidx + 1) * 64 + n], P1 = pwr[(sidx + 1) * 64 + n + 1];
      float v0, v1;
      if (k2 < 64) { v0 = C0.x * P0.x - C0.y * P0.y; v1 = C1.x * P1.x - C1.y * P1.y; }
      else { v0 = -(C0.x * P0.y + C0.y * P0.x); v1 = -(C1.x * P1.y + C1.y * P1.x); }
      w2[e2] = pk_bf16(v0, v1);
    }
    __syncthreads();
  }
}

DEVFN void phase_ssm_x1(const int WID, PP p, int layer) {
  const int BID = opaque_bid();
  const int tid = opaque_tid(WID), lane = tid & 63, wave = tid >> 6;
  char* ws = p->ws;
  const u16* uz = (const u16*)(ws + OFF_UZ);
  float* st = (float*)(ws + OFF_ST);
  const int l15 = lane & 15, l4 = lane >> 4;
  for (int bt = BID; bt < 256; bt += gridDim.x) {
    int wt = bt * 8 + wave; int g = wt >> 4, ct = wt & 15;
    int col = ct * 16 + l15; int b = col >> 6, chunk = col & 63;
    const u16* ub = uz + (size_t)(b * 4096 + chunk * 64) * 4096 + g * 16;
    const u16* w1 = (const u16*)(ws + OFF_SSM_W1) + (size_t)g * 131072;
    f32x4 acc[8];
#pragma unroll
    for (int mt = 0; mt < 8; mt++) acc[mt] = f32x4{0.f, 0.f, 0.f, 0.f};
#pragma unroll 4
    for (int ks = 0; ks < 32; ks++) {
      int sidx = ks * 2 + (l4 >> 1), c0 = (l4 & 1) * 8;
      bf16x8 bfr = *(const bf16x8*)&ub[(size_t)sidx * 4096 + c0];
#pragma unroll
      for (int mt = 0; mt < 8; mt++) {
        bf16x8 afr = *(const bf16x8*)&w1[(size_t)(mt * 16 + l15) * 1024 + ks * 32 + l4 * 8];
        acc[mt] = __builtin_amdgcn_mfma_f32_16x16x32_bf16(afr, bfr, acc[mt], 0, 0, 0);
      }
    }
    float* sb = st + (((size_t)(b * 128 + g) * 64 + chunk) * 64) * 2;
#pragma unroll
    for (int mt = 0; mt < 8; mt++)
#pragma unroll
      for (int j = 0; j < 4; j++) {
        int n2 = mt * 16 + l4 * 4 + j;
        sb[(n2 & 63) * 2 + (n2 >> 6)] = acc[mt][j];
      }
  }
}


DEVFN void phase_ssm_x3(const int WID, PP p, int layer) {
  const int BID = opaque_bid();
  const int tid = opaque_tid(WID), lane = tid & 63, wave = tid >> 6;
  char* ws = p->ws;
  const u16* uz = (const u16*)(ws + OFF_UZ);
  u16* yb = (u16*)(ws + OFF_Y);
  char* Kl = smem + 512;
  char* Wl = smem + 33280;
  const int l15 = lane & 15, l4 = lane >> 4;
  for (int bt = BID; bt < 256; bt += gridDim.x) {
    int wt = bt * 8 + wave; int g = wt >> 4, ct = wt & 15;
    int col = ct * 16 + l15; int b = col >> 6, chunk = col & 63;
    const u16* ub = uz + (size_t)(b * 4096 + chunk * 64) * 4096 + g * 16;
    const u16* kt = (const u16*)(ws + OFF_SSM_KT) + (size_t)g * 16384;
    const u16* w2 = (const u16*)(ws + OFF_SSM_W2) + (size_t)g * 131072;
    const u16* xpb = (const u16*)(ws + OFF_SSM_XP) + ((size_t)(b * 128 + g) * 64 + chunk) * 128;
    const int c0 = (l4 & 1) * 8;
    const char* kbase_l = Kl + (l15 - (l4 >> 1) * 16) * 32 + c0 * 2;
    float4 dsk = *(const float4*)&p->dskip[layer * 2048 + g * 16 + l4 * 4];
    __syncthreads();
#pragma unroll
    for (int i = 0; i < 4; i++) {
      int ci = tid + 512 * i;
      *(uint4*)(Kl + ci * 16) = *(const uint4*)&kt[ci * 8];
    }
    if (tid < 32) { unsigned zz = 0; asm volatile("" : "+v"(zz)); *(uint4*)(smem + tid * 16) = make_uint4(zz, zz, zz, zz); }
#pragma unroll 1
    for (int qd = 0; qd < 4; qd++) {
      if (qd) __syncthreads();
#pragma unroll
      for (int i = 0; i < 8; i++) {
        int ci = tid + 512 * i; int row = ci >> 4, c16 = ci & 15;
        *(uint4*)(Wl + row * 272 + c16 * 16) = *(const uint4*)&w2[(size_t)(qd * 256 + row) * 128 + c16 * 8];
      }
      __syncthreads();
      f32x4 acc[16];
#pragma unroll
      for (int sl = 0; sl < 16; sl++) acc[sl] = f32x4{0.f, 0.f, 0.f, 0.f};
      const int nks = 8 * qd + 8;
      bf16x8 ucur[4], unxt[4];
#pragma unroll
      for (int i = 0; i < 4; i++) ucur[i] = *(const bf16x8*)&ub[(size_t)(2 * i + (l4 >> 1)) * 4096 + c0];
#pragma unroll 1
      for (int ks0 = 0; ks0 < nks; ks0 += 4) {
#pragma unroll
        for (int i = 0; i < 4; i++) {
          int ksn = min(ks0 + 4 + i, nks - 1);
          unxt[i] = *(const bf16x8*)&ub[(size_t)(2 * ksn + (l4 >> 1)) * 4096 + c0];
        }
#pragma unroll
        for (int i = 0; i < 4; i++) {
          const int ks = ks0 + i;
#pragma unroll
          for (int sl = 0; sl < 16; sl++) {
            int sidx = qd * 16 + sl;
            if (sidx >= 2 * ks) {
              bf16x8 afr = *(const bf16x8*)(kbase_l + (sidx - 2 * ks) * 512);
              acc[sl] = __builtin_amdgcn_mfma_f32_16x16x32_bf16(afr, ucur[i], acc[sl], 0, 0, 0);
            }
          }
        }
#pragma unroll
        for (int i = 0; i < 4; i++) ucur[i] = unxt[i];
      }
#pragma unroll
      for (int kk = 0; kk < 4; kk++) {
        bf16x8 bfr = *(const bf16x8*)&xpb[kk * 32 + l4 * 8];
#pragma unroll
        for (int sl = 0; sl < 16; sl++) {
          bf16x8 afr = *(const bf16x8*)(Wl + (sl * 16 + l15) * 272 + (kk * 32 + l4 * 8) * 2);
          acc[sl] = __builtin_amdgcn_mfma_f32_16x16x32_bf16(afr, bfr, acc[sl], 0, 0, 0);
        }
      }
      {
        uint2 uuv[16];
#pragma unroll
        for (int sl = 0; sl < 16; sl++) {
          int t = chunk * 64 + qd * 16 + sl;
          uuv[sl] = *(const uint2*)&uz[(size_t)(b * 4096 + t) * 4096 + g * 16 + l4 * 4];
        }
#pragma unroll
        for (int sl = 0; sl < 16; sl++) {
          int t = chunk * 64 + qd * 16 + sl;
          uint2 uu = uuv[sl];
          float y0 = gelu_tanh(acc[sl][0] + dsk.x * __uint_as_float(uu.x << 16));
          float y1 = gelu_tanh(acc[sl][1] + dsk.y * __uint_as_float(uu.x & 0xffff0000u));
          float y2 = gelu_tanh(acc[sl][2] + dsk.z * __uint_as_float(uu.y << 16));
          float y3 = gelu_tanh(acc[sl][3] + dsk.w * __uint_as_float(uu.y & 0xffff0000u));
          uint2 o;
          o.x = pk_bf16(y0, y1);
          o.y = pk_bf16(y2, y3);
          *(uint2*)&yb[(size_t)(b * 4096 + t) * 2048 + g * 16 + l4 * 4] = o;
        }
      }
    }
  }
}

DEVFN void phase_ssm_b(const int WID, PP p, int layer) {
  const int BID = opaque_bid();
  const int tid = opaque_tid(WID);
  char* ws = p->ws;
  const float2* aq = (const float2*)(ws + OFF_AQ);
  float2* st = (float2*)(ws + OFF_ST);
  u16* xp = (u16*)(ws + OFF_SSM_XP);
  if (tid >= 128) return;
  for (int i = BID * 128 + tid; i < 4 * 128 * 64; i += gridDim.x * 128) {
    int n = i & 63, bg = i >> 6, g = bg & 127;
    float2 a = aq[(layer * 128 + g) * 64 + n];
    float xr = 0, xi = 0;
#pragma unroll 1
    for (int c0 = 0; c0 < 64; c0 += 32) {
      float2 sv[32];
#pragma unroll
      for (int k = 0; k < 32; k++) sv[k] = st[((size_t)bg * 64 + c0 + k) * 64 + n];
#pragma unroll
      for (int k = 0; k < 32; k++) {
        size_t idx = ((size_t)bg * 64 + c0 + k) * 64 + n;
        st[idx] = make_float2(xr, xi);
        xp[((size_t)bg * 64 + c0 + k) * 128 + n] = f2bf(xr);
        xp[((size_t)bg * 64 + c0 + k) * 128 + 64 + n] = f2bf(xi);
        float nr = a.x * xr - a.y * xi + sv[k].x;
        float ni = a.x * xi + a.y * xr + sv[k].y;
        xr = nr; xi = ni;
      }
    }
  }
}

DEVFN void phase_ssm_c(const int WID, PP p, int layer) {
  const int BID = opaque_bid();
  const int tid = opaque_tid(WID), lane = tid & 63, wave = tid >> 6;
  char* ws = p->ws;
  const u16* uz = (const u16*)(ws + OFF_UZ);
  u16* yb = (u16*)(ws + OFF_Y);
  const float2* abar = (const float2*)(ws + OFF_ABAR);
  const float* bbre = (const float*)(ws + OFF_BBRE); const float* bbim = (const float*)(ws + OFF_BBIM);
  const float2* st = (const float2*)(ws + OFF_ST);
  float* Cs = (float*)smem;
  float* uw = (float*)(smem + 8192 + wave * 12416);
  float* xs = uw + 1024;
  for (int task = BID; task < 4096; task += gridDim.x) {
    int bg = task >> 3, co = task & 7; int b = bg >> 7, g = bg & 127;
    int c = co * 8 + wave;
    for (int i = tid; i < 2048; i += 512) {
      int im = i >> 10, cp = (i >> 6) & 15, n = i & 63;
      const float* src = im ? p->c_im : p->c_re;
      Cs[n * 32 + im * 16 + cp] = src[((size_t)(layer * 128 + g) * 16 + cp) * 64 + n];
    }
    {
      int t = c * 64 + lane;
      const u16* up = uz + (size_t)(b * 4096 + t) * 4096 + g * 16;
      bf16x8 u0 = *(const bf16x8*)up, u1 = *(const bf16x8*)(up + 8);
#pragma unroll
      for (int j = 0; j < 8; j++) { uw[lane * 16 + j] = bf2f((u16)u0[j]); uw[lane * 16 + 8 + j] = bf2f((u16)u1[j]); }
    }
    int gi = (layer * 128 + g) * 64 + lane;
    float br[16], bi[16];
#pragma unroll
    for (int k = 0; k < 16; k++) { br[k] = bbre[(size_t)gi * 16 + k]; bi[k] = bbim[(size_t)gi * 16 + k]; }
    float2 a = abar[gi];
    float2 x0 = st[((size_t)bg * 64 + c) * 64 + lane];
    float xr = x0.x, xi = x0.y;
    const int s16 = lane >> 2, cq = lane & 3;
    float4 dsk = *(const float4*)&p->dskip[layer * 2048 + g * 16 + cq * 4];
    __syncthreads();
    for (int sub = 0; sub < 4; sub++) {
      for (int s = 0; s < 16; s++) {
        int sg = sub * 16 + s;
        float bur = 0, bui = 0;
#pragma unroll
        for (int k4 = 0; k4 < 4; k4++) {
          float4 u = *(const float4*)&uw[sg * 16 + k4 * 4];
          bur += br[k4 * 4 + 0] * u.x + br[k4 * 4 + 1] * u.y + br[k4 * 4 + 2] * u.z + br[k4 * 4 + 3] * u.w;
          bui += bi[k4 * 4 + 0] * u.x + bi[k4 * 4 + 1] * u.y + bi[k4 * 4 + 2] * u.z + bi[k4 * 4 + 3] * u.w;
        }
        float nr = a.x * xr - a.y * xi + bur;
        float ni = a.x * xi + a.y * xr + bui;
        xr = nr; xi = ni;
        *(float2*)&xs[s * 130 + 2 * lane] = make_float2(xr, xi);
      }
      __syncthreads();
      float y0 = 0, y1 = 0, y2 = 0, y3 = 0;
#pragma unroll 8
      for (int n = 0; n < 64; n++) {
        float2 xv = *(const float2*)&xs[s16 * 130 + 2 * n];
        float4 cr = *(const float4*)&Cs[n * 32 + cq * 4];
        float4 ci = *(const float4*)&Cs[n * 32 + 16 + cq * 4];
        y0 += cr.x * xv.x - ci.x * xv.y; y1 += cr.y * xv.x - ci.y * xv.y;
        y2 += cr.z * xv.x - ci.z * xv.y; y3 += cr.w * xv.x - ci.w * xv.y;
      }
      int sg = sub * 16 + s16;
      float4 u = *(const float4*)&uw[sg * 16 + cq * 4];
      y0 = gelu_tanh(y0 + dsk.x * u.x); y1 = gelu_tanh(y1 + dsk.y * u.y);
      y2 = gelu_tanh(y2 + dsk.z * u.z); y3 = gelu_tanh(y3 + dsk.w * u.w);
      int t = c * 64 + sg;
      uint2 o;
      o.x = (unsigned)f2bf(y0) | ((unsigned)f2bf(y1) << 16);
      o.y = (unsigned)f2bf(y2) | ((unsigned)f2bf(y3) << 16);
      *(uint2*)&yb[(size_t)(b * 4096 + t) * 2048 + g * 16 + cq * 4] = o;
      __syncthreads();
    }
  }
}

DEVFN void phase_compress(const int WID, PP p) {
  const int BID = opaque_bid();
  const int tid = opaque_tid(WID), lane = tid & 63, wave = tid >> 6;
  char* ws = p->ws;
  const u16* kvb = (const u16*)(ws + OFF_KVB);
  const float* peb = (const float*)(ws + OFF_PEB);
  u16* kc = (u16*)(ws + OFF_KC); u16* vct = (u16*)(ws + OFF_VCT);
  float* red = (float*)smem;
  float* hm = red + 8 * 2048;
  for (int task = BID; task < 510; task += gridDim.x) {
    int kvi = task / 255, tile = task % 255;
    const u16* w1t = (const u16*)(ws + OFF_W1T) + (size_t)kvi * 128 * 4096;
    int R = tile * 16 + (lane & 15);
    int b = R / 1020, rem = R % 1020, n = rem >> 2, g = rem & 3;
    const u16* arow = kvb + (size_t)(b * 4096 + 16 * n) * 3072 + kvi * 512 + g * 128;
    f32x4 acc[8] = {};
#pragma unroll 4
    for (int ks = 0; ks < 16; ks++) {
      int s = wave * 4 + (ks >> 2), d = (ks & 3) * 32 + (lane >> 4) * 8;
      bf16x8 af = *(const bf16x8*)&arow[(size_t)s * 3072 + d];
      int k = wave * 512 + ks * 32 + (lane >> 4) * 8;
#pragma unroll
      for (int nt = 0; nt < 8; nt++) {
        bf16x8 bfr = *(const bf16x8*)&w1t[(size_t)(nt * 16 + (lane & 15)) * 4096 + k];
        acc[nt] = __builtin_amdgcn_mfma_f32_16x16x32_bf16(af, bfr, acc[nt], 0, 0, 0);
      }
    }
#pragma unroll
    for (int nt = 0; nt < 8; nt++)
#pragma unroll
      for (int j = 0; j < 4; j++) red[wave * 2048 + ((lane >> 4) * 4 + j) * 128 + nt * 16 + (lane & 15)] = acc[nt][j];
    __syncthreads();
    for (int i = tid; i < 2048; i += 512) {
      float s = 0;
#pragma unroll
      for (int w = 0; w < 8; w++) s += red[w * 2048 + i];
      hm[i] = gelu_tanh(s + peb[kvi * 128 + (i & 127)]);
    }
    __syncthreads();
    {
      int r = tid >> 5, c0 = (tid & 31) * 4;
      const float* w2 = p->cmp_w2 + (size_t)kvi * 128 * 128;
      float4 o = *(const float4*)&p->cmp_b2[kvi * 128 + c0];
#pragma unroll 16
      for (int k = 0; k < 128; k++) {
        float hv = hm[r * 128 + k];
        float4 w = *(const float4*)&w2[k * 128 + c0];
        o.x += hv * w.x; o.y += hv * w.y; o.z += hv * w.z; o.w += hv * w.w;
      }
      int R2 = tile * 16 + r;
      int b2 = R2 / 1020, rem2 = R2 % 1020, n2 = rem2 >> 2, g2 = rem2 & 3;
      if (kvi == 0) {
        u16* dst = kc + ((size_t)((b2 * 4 + g2) * 256 + n2)) * 128 + c0;
        uint2 pk;
        pk.x = (unsigned)f2bf(o.x) | ((unsigned)f2bf(o.y) << 16);
        pk.y = (unsigned)f2bf(o.z) | ((unsigned)f2bf(o.w) << 16);
        *(uint2*)dst = pk;
      } else {
        u16* dst = vct + ((size_t)((b2 * 4 + g2) * 128 + c0)) * 256 + n2;
        dst[0] = f2bf(o.x); dst[256] = f2bf(o.y); dst[512] = f2bf(o.z); dst[768] = f2bf(o.w);
      }
    }
    __syncthreads();
  }
}

__device__ __forceinline__ float quad_sum(float v) {
  float a = v + __int_as_float(__builtin_amdgcn_update_dpp(0, __float_as_int(v), 0xB1, 0xF, 0xF, false));
  return a + __int_as_float(__builtin_amdgcn_update_dpp(0, __float_as_int(a), 0x4E, 0xF, 0xF, false));
}

DEVFN void phase_n2(const int WID, PP p) {
  const int BID = opaque_bid();
  const int tid = opaque_tid(WID), lane = tid & 63, wave = tid >> 6;
  char* ws = p->ws;
  const u16* q = (const u16*)(ws + OFF_Q);
  const u16* kc = (const u16*)(ws + OFF_KC); const u16* vct = (const u16*)(ws + OFF_VCT);
  u16* sz3 = (u16*)(ws + OFF_SZ3);
  const float* gates = (const float*)(ws + OFF_GATES);
  u64* selm = (u64*)(ws + OFF_SELM);
  char* Kl = smem;
  char* Vl = smem + 69632;
  float* psl = (float*)(smem + 137216) + wave * 256;
  const int l15 = lane & 15, l4 = lane >> 4;
  for (int task = BID; task < 256; task += gridDim.x) {
    const int bg = task >> 4, rr = task & 15;
    const int b = bg >> 2, g = bg & 3;
    const int thi = (31 - rr) * 128;
    const int NTb = min(16, (((thi + 127 - 31) >> 4) + 1 + 15) >> 4);
    __syncthreads();
    for (int ci = tid; ci < ((NTb + 1) & ~1) * 256; ci += 512) {
      int row = ci >> 4, c16 = ci & 15;
      *(uint4*)(Kl + row * 272 + c16 * 16) = *(const uint4*)&kc[((size_t)bg * 256 + row) * 128 + c16 * 8];
    }
    {
      const int cpr = ((NTb + 1) >> 1) * 4;
      for (int ci = tid; ci < 128 * cpr; ci += 512) {
        int row = ci / cpr, ch = ci - row * cpr;
        *(uint4*)(Vl + row * 528 + ch * 16) = *(const uint4*)&vct[((size_t)bg * 128 + row) * 256 + ch * 8];
      }
    }
    __syncthreads();
    const int head = g * 4 + (l15 & 3);
    bf16x8 Qf[4];
    {
      const int tl0 = thi + wave * 16 + (l15 >> 2);
#pragma unroll
      for (int kk = 0; kk < 4; kk++)
        Qf[kk] = *(const bf16x8*)&q[(size_t)(b * 4096 + tl0) * 2048 + head * 128 + kk * 32 + l4 * 8];
    }
#pragma unroll 1
    for (int it = 0; it < 8; it++) {
      const int t0 = ((it < 4) ? thi : rr * 128) + wave * 16 + (it & 3) * 4;
      const int tl = t0 + (l15 >> 2);
      const int tmax = t0 + 3;
      const int nvmax = (tmax >= 31) ? ((tmax - 31) >> 4) + 1 : 0;
      const int NT = (nvmax + 15) >> 4;
      const int nvalid = (tl >= 31) ? ((tl - 31) >> 4) + 1 : 0;
      f32x4 S[16];
#pragma unroll
      for (int kt = 0; kt < 16; kt++) S[kt] = f32x4{0.f, 0.f, 0.f, 0.f};
#pragma unroll
      for (int kp = 0; kp < 8; kp++) {
        if (2 * kp < NT) {
          bf16x8 kf[2][4];
#pragma unroll
          for (int h = 0; h < 2; h++)
#pragma unroll
            for (int kk = 0; kk < 4; kk++)
              kf[h][kk] = *(const bf16x8*)(Kl + ((2 * kp + h) * 16 + l15) * 272 + (kk * 32 + l4 * 8) * 2);
          asm volatile("" ::: "memory");
#pragma unroll
          for (int kk = 0; kk < 4; kk++)
#pragma unroll
            for (int h = 0; h < 2; h++)
              S[2 * kp + h] = __builtin_amdgcn_mfma_f32_16x16x32_bf16(kf[h][kk], Qf[kk], S[2 * kp + h], 0, 0, 0);
        }
      }
      {
        const int itn = (it < 7) ? it + 1 : 7;
        const int tln = ((itn < 4) ? thi : rr * 128) + wave * 16 + (itn & 3) * 4 + (l15 >> 2);
#pragma unroll
        for (int kk = 0; kk < 4; kk++)
          Qf[kk] = *(const bf16x8*)&q[(size_t)(b * 4096 + tln) * 2048 + head * 128 + kk * 32 + l4 * 8];
      }
      float mx = -1e30f;
#pragma unroll
      for (int kt = 0; kt < 16; kt++)
#pragma unroll
        for (int j = 0; j < 4; j++) { bool ok = (kt * 16 + l4 * 4 + j) < nvalid; mx = fmaxf(mx, ok ? S[kt][j] : -1e30f); }
      mx = fmaxf(mx, shx(mx, 16, lane));
      mx = fmaxf(mx, shx(mx, 32, lane));
      float sm = 0.f;
#pragma unroll
      for (int kt = 0; kt < 16; kt++)
#pragma unroll
        for (int j = 0; j < 4; j++) {
          bool ok = (kt * 16 + l4 * 4 + j) < nvalid;
          float e = ok ? __builtin_amdgcn_exp2f(S[kt][j] - mx) : 0.f; S[kt][j] = e; sm += e;
        }
      sm += shx(sm, 16, lane);
      sm += shx(sm, 32, lane);
      const float inv = (sm > 0.f) ? 1.f / sm : 0.f;
#pragma unroll
      for (int kt = 0; kt < 16; kt++)
#pragma unroll
        for (int j = 0; j < 4; j++) S[kt][j] *= inv;
      {
        float v3q[16], wq[16];
#pragma unroll
        for (int kt = 0; kt < 16; kt++) {
          wq[kt] = quad_sum(2.f * (S[kt][0] + S[kt][1] + S[kt][2]) + S[kt][3]);
          v3q[kt] = quad_sum(S[kt][3]);
        }
        const int srcl = (l4 > 0) ? lane - 16 : lane + 48;
#pragma unroll
        for (int kt = 0; kt < 16; kt++) {
          float pub = (l4 == 3) ? ((kt > 0) ? v3q[kt > 0 ? kt - 1 : 0] : 0.f) : v3q[kt];
          float prev = __int_as_float(__builtin_amdgcn_ds_bpermute(srcl << 2, __float_as_int(pub)));
          if ((l15 & 3) == 0) psl[(l15 >> 2) * 64 + kt * 4 + l4] = wq[kt] + prev;
        }
      }
      f32x4 O[8];
#pragma unroll
      for (int dt = 0; dt < 8; dt++) O[dt] = f32x4{0.f, 0.f, 0.f, 0.f};
      const int nks = (NT + 1) >> 1;
      const size_t tok = (size_t)(b * 4096 + tl);
      const float gate = gates[tok * 48 + head];
      uint2 zz[8];
#pragma unroll
      for (int dt = 0; dt < 8; dt++) zz[dt] = *(const uint2*)&sz3[tok * 6144 + head * 128 + dt * 16 + l4 * 4];
#pragma unroll
      for (int ks = 0; ks < 8; ks++) {
        if (ks < nks) {
          bf16x8 pf = mk8(pk_bf16(S[2 * ks][0], S[2 * ks][1]), pk_bf16(S[2 * ks][2], S[2 * ks][3]),
                          pk_bf16(S[2 * ks + 1][0], S[2 * ks + 1][1]), pk_bf16(S[2 * ks + 1][2], S[2 * ks + 1][3]));
          bf16x8 vf[8];
#pragma unroll
          for (int dt = 0; dt < 8; dt++) {
            const char* vrow = Vl + (dt * 16 + l15) * 528 + (ks * 32 + l4 * 4) * 2;
            uint2 h0 = *(const uint2*)(vrow);
            uint2 h1 = *(const uint2*)(vrow + 32);
            vf[dt] = mk8(h0.x, h0.y, h1.x, h1.y);
          }
          asm volatile("" ::: "memory");
#pragma unroll
          for (int dt = 0; dt < 8; dt++) O[dt] = __builtin_amdgcn_mfma_f32_16x16x32_bf16(vf[dt], pf, O[dt], 0, 0, 0);
        }
      }
      {
#pragma unroll
        for (int dt = 0; dt < 8; dt++) {
          size_t zi = tok * 6144 + head * 128 + dt * 16 + l4 * 4;
          uint2 o;
          o.x = pk_bf16(O[dt][0] * gate * __uint_as_float(zz[dt].x << 16), O[dt][1] * gate * __uint_as_float(zz[dt].x & 0xffff0000u));
          o.y = pk_bf16(O[dt][2] * gate * __uint_as_float(zz[dt].y << 16), O[dt][3] * gate * __uint_as_float(zz[dt].y & 0xffff0000u));
          *(uint2*)&sz3[zi] = o;
        }
      }
      __builtin_amdgcn_fence(__ATOMIC_SEQ_CST, "wavefront");
      __builtin_amdgcn_wave_barrier();
#pragma unroll 1
      for (int tk = 0; tk < 4; tk++) {
        int t = t0 + tk, cur = t >> 6;
        float pslv = psl[tk * 64 + lane];
        bool valid = lane <= cur;
        bool forced = (lane == 0) || (lane == cur) || (lane == cur - 1);
        float key = valid ? (forced ? 3e38f : pslv) : -1.f;
        int cnt = 0;
#pragma unroll 4
        for (int jp = 0; jp < 64; jp++) {
          float kp = __int_as_float(__builtin_amdgcn_readlane(__float_as_int(key), jp));
          cnt += ((kp > key) || (kp == key && jp < lane)) ? 1 : 0;
        }
        bool sel = valid && (cnt < 16);
        u64 m = __ballot(sel);
        if (lane == 0) selm[(size_t)bg * 4096 + t] = m;
      }
      __builtin_amdgcn_fence(__ATOMIC_SEQ_CST, "wavefront");
      __builtin_amdgcn_wave_barrier();
    }
  }
}


DEVFN void phase_gates(const int WID, PP p, int j) {
  const int BID = opaque_bid();
  const int tid = opaque_tid(WID), lane = tid & 63, wave = tid >> 6;
  char* ws = p->ws;
  const u16* h = (const u16*)(ws + OFF_HBUF);
  const u16* wg = (const u16*)(ws + OFF_WT_QG) + (size_t)j * 8448 * 2048 + (size_t)8192 * 2048;
  float* gates = (float*)(ws + OFF_GATES);
  float* red = (float*)smem;
  const int l15 = lane & 15, l4 = lane >> 4;
  const int mt = wave & 3, kh = wave >> 2;
  for (int bt = BID; bt < 256; bt += gridDim.x) {
    const int row0 = bt * 64 + mt * 16;
    f32x4 acc[3];
#pragma unroll
    for (int nt = 0; nt < 3; nt++) acc[nt] = f32x4{0.f, 0.f, 0.f, 0.f};
    const u16* ap = h + (size_t)(row0 + l15) * 2048 + kh * 1024 + l4 * 8;
    const u16* bp = wg + (size_t)l15 * 2048 + kh * 1024 + l4 * 8;
#pragma unroll 8
    for (int ks = 0; ks < 32; ks++) {
      bf16x8 af = *(const bf16x8*)&ap[ks * 32];
#pragma unroll
      for (int nt = 0; nt < 3; nt++) {
        bf16x8 bfr = *(const bf16x8*)&bp[(size_t)nt * 16 * 2048 + ks * 32];
        acc[nt] = __builtin_amdgcn_mfma_f32_16x16x32_bf16(af, bfr, acc[nt], 0, 0, 0);
      }
    }
    __syncthreads();
    if (kh == 1) {
#pragma unroll
      for (int nt = 0; nt < 3; nt++)
#pragma unroll
        for (int jj = 0; jj < 4; jj++) red[(mt * 16 + l4 * 4 + jj) * 48 + nt * 16 + l15] = acc[nt][jj];
    }
    __syncthreads();
    if (kh == 0) {
#pragma unroll
      for (int nt = 0; nt < 3; nt++)
#pragma unroll
        for (int jj = 0; jj < 4; jj++) {
          float v = acc[nt][jj] + red[(mt * 16 + l4 * 4 + jj) * 48 + nt * 16 + l15];
          gates[(size_t)(row0 + l4 * 4 + jj) * 48 + nt * 16 + l15] = sigmoidf_(v);
        }
    }
  }
}


DEVFN void phase_n3(const int WID, PP p) {
  const int BID = opaque_bid();
  const int tid = opaque_tid(WID), lane = tid & 63, wave = tid >> 6;
  char* ws = p->ws;
  const u16* q = (const u16*)(ws + OFF_Q);
  const u16* kvb = (const u16*)(ws + OFF_KVB);
  const u16* vt = (const u16*)(ws + OFF_VT);
  u16* sz3 = (u16*)(ws + OFF_SZ3);
  u16* ocomb = (u16*)(ws + OFF_HBUF);
  const float* gates = (const float*)(ws + OFF_GATES);
  const u64* selm = (const u64*)(ws + OFF_SELM);
  char* Ks = smem;
  char* Vs = smem + 32768;
  char* Qs = smem + 65536 + wave * 8704;
  const unsigned lds0 = (unsigned)(unsigned long)(__attribute__((address_space(3))) char*)smem;
  const int l15 = lane & 15, l4 = lane >> 4;
  unsigned koff[2], voff[2];
#pragma unroll
  for (int i = 0; i < 2; i++) {
    int slab = i * 8 + wave;
    int rk = slab * 4 + (lane >> 4), ck = (lane & 15) ^ (rk & 15);
    koff[i] = (unsigned)(rk * 3072 + ck * 8) * 2u;
    int rv = slab * 8 + (lane >> 3), cv = (lane & 7) ^ ((rv >> 1) & 7);
    voff[i] = (unsigned)(rv * 4096 + cv * 8) * 2u;
  }
  const unsigned slab0 = (unsigned)__builtin_amdgcn_readfirstlane(wave * 1024);
#define N3_DMA(voffv, sbase, ldsa) asm volatile("s_mov_b32 m0, %2\n\ts_nop 0\n\tglobal_load_lds_dwordx4 %0, %1" :: "v"(voffv), "s"(sbase), "s"(ldsa) : "memory")
  int kofs[4], vofs[4];
#pragma unroll
  for (int kk = 0; kk < 4; kk++) kofs[kk] = l15 * 256 + (((kk * 4 + l4) ^ l15) & 15) * 16;
#pragma unroll
  for (int c = 0; c < 4; c++) {
    int logical = (c >> 1) * 4 + (l4 >> 1) + (c & 1) * 2;
    vofs[c] = l15 * 128 + ((logical ^ ((l15 >> 1) & 7)) & 7) * 16 + (l4 & 1) * 8;
  }
  const int qofs = l15 * 272 + l4 * 16;
  for (int task = BID; task < 512; task += gridDim.x) {
    int bg = task >> 5, pp = task & 31; int b = bg >> 2, g = bg & 3;
#pragma unroll 1
    for (int half = 0; half < 2; half++) {
      int cur = half ? pp : 63 - pp;
      int tq0 = cur * 64 + wave * 8;
#pragma unroll
      for (int i = 0; i < 8; i++) {
        int ci = lane + 64 * i; int row = ci >> 4, c16 = ci & 15;
        uint4 v = *(const uint4*)&q[(size_t)(b * 4096 + tq0 + (row >> 2)) * 2048 + (g * 4 + (row & 3)) * 128 + c16 * 8];
        *(uint4*)(Qs + row * 272 + c16 * 16) = v;
      }
      __builtin_amdgcn_fence(__ATOMIC_SEQ_CST, "wavefront");
      __builtin_amdgcn_wave_barrier();
      int tokL[2]; u64 sm_[2];
#pragma unroll
      for (int mt = 0; mt < 2; mt++) { tokL[mt] = tq0 + mt * 4 + (l15 >> 2); sm_[mt] = selm[(size_t)bg * 4096 + tokL[mt]]; }
      u64 wm = 0;
#pragma unroll
      for (int i = 0; i < 8; i++) wm |= selm[(size_t)bg * 4096 + tq0 + i];
      const int head = g * 4 + (l15 & 3);
#pragma unroll 1
      for (int mode = 0; mode < 2; mode++) {
        int jb0 = (mode == 0) ? 0 : max(0, cur - 8);
        int ntile = cur - jb0 + 1;
        int kbr = (mode == 0) ? 2 : 4;
        const u16* kbase = kvb + (size_t)b * 4096 * 3072 + kbr * 512 + g * 128;
        const u16* vbase = vt + (size_t)((mode * 4 + b) * 4 + g) * 128 * 4096;
        f32x4 O[8][2];
        float mrow[2], ls[2];
#pragma unroll
        for (int mt = 0; mt < 2; mt++) {
#pragma unroll
          for (int dt = 0; dt < 8; dt++) O[dt][mt] = f32x4{0.f, 0.f, 0.f, 0.f};
          mrow[mt] = -1e30f; ls[mt] = 0.f;
        }
        __syncthreads();
        {
          const char* kb_ = (const char*)(kbase + (size_t)jb0 * 64 * 3072);
          const char* vb_ = (const char*)(vbase + (size_t)jb0 * 64);
          N3_DMA(koff[0], kb_, lds0 + slab0);
          N3_DMA(koff[1], kb_, lds0 + slab0 + 8192u);
          N3_DMA(voff[0], vb_, lds0 + 32768u + slab0);
          N3_DMA(voff[1], vb_, lds0 + 32768u + slab0 + 8192u);
        }
        asm volatile("s_waitcnt vmcnt(0)" ::: "memory");
        __syncthreads();
        for (int it = 0; it < ntile; it++) {
          int jb = jb0 + it;
          const int jn = (it + 1 < ntile) ? jb + 1 : jb;
          {
            const unsigned nb = (unsigned)((it + 1) & 1) * 16384u;
            const char* kb_ = (const char*)(kbase + (size_t)jn * 64 * 3072);
            const char* vb_ = (const char*)(vbase + (size_t)jn * 64);
            N3_DMA(koff[0], kb_, lds0 + nb + slab0);
            N3_DMA(koff[1], kb_, lds0 + nb + slab0 + 8192u);
            N3_DMA(voff[0], vb_, lds0 + 32768u + nb + slab0);
            N3_DMA(voff[1], vb_, lds0 + 32768u + nb + slab0 + 8192u);
          }
          const char* Kc = Ks + (it & 1) * 16384;
          const char* Vc = Vs + (it & 1) * 16384;
          bool act = (mode == 1) || ((wm >> jb) & 1ull);
          if (act) {
            f32x4 S[4][2];
#pragma unroll
            for (int nt = 0; nt < 4; nt++)
#pragma unroll
              for (int mt = 0; mt < 2; mt++) S[nt][mt] = f32x4{0.f, 0.f, 0.f, 0.f};
#define N3_LOADKQ(kk, qf, kf) do { \
              _Pragma("unroll") for (int mt = 0; mt < 2; mt++) qf[mt] = *(const bf16x8*)(Qs + qofs + mt * 4352 + (kk) * 64); \
              _Pragma("unroll") for (int nt = 0; nt < 4; nt++) kf[nt] = *(const bf16x8*)(Kc + kofs[kk] + nt * 4096); } while (0)
#define N3_MMAS(qf, kf) do { \
              _Pragma("unroll") for (int nt = 0; nt < 4; nt++) \
              _Pragma("unroll") for (int mt = 0; mt < 2; mt++) S[nt][mt] = __builtin_amdgcn_mfma_f32_16x16x32_bf16(kf[nt], qf[mt], S[nt][mt], 0, 0, 0); } while (0)
#define CBAR asm volatile("" ::: "memory")
            {
              bf16x8 qa[2], ka[4], qb[2], kb[4];
              N3_LOADKQ(0, qa, ka); CBAR;
              N3_LOADKQ(1, qb, kb); CBAR;
              N3_MMAS(qa, ka);
              N3_LOADKQ(2, qa, ka); CBAR;
              N3_MMAS(qb, kb);
              N3_LOADKQ(3, qb, kb); CBAR;
              N3_MMAS(qa, ka);
              N3_MMAS(qb, kb);
            }
            const bool interior = (mode == 0) ? (jb < cur) : (jb < cur && jb > cur - 8);
            bf16x8 Pf[2][2];
            float alpha[2];
#pragma unroll
            for (int mt = 0; mt < 2; mt++) {
              const bool rowok = (mode == 1) || ((sm_[mt] >> jb) & 1ull);
              const int tt = tokL[mt];
              float mx = -1e30f;
              float psum = 0.f;
              if (interior) {
#pragma unroll
                for (int nt = 0; nt < 4; nt++)
#pragma unroll
                  for (int j = 0; j < 4; j++) mx = fmaxf(mx, S[nt][mt][j]);
                mx = rowok ? mx : -1e30f;
                mx = fmaxf(mx, shx(mx, 16, lane));
                mx = fmaxf(mx, shx(mx, 32, lane));
                float mnew = fmaxf(mrow[mt], mx);
                alpha[mt] = __builtin_amdgcn_exp2f(mrow[mt] - mnew);
                mrow[mt] = mnew;
                const float msub = rowok ? mnew : 1e30f;
#pragma unroll
                for (int nt = 0; nt < 4; nt++)
#pragma unroll
                  for (int j = 0; j < 4; j++) { float pv = __builtin_amdgcn_exp2f(S[nt][mt][j] - msub); S[nt][mt][j] = pv; psum += pv; }
              } else {
#pragma unroll
                for (int nt = 0; nt < 4; nt++)
#pragma unroll
                  for (int j = 0; j < 4; j++) {
                    int kp = jb * 64 + nt * 16 + l4 * 4 + j;
                    bool ok = rowok && (kp <= tt) && ((mode == 0) || (kp + 512 > tt));
                    float sv = ok ? S[nt][mt][j] : -1e30f; S[nt][mt][j] = sv; mx = fmaxf(mx, sv);
                  }
                mx = fmaxf(mx, shx(mx, 16, lane));
                mx = fmaxf(mx, shx(mx, 32, lane));
                float mnew = fmaxf(mrow[mt], mx);
                alpha[mt] = __builtin_amdgcn_exp2f(mrow[mt] - mnew);
                mrow[mt] = mnew;
#pragma unroll
                for (int nt = 0; nt < 4; nt++)
#pragma unroll
                  for (int j = 0; j < 4; j++) {
                    float sv = S[nt][mt][j];
                    float pv = (sv > -1e29f) ? __builtin_amdgcn_exp2f(sv - mnew) : 0.f;
                    S[nt][mt][j] = pv; psum += pv;
                  }
              }
              ls[mt] = ls[mt] * alpha[mt] + psum;
#pragma unroll
              for (int ks = 0; ks < 2; ks++) {
                Pf[mt][ks] = mk8(pk_bf16(S[2 * ks][mt][0], S[2 * ks][mt][1]), pk_bf16(S[2 * ks][mt][2], S[2 * ks][mt][3]),
                                 pk_bf16(S[2 * ks + 1][mt][0], S[2 * ks + 1][mt][1]), pk_bf16(S[2 * ks + 1][mt][2], S[2 * ks + 1][mt][3]));
              }
            }
            if (__builtin_amdgcn_ballot_w64((alpha[0] != 1.f) || (alpha[1] != 1.f)) != 0ull) {
#pragma unroll
              for (int mt = 0; mt < 2; mt++)
#pragma unroll
                for (int dt = 0; dt < 8; dt++)
#pragma unroll
                  for (int j = 0; j < 4; j++) O[dt][mt][j] *= alpha[mt];
            }
#define N3_LOADV(ks, d0, vf) do { \
              _Pragma("unroll") for (int dd = 0; dd < 4; dd++) { \
                uint2 h0 = *(const uint2*)(Vc + vofs[(ks) * 2] + ((d0) + dd) * 2048); uint2 h1 = *(const uint2*)(Vc + vofs[(ks) * 2 + 1] + ((d0) + dd) * 2048); \
                vf[dd] = mk8(h0.x, h0.y, h1.x, h1.y); } } while (0)
#define N3_MMAV(ks, d0, vf) do { \
              _Pragma("unroll") for (int dd = 0; dd < 4; dd++) \
              _Pragma("unroll") for (int mt = 0; mt < 2; mt++) O[(d0) + dd][mt] = __builtin_amdgcn_mfma_f32_16x16x32_bf16(vf[dd], Pf[mt][ks], O[(d0) + dd][mt], 0, 0, 0); } while (0)
            {
              bf16x8 va[4], vb[4];
              N3_LOADV(0, 0, va); CBAR;
              N3_LOADV(0, 4, vb); CBAR;
              N3_MMAV(0, 0, va);
              N3_LOADV(1, 0, va); CBAR;
              N3_MMAV(0, 4, vb);
              N3_LOADV(1, 4, vb); CBAR;
              N3_MMAV(1, 0, va);
              N3_MMAV(1, 4, vb);
            }
          }
          asm volatile("s_waitcnt vmcnt(0)" ::: "memory");
          __syncthreads();
        }
#pragma unroll
        for (int mt = 0; mt < 2; mt++) {
          size_t tok = (size_t)(b * 4096 + tokL[mt]);
          float l = ls[mt];
          l += shx(l, 16, lane);
          l += shx(l, 32, lane);
          float inv = (l > 0.f) ? 1.f / l : 0.f;
          float gate = gates[tok * 48 + (mode + 1) * 16 + head] * inv;
#pragma unroll
          for (int dt = 0; dt < 8; dt++) {
            int d0 = dt * 16 + l4 * 4;
            size_t zi = tok * 6144 + (size_t)(mode + 1) * 2048 + head * 128 + d0;
            uint2 zz = *(const uint2*)&sz3[zi];
            float v0 = O[dt][mt][0] * gate * __uint_as_float(zz.x << 16);
            float v1 = O[dt][mt][1] * gate * __uint_as_float(zz.x & 0xffff0000u);
            float v2 = O[dt][mt][2] * gate * __uint_as_float(zz.y << 16);
            float v3 = O[dt][mt][3] * gate * __uint_as_float(zz.y & 0xffff0000u);
            if (mode == 0) {
              uint2 o; o.x = pk_bf16(v0, v1); o.y = pk_bf16(v2, v3);
              *(uint2*)&ocomb[tok * 2048 + head * 128 + d0] = o;
            } else {
              uint2 c0 = *(const uint2*)&sz3[tok * 6144 + head * 128 + d0];
              uint2 c1 = *(const uint2*)&ocomb[tok * 2048 + head * 128 + d0];
              v0 += __uint_as_float(c0.x << 16) + __uint_as_float(c1.x << 16);
              v1 += __uint_as_float(c0.x & 0xffff0000u) + __uint_as_float(c1.x & 0xffff0000u);
              v2 += __uint_as_float(c0.y << 16) + __uint_as_float(c1.y << 16);
              v3 += __uint_as_float(c0.y & 0xffff0000u) + __uint_as_float(c1.y & 0xffff0000u);
              uint2 o; o.x = pk_bf16(v0, v1); o.y = pk_bf16(v2, v3);
              *(uint2*)&ocomb[tok * 2048 + head * 128 + d0] = o;
            }
          }
        }
      }
    }
  }
}

constexpr int N_PHASES = 27;

DEVFN void decode_phase(int ph, int& kind, int& arg) {
  arg = 0;
  if (ph == 0) kind = 0;
  else if (ph <= 14) { arg = (ph - 1) / 7; kind = 1 + (ph - 1) % 7; }
  else {
    switch (ph) {
      case 15: kind = 1; arg = 2; break;
      case 16: kind = 8; break;
      case 17: kind = 10; arg = 0; break;
      case 18: kind = 11; break;
      case 19: kind = 12; break;
      case 20: kind = 7; arg = 2; break;
      case 21: kind = 1; arg = 3; break;
      case 22: kind = 10; arg = 1; break;
      case 23: kind = 11; break;
      case 24: kind = 12; break;
      case 25: kind = 7; arg = 3; break;
      default: kind = 13; break;
    }
  }
}
static void decode_phase_host(int ph, int& kind, int& arg) {
  arg = 0;
  if (ph == 0) kind = 0;
  else if (ph <= 14) { arg = (ph - 1) / 7; kind = 1 + (ph - 1) % 7; }
  else {
    const int kk[12] = {1, 8, 10, 11, 12, 7, 1, 10, 11, 12, 7, 13};
    const int aa[12] = {2, 0, 0, 0, 0, 2, 3, 1, 0, 0, 3, 0};
    kind = kk[ph - 15]; arg = aa[ph - 15];
  }
}

template <int KIND>
DEVFN void run_kind(const int WID, PP p, int arg) {
  char* ws = p->ws;
  if constexpr (KIND == 0) phase_prep(WID, p);
  else if constexpr (KIND == 1) { phase_prenorm(WID, p, arg, arg == 2); if (arg < 2) phase_ssm_gen(WID, p, arg); if (arg == 2) phase_peb_final(WID, p); }
  else if constexpr (KIND == 2) gemm_phase<EPI_S1>(WID, p, (const u16*)(ws + OFF_HBUF), (const u16*)(ws + OFF_WT_IN) + (size_t)arg * 4096 * 2048, 4096, arg);
  else if constexpr (KIND == 3) phase_ssm_x1(WID, p, arg);
  else if constexpr (KIND == 4) phase_ssm_b(WID, p, arg);
  else if constexpr (KIND == 5) phase_ssm_x3(WID, p, arg);
  else if constexpr (KIND == 6) gemm_phase<EPI_S3>(WID, p, (const u16*)(ws + OFF_Y), (const u16*)(ws + OFF_WT_GLU) + (size_t)arg * 2048 * 2048, 2048, arg);
  else if constexpr (KIND == 7) {
    const u16* A = (arg < 2) ? (const u16*)(ws + OFF_V) : (const u16*)(ws + OFF_HBUF);
    const u16* B = (arg < 2) ? (const u16*)(ws + OFF_WT_OUT) + (size_t)arg * 2048 * 2048
                             : (const u16*)(ws + OFF_WT_O) + (size_t)(arg - 2) * 2048 * 2048;
    gemm_phase<EPI_RES>(WID, p, A, B, 2048, arg);
  }
  else if constexpr (KIND == 8) gemm_phase<EPI_KV>(WID, p, (const u16*)(ws + OFF_HKV), (const u16*)(ws + OFF_WT_KV), 3072, 0);
  else if constexpr (KIND == 9) { }
  else if constexpr (KIND == 10) {
    if (arg == 0) phase_compress(WID, p);
    __syncthreads();
    phase_gates(WID, p, arg);
    __syncthreads();
    gemm_phase<EPI_QG>(WID, p, (const u16*)(ws + OFF_HBUF), (const u16*)(ws + OFF_WT_QG) + (size_t)arg * 8448 * 2048, 8192, arg);
  }
  else if constexpr (KIND == 11) phase_n2(WID, p);
  else if constexpr (KIND == 12) phase_n3(WID, p);
  else phase_final(WID, p);
}


#define XB_TMO      128
#define XB_XCNT(j)  (256  + 64 * (j))
#define XB_XSUB(j)  (1280 + 64 * (j))
#define XB_XGEN(j)  (2304 + 64 * (j))
#define XB_TOP      3328
#define XB_TOPGEN   3392
#define XCD_BAR_WORDS 3456
#define XB_SPIN_CAP (1u << 20)
#define LAS __attribute__((address_space(3)))
__device__ __forceinline__ unsigned xb_ld(unsigned* p)              { return __hip_atomic_load(p, __ATOMIC_RELAXED, __HIP_MEMORY_SCOPE_AGENT); }
__device__ __forceinline__ unsigned xb_add(unsigned* p, unsigned v) { return __hip_atomic_fetch_add(p, v, __ATOMIC_RELAXED, __HIP_MEMORY_SCOPE_AGENT); }
__device__ __forceinline__ unsigned xb_xcc_id() { return (unsigned)__builtin_amdgcn_s_getreg((3 << 11) | 20) & 0xFu; }
#define XB_SPIN(cond, bar) do { unsigned _sp = 0; while (cond) { __builtin_amdgcn_s_sleep(1); \
    if ((++_sp & 255u) == 0u) { if (xb_ld(&(bar)[XB_TMO])) break; if (_sp > XB_SPIN_CAP) { atomicAdd(&(bar)[XB_TMO], 1u); break; } } } } while (0)
struct XcdBarrier { unsigned* bar; unsigned x; volatile LAS unsigned* st; };
__device__ __forceinline__ XcdBarrier xcd_barrier_post(unsigned* bar, volatile LAS unsigned* st) {
  XcdBarrier b; b.bar = bar; b.x = xb_xcc_id(); b.st = st;
  if (threadIdx.x == 0) (void)xb_add(&bar[XB_XCNT(b.x)], 1u);
  return b;
}
__device__ __forceinline__ void xcd_barrier_complete(unsigned* bar, unsigned x, unsigned& nloc, unsigned& nx) {
  const unsigned G = gridDim.x * gridDim.y * gridDim.z;
  unsigned sum, cnt, mine, sp = 0u;
  for (;;) {
    sum = 0u; cnt = 0u; mine = 0u;
#pragma unroll
    for (unsigned j = 0; j < 16; ++j) { const unsigned c = xb_ld(&bar[XB_XCNT(j)]); sum += c; cnt += (c > 0u) ? 1u : 0u; mine = (j == x) ? c : mine; }
    if (sum == G) break;
    __builtin_amdgcn_s_sleep(1);
    if ((++sp & 255u) == 0u) { if (xb_ld(&bar[XB_TMO])) break; if (sp > XB_SPIN_CAP) { atomicAdd(&bar[XB_TMO], 1u); break; } }
  }
  nloc = mine > 0u ? mine : 1u; nx = cnt > 0u ? cnt : 1u;
}
__device__ __forceinline__ void xcd_barrier(const XcdBarrier& b, const int WID) {
  asm volatile("s_waitcnt vmcnt(0)" ::: "memory");
  __syncthreads();
  if (opaque_tid(WID) == 0) {
    unsigned* bar = b.bar; asm volatile("" : "+s"(bar));
    __builtin_amdgcn_s_waitcnt(0);
    unsigned nloc = b.st[0], nx = b.st[1];
    if (nloc == 0u) { xcd_barrier_complete(bar, b.x, nloc, nx); b.st[0] = nloc; b.st[1] = nx; }
    const unsigned old = xb_add(&bar[XB_XSUB(b.x)], 1u);
    const unsigned gen = old / nloc;
    if (old + 1u == (gen + 1u) * nloc) {
      __builtin_amdgcn_fence(__ATOMIC_RELEASE, "agent");
      asm volatile("s_waitcnt vmcnt(0)" ::: "memory");
      const unsigned og = xb_add(&bar[XB_TOP], 1u);
      const unsigned tg = og / nx;
      if (og + 1u == (tg + 1u) * nx) xb_add(&bar[XB_TOPGEN], 1u);
      else XB_SPIN(xb_ld(&bar[XB_TOPGEN]) == tg, bar);
      __builtin_amdgcn_fence(__ATOMIC_ACQUIRE, "agent");
      xb_add(&bar[XB_XGEN(b.x)], 1u);
      asm volatile("s_waitcnt vmcnt(0)" ::: "memory");
    } else {
      XB_SPIN(xb_ld(&bar[XB_XGEN(b.x)]) == gen, bar);
      __builtin_amdgcn_fence(__ATOMIC_ACQUIRE, "agent");
      asm volatile("s_waitcnt vmcnt(0)" ::: "memory");
    }
  }
  __syncthreads();
}

#if ONE_LAUNCH
__global__ void __launch_bounds__(512) mega(Params pv, int lo, int hi) {
  cg::grid_group grid = cg::this_grid();
  PP pp = (PP)__builtin_amdgcn_kernarg_segment_ptr();
  const int WID = __builtin_amdgcn_readfirstlane((int)(threadIdx.x >> 6));
  __shared__ uint4 xb_words;
  if (threadIdx.x == 0) xb_words = make_uint4(0u, 0u, 0u, 0u);
  __syncthreads();
  XcdBarrier xb = xcd_barrier_post((unsigned*)(pp->ws + OFF_BAR), (volatile LAS unsigned*)&xb_words);
  for (int ph = lo; ph < hi; ph++) {
    PP p = opaque_pp(pp);
    int kind, arg;
    decode_phase(ph, kind, arg);
#if REPEAT_MASK
    for (int rep = 0; rep < (((REPEAT_MASK >> kind) & 1) ? 2 : 1); rep++) {
    if (rep) xcd_barrier(xb, WID);
#endif
    switch (kind) {
      case 0: run_kind<0>(WID, p, arg); break;
      case 1: run_kind<1>(WID, p, arg); break;
      case 2: run_kind<2>(WID, p, arg); break;
      case 3: run_kind<3>(WID, p, arg); break;
      case 4: run_kind<4>(WID, p, arg); break;
      case 5: run_kind<5>(WID, p, arg); break;
      case 6: run_kind<6>(WID, p, arg); break;
      case 7: run_kind<7>(WID, p, arg); break;
      case 8: run_kind<8>(WID, p, arg); break;
      case 9: run_kind<9>(WID, p, arg); break;
      case 10: run_kind<10>(WID, p, arg); break;
      case 11: run_kind<11>(WID, p, arg); break;
      case 12: run_kind<12>(WID, p, arg); break;
      default: run_kind<13>(WID, p, arg); break;
    }
#if REPEAT_MASK
    }
#endif
    if (ph + 1 < hi) {
      if (hi > 1000) grid.sync();
      xcd_barrier(xb, WID);
    }
  }
}
#else
template <int KIND>
__global__ void __launch_bounds__(512) pk(Params pv, int arg) {
  PP p = opaque_pp((PP)__builtin_amdgcn_kernarg_segment_ptr());
  const int WID = __builtin_amdgcn_readfirstlane((int)(threadIdx.x >> 6));
  run_kind<KIND>(WID, p, arg);
}
template <int KIND>
static void launch_kind(const Params& p, int arg, int grid, hipStream_t stream) {
  static bool attr_set = false;
  if (!attr_set) { (void)hipFuncSetAttribute((const void*)pk<KIND>, hipFuncAttributeMaxDynamicSharedMemorySize, LDS_BYTES); attr_set = true; }
  hipLaunchKernelGGL(pk<KIND>, dim3(grid), dim3(512), LDS_BYTES, stream, p, arg);
}
#endif

extern "C" void kernel_launch(void* const* d_in, const int* in_sizes, int n_in, void* d_out, int out_size, void* d_ws,
                              size_t ws_size, hipStream_t stream) {
  Params p{};
  const float** f = (const float**)&p;
  for (int i = 0; i < 29; i++) f[i] = (const float*)d_in[i];
  p.out = (float*)d_out;
  p.ws = (char*)d_ws;
#if ONE_LAUNCH
  static int grid_blocks = 0;
  if (!grid_blocks) {
    (void)hipFuncSetAttribute((const void*)mega, hipFuncAttributeMaxDynamicSharedMemorySize, LDS_BYTES);
    int dev = 0, cus = 0, per_cu = 0;
    (void)hipGetDevice(&dev);
    (void)hipDeviceGetAttribute(&cus, hipDeviceAttributeMultiprocessorCount, dev);
    (void)hipOccupancyMaxActiveBlocksPerMultiprocessor(&per_cu, mega, 512, LDS_BYTES);
    if (per_cu < 1) per_cu = 1;
    grid_blocks = cus * per_cu;
    if (ws_size < WS_NEEDED) fprintf(stderr, "workspace too small: %zu < %zu\n", ws_size, (size_t)WS_NEEDED);
  }
  (void)hipMemsetAsync((char*)d_ws + OFF_BAR, 0, 16384, stream);
  int lo = 0, hi = N_PHASES;
  void* args[] = {&p, &lo, &hi};
  hipError_t e = hipLaunchCooperativeKernel((void*)mega, dim3(grid_blocks), dim3(512), args, LDS_BYTES, stream);
  if (e != hipSuccess) fprintf(stderr, "cooperative launch failed: %s (grid %d)\n", hipGetErrorString(e), grid_blocks);
#else
  const int grid = 256;
  for (int ph = 0; ph < N_PHASES; ph++) {
    int kind, arg;
    decode_phase_host(ph, kind, arg);
    for (int rep = 0; rep < (((REPEAT_MASK >> kind) & 1) ? 2 : 1); rep++)
    switch (kind) {
      case 0: launch_kind<0>(p, arg, grid, stream); break;
      case 1: launch_kind<1>(p, arg, grid, stream); break;
      case 2: launch_kind<2>(p, arg, grid, stream); break;
      case 3: launch_kind<3>(p, arg, grid, stream); break;
      case 4: launch_kind<4>(p, arg, grid, stream); break;
      case 5: launch_kind<5>(p, arg, grid, stream); break;
      case 6: launch_kind<6>(p, arg, grid, stream); break;
      case 7: launch_kind<7>(p, arg, grid, stream); break;
      case 8: launch_kind<8>(p, arg, grid, stream); break;
      case 9: launch_kind<9>(p, arg, grid, stream); break;
      case 10: launch_kind<10>(p, arg, grid, stream); break;
      case 11: launch_kind<11>(p, arg, grid, stream); break;
      case 12: launch_kind<12>(p, arg, grid, stream); break;
      default: launch_kind<13>(p, arg, grid, stream); break;
    }
  }
#endif
}
```

```cpp
#include <hip/hip_runtime.h>
#include <hip/hip_bf16.h>
#include <hip/hip_cooperative_groups.h>
#include <cstdio>
namespace cg = cooperative_groups;

typedef unsigned short u16;
typedef unsigned long long u64;
using bf16x8 = __attribute__((ext_vector_type(8))) short;
using f32x4 = __attribute__((ext_vector_type(4))) float;

#ifndef ONE_LAUNCH
#define ONE_LAUNCH 1
#endif
#ifndef REPEAT_MASK
#define REPEAT_MASK 0
#endif

constexpr int T_ = 16384, L_ = 4096, D_ = 2048;
constexpr size_t MB = 1ull << 20;
constexpr size_t OFF_WT_IN = 0;
constexpr size_t OFF_WT_GLU = 32 * MB;
constexpr size_t OFF_WT_OUT = 48 * MB;
constexpr size_t OFF_WT_KV = 64 * MB;
constexpr size_t OFF_WT_QG = 76 * MB;
constexpr size_t OFF_WT_O = 142 * MB;
constexpr size_t OFF_W1T = 158 * MB;
constexpr size_t OFF_SMALL = 160 * MB;
constexpr size_t OFF_MODV = OFF_SMALL;
constexpr size_t OFF_KVMOD = OFF_SMALL + 512 * 1024;
constexpr size_t OFF_ABAR = OFF_SMALL + 1 * MB;
constexpr size_t OFF_AQ = OFF_ABAR + 256 * 1024;
constexpr size_t OFF_PEB = OFF_AQ + 256 * 1024;
constexpr size_t OFF_PEBP = OFF_SMALL + 6 * MB;
constexpr size_t OFF_BBRE = OFF_SMALL + 2 * MB;
constexpr size_t OFF_BBIM = OFF_SMALL + 3 * MB;
constexpr size_t OFF_BAR = OFF_SMALL + 5 * MB;
constexpr size_t OFF_KC = 168 * MB;
constexpr size_t OFF_VCT = 169 * MB;
constexpr size_t OFF_SELM = 170 * MB;
constexpr size_t OFF_XBUF = 172 * MB;
constexpr size_t OFF_HBUF = 300 * MB;
constexpr size_t OFF_R = 364 * MB;
constexpr size_t OFF_UZ = OFF_R;
constexpr size_t OFF_Y = OFF_R + 128 * MB;
constexpr size_t OFF_V = OFF_R + 192 * MB;
constexpr size_t OFF_ST = OFF_R + 256 * MB;
constexpr size_t OFF_SSM_KT = OFF_R + 272 * MB;
constexpr size_t OFF_SSM_W1 = OFF_R + 276 * MB;
constexpr size_t OFF_SSM_W2 = OFF_R + 308 * MB;
constexpr size_t OFF_SSM_XP = OFF_R + 340 * MB;
constexpr size_t OFF_KVB = OFF_R;
constexpr size_t OFF_VT = OFF_R + 96 * MB;
constexpr size_t OFF_Q = OFF_R + 128 * MB;
constexpr size_t OFF_SZ3 = OFF_R + 192 * MB;
constexpr size_t OFF_HKV = OFF_SZ3;
constexpr size_t OFF_GATES = OFF_R + 384 * MB;
constexpr size_t WS_NEEDED = OFF_GATES + 4 * MB;

constexpr int LDS_BYTES = 145408;

struct Params {
  const float *x, *c, *norm_g, *mod_w, *mod_b, *w_in, *lam_re, *lam_im, *log_step, *b_re, *b_im, *c_re, *c_im,
      *dskip, *w_glu, *b_glu, *w_out, *kv_norm_g, *kv_mod_w, *kv_mod_b, *w_kv, *cmp_pe, *cmp_w1, *cmp_b1, *cmp_w2,
      *cmp_b2, *w_qg, *w_o, *final_g;
  float* out;
  char* ws;
};

typedef const __attribute__((address_space(4))) Params* PP;
#define DEVFN __device__ __attribute__((always_inline)) inline

extern __shared__ __attribute__((aligned(16))) char smem[];
__device__ __forceinline__ int opaque_tid(int wid) { unsigned z = 0; asm volatile("" : "+v"(z)); return wid * 64 + (int)__builtin_amdgcn_mbcnt_hi(~0u, __builtin_amdgcn_mbcnt_lo(~0u, z)); }
__device__ __forceinline__ int opaque_bid() { int v = blockIdx.x; asm volatile("" : "+s"(v)); return v; }
__device__ __forceinline__ float shx(float v, int mask, int lane) {
  return __int_as_float(__builtin_amdgcn_ds_bpermute((lane ^ mask) << 2, __float_as_int(v)));
}
__device__ __forceinline__ PP opaque_pp(PP p) { asm volatile("" : "+s"(p)); return p; }

__device__ __forceinline__ u16 f2bf(float f) {
  unsigned u = __float_as_uint(f);
  u += 0x7fffu + ((u >> 16) & 1u);
  return (u16)(u >> 16);
}
__device__ __forceinline__ unsigned pk_bf16(float lo, float hi) {
  unsigned r; asm("v_cvt_pk_bf16_f32 %0, %1, %2" : "=v"(r) : "v"(lo), "v"(hi)); return r;
}
typedef unsigned u32x4 __attribute__((ext_vector_type(4)));
__device__ __forceinline__ bf16x8 mk8(unsigned a, unsigned b, unsigned c, unsigned d) { u32x4 t = {a, b, c, d}; return __builtin_bit_cast(bf16x8, t); }
__device__ __forceinline__ float bf2f(u16 h) { return __uint_as_float(((unsigned)h) << 16); }
__device__ __forceinline__ float sigmoidf_(float x) { return 1.f / (1.f + __expf(-x)); }
__device__ __forceinline__ float siluf_(float x) { return x / (1.f + __expf(-x)); }
__device__ __forceinline__ float gelu_tanh(float x) {
  float u2 = 1.5957691216057308f * (x + 0.044715f * x * x * x);
  return x / (1.f + __expf(-u2));
}
__device__ __forceinline__ float wave_sum(float v, int lane) {
#pragma unroll
  for (int o = 32; o > 0; o >>= 1) v += shx(v, o, lane);
  return v;
}

DEVFN void xpose(const int WID, const float* __restrict__ src, u16* __restrict__ dst, int K, int Nsrc, int Ndst, int mode) {
  const int BID = opaque_bid();
  float* tile = (float*)smem;
  const int tid = opaque_tid(WID);
  const int tilesK = K / 64, nt = (Ndst / 64) * tilesK;
  const int kr = tid >> 4, nc = (tid & 15) * 4;
  const int n = tid >> 3, kc = (tid & 7) * 8;
  int t = BID;
  if (t >= nt) return;
  float4 cur0, cur1;
  {
    int tn = t / tilesK, tk = t - tn * tilesK; int n0 = tn * 64, k0 = tk * 64;
    int sc0 = n0, nvalid = 64;
    if (mode == 1) { if (n0 < 2048) sc0 = n0; else if (n0 < 8192) sc0 = n0 + 48; else if (n0 == 8192) { sc0 = 2048; nvalid = 48; } else { sc0 = 0; nvalid = 0; } }
    cur0 = make_float4(0.f, 0.f, 0.f, 0.f); cur1 = cur0;
    if (nc < nvalid) { cur0 = *(const float4*)&src[(size_t)(k0 + kr) * Nsrc + sc0 + nc]; cur1 = *(const float4*)&src[(size_t)(k0 + kr + 32) * Nsrc + sc0 + nc]; }
  }
  int it = 0;
  for (; t < nt; t += gridDim.x, ++it) {
    const int t2 = (t + (int)gridDim.x < nt) ? t + (int)gridDim.x : t;
    float4 nx0, nx1;
    {
      int tn = t2 / tilesK, tk = t2 - tn * tilesK; int n0 = tn * 64, k0 = tk * 64;
      int sc0 = n0, nvalid = 64;
      if (mode == 1) { if (n0 < 2048) sc0 = n0; else if (n0 < 8192) sc0 = n0 + 48; else if (n0 == 8192) { sc0 = 2048; nvalid = 48; } else { sc0 = 0; nvalid = 0; } }
      nx0 = make_float4(0.f, 0.f, 0.f, 0.f); nx1 = nx0;
      if (nc < nvalid) { nx0 = *(const float4*)&src[(size_t)(k0 + kr) * Nsrc + sc0 + nc]; nx1 = *(const float4*)&src[(size_t)(k0 + kr + 32) * Nsrc + sc0 + nc]; }
    }
    float* tb = tile + (it & 1) * (64 * 65);
    tb[kr * 65 + nc + 0] = cur0.x; tb[kr * 65 + nc + 1] = cur0.y; tb[kr * 65 + nc + 2] = cur0.z; tb[kr * 65 + nc + 3] = cur0.w;
    tb[(kr + 32) * 65 + nc + 0] = cur1.x; tb[(kr + 32) * 65 + nc + 1] = cur1.y; tb[(kr + 32) * 65 + nc + 2] = cur1.z; tb[(kr + 32) * 65 + nc + 3] = cur1.w;
    __syncthreads();
    {
      int tn = t / tilesK, tk = t - tn * tilesK; int n0 = tn * 64, k0 = tk * 64;
      uint4 o;
      o.x = pk_bf16(tb[(kc + 0) * 65 + n], tb[(kc + 1) * 65 + n]);
      o.y = pk_bf16(tb[(kc + 2) * 65 + n], tb[(kc + 3) * 65 + n]);
      o.z = pk_bf16(tb[(kc + 4) * 65 + n], tb[(kc + 5) * 65 + n]);
      o.w = pk_bf16(tb[(kc + 6) * 65 + n], tb[(kc + 7) * 65 + n]);
      *(uint4*)&dst[(size_t)(n0 + n) * K + k0 + kc] = o;
    }
    cur0 = nx0; cur1 = nx1;
  }
  __syncthreads();
}

DEVFN void phase_prep(const int WID, PP p) {
  const int BID = opaque_bid();
  const int tid = opaque_tid(WID), lane = tid & 63, wave = tid >> 6;
  char* ws = p->ws;
  for (int job = 0; job < 13; job++) {
    const float* src; u16* dst; int K = 2048, Nsrc, Ndst, mode = 0;
    int l = job & 1, kind = job >> 1;
    if (kind == 0) { src = p->w_in + (size_t)l * 2048 * 4096; dst = (u16*)(ws + OFF_WT_IN) + (size_t)l * 4096 * 2048; Nsrc = 4096; Ndst = 4096; }
    else if (kind == 1) { src = p->w_glu + (size_t)l * 2048 * 2048; dst = (u16*)(ws + OFF_WT_GLU) + (size_t)l * 2048 * 2048; Nsrc = 2048; Ndst = 2048; }
    else if (kind == 2) { src = p->w_out + (size_t)l * 2048 * 2048; dst = (u16*)(ws + OFF_WT_OUT) + (size_t)l * 2048 * 2048; Nsrc = 2048; Ndst = 2048; }
    else if (kind == 3) { src = p->w_qg + (size_t)l * 2048 * 8240; dst = (u16*)(ws + OFF_WT_QG) + (size_t)l * 8448 * 2048; Nsrc = 8240; Ndst = 8448; mode = 1; }
    else if (kind == 4) { src = p->w_o + (size_t)l * 2048 * 2048; dst = (u16*)(ws + OFF_WT_O) + (size_t)l * 2048 * 2048; Nsrc = 2048; Ndst = 2048; }
    else if (kind == 5) { src = p->cmp_w1 + (size_t)l * 4096 * 128; dst = (u16*)(ws + OFF_W1T) + (size_t)l * 128 * 4096; K = 4096; Nsrc = 128; Ndst = 128; }
    else { src = p->w_kv; dst = (u16*)(ws + OFF_WT_KV); Nsrc = 3072; Ndst = 3072; }
    xpose(WID, src, dst, K, Nsrc, Ndst, mode);
  }
  {
    uint4* z = (uint4*)(ws + OFF_KC);
    unsigned zz = 0; asm volatile("" : "+v"(zz));
    for (int i = BID * 512 + tid; i < (int)(2 * MB / 16); i += gridDim.x * 512) z[i] = make_uint4(zz, zz, zz, zz);
  }
  {
    float* cact = (float*)smem;
    float* red = cact + 8192;
    float* modv = (float*)(ws + OFF_MODV);
    float* kvmod = (float*)(ws + OFF_KVMOD);
    for (int i = tid; i < 8192; i += 512) { float v = p->c[i]; cact[i] = v / (1.f + expf(-v)); }
    __syncthreads();
    for (int task = BID; task < 448; task += gridDim.x) {
      const float* W; const float* bias; float* outp; int N; int col0;
      if (task < 384) {
        int l = task / 96; col0 = (task % 96) * 64; W = p->mod_w + (size_t)l * 2048 * 6144; N = 6144;
        bias = p->mod_b + l * 6144; outp = modv + l * 4 * 6144;
      } else {
        col0 = (task - 384) * 64; W = p->kv_mod_w; N = 4096; bias = p->kv_mod_b; outp = kvmod;
      }
      float a0 = 0, a1 = 0, a2 = 0, a3 = 0;
      int kb = wave * 256;
      const float* wp = W + (size_t)kb * N + col0 + lane;
#pragma unroll 1
      for (int k0 = 0; k0 < 256; k0 += 32) {
        float wv[32];
#pragma unroll
        for (int i = 0; i < 32; i++) wv[i] = wp[(size_t)(k0 + i) * N];
#pragma unroll
        for (int i = 0; i < 32; i++) {
          int k = kb + k0 + i;
          a0 += cact[k] * wv[i]; a1 += cact[2048 + k] * wv[i]; a2 += cact[4096 + k] * wv[i]; a3 += cact[6144 + k] * wv[i];
        }
      }
      red[(wave * 4 + 0) * 64 + lane] = a0; red[(wave * 4 + 1) * 64 + lane] = a1;
      red[(wave * 4 + 2) * 64 + lane] = a2; red[(wave * 4 + 3) * 64 + lane] = a3;
      __syncthreads();
      if (tid < 256) {
        int b = tid >> 6, ln = tid & 63; float s = 0;
#pragma unroll
        for (int w = 0; w < 8; w++) s += red[(w * 4 + b) * 64 + ln];
        outp[b * N + col0 + ln] = s + bias[col0 + ln];
      }
      __syncthreads();
    }
  }
  {
    float2* abar = (float2*)(ws + OFF_ABAR); float2* aq = (float2*)(ws + OFF_AQ);
    float* bbre = (float*)(ws + OFF_BBRE); float* bbim = (float*)(ws + OFF_BBIM);
    for (int i = BID * 512 + tid; i < 2 * 128 * 64; i += gridDim.x * 512) {
      int lg = i >> 6;
      float dt = expf(p->log_step[lg]);
      float lr = p->lam_re[i], li = p->lam_im[i];
      float zr = lr * dt, zi = li * dt;
      float em1 = expm1f(zr), cz = cosf(zi), sz = sinf(zi), sh = sinf(0.5f * zi);
      float mag = em1 + 1.f;
      float arm1 = em1 * cz - 2.f * sh * sh;
      float are = 1.f + arm1, aim = mag * sz;
      float den = lr * lr + li * li;
      float cre = (arm1 * lr + aim * li) / den, cim = (aim * lr - arm1 * li) / den;
      abar[i] = make_float2(are, aim);
      float m64 = expf(zr * 64.f), a64 = zi * 64.f;
      aq[i] = make_float2(m64 * cosf(a64), m64 * sinf(a64));
#pragma unroll
      for (int c = 0; c < 16; c++) {
        float br = p->b_re[(size_t)i * 16 + c], bi = p->b_im[(size_t)i * 16 + c];
        bbre[(size_t)i * 16 + c] = cre * br - cim * bi;
        bbim[(size_t)i * 16 + c] = cre * bi + cim * br;
      }
    }
  }
  {
    float* red = (float*)smem + 16384;
    float* pebp = (float*)(ws + OFF_PEBP);
    for (int task = BID; task < 256; task += gridDim.x) {
      int kvi = task >> 7, kq = task & 127;
      int j = tid & 127, sub = tid >> 7;
      const float* pe = p->cmp_pe + kvi * 4096 + kq * 32 + sub * 8; const float* w1 = p->cmp_w1 + ((size_t)kvi * 4096 + kq * 32 + sub * 8) * 128 + j;
      float a = 0;
#pragma unroll
      for (int k = 0; k < 8; k++) a += pe[k] * w1[(size_t)k * 128];
      red[tid] = a;
      __syncthreads();
      if (tid < 128) pebp[(size_t)task * 128 + tid] = red[tid] + red[tid + 128] + red[tid + 256] + red[tid + 384];
      __syncthreads();
    }
  }
}

DEVFN void phase_peb_final(const int WID, PP p) {
  const int BID = opaque_bid();
  const int tid = opaque_tid(WID);
  if (BID != 0 || tid >= 256) return;
  char* ws = p->ws;
  const float* pebp = (const float*)(ws + OFF_PEBP);
  float* peb = (float*)(ws + OFF_PEB);
  int kvi = tid >> 7, j = tid & 127;
  float s = p->cmp_b1[kvi * 128 + j];
#pragma unroll 1
  for (int k0 = 0; k0 < 128; k0 += 32) {
    float v[32];
#pragma unroll
    for (int i = 0; i < 32; i++) v[i] = pebp[(size_t)(kvi * 128 + k0 + i) * 128 + j];
#pragma unroll
    for (int i = 0; i < 32; i++) s += v[i];
  }
  peb[kvi * 128 + j] = s;
}

DEVFN void phase_prenorm(const int WID, PP p, int layer, bool dual) {
  const int BID = opaque_bid();
  const int tid = opaque_tid(WID), lane = tid & 63, wave = tid >> 6;
  char* ws = p->ws;
  const float* xin = (layer == 0) ? p->x : (const float*)(ws + OFF_XBUF);
  const float* modv = (const float*)(ws + OFF_MODV);
  const float* kvmod = (const float*)(ws + OFF_KVMOD);
  u16* hbuf = (u16*)(ws + OFF_HBUF);
  u16* hkv = (u16*)(ws + OFF_HKV);
  for (int r0 = (BID * 8 + wave) * 2; r0 < T_; r0 += gridDim.x * 16) {
    float4 v[2][8]; float ss[2] = {0.f, 0.f};
#pragma unroll
    for (int rr = 0; rr < 2; rr++) {
      const float* xr = xin + (size_t)(r0 + rr) * 2048;
#pragma unroll
      for (int i = 0; i < 8; i++) v[rr][i] = *(const float4*)&xr[(i * 64 + lane) * 4];
    }
#pragma unroll
    for (int rr = 0; rr < 2; rr++) {
#pragma unroll
      for (int i = 0; i < 8; i++) ss[rr] += v[rr][i].x * v[rr][i].x + v[rr][i].y * v[rr][i].y + v[rr][i].z * v[rr][i].z + v[rr][i].w * v[rr][i].w;
      ss[rr] = wave_sum(ss[rr], lane);
    }
    const int b = r0 >> 12;
    const float* g = p->norm_g + layer * 2048; const float* mv = modv + (size_t)(layer * 4 + b) * 6144;
#pragma unroll
    for (int rr = 0; rr < 2; rr++) {
      const int r = r0 + rr;
      const float rstd = rsqrtf(ss[rr] * (1.f / 2048.f) + 1e-6f);
#pragma unroll
      for (int i = 0; i < 8; i++) {
        int c = (i * 64 + lane) * 4;
        float4 gg = *(const float4*)&g[c], sh = *(const float4*)&mv[c], sc = *(const float4*)&mv[2048 + c];
        uint2 o;
        o.x = pk_bf16(v[rr][i].x * rstd * gg.x * (1.f + sc.x) + sh.x, v[rr][i].y * rstd * gg.y * (1.f + sc.y) + sh.y);
        o.y = pk_bf16(v[rr][i].z * rstd * gg.z * (1.f + sc.z) + sh.z, v[rr][i].w * rstd * gg.w * (1.f + sc.w) + sh.w);
        *(uint2*)&hbuf[(size_t)r * 2048 + c] = o;
      }
      if (dual) {
        const float* g2 = p->kv_norm_g; const float* mv2 = kvmod + (size_t)b * 4096;
#pragma unroll
        for (int i = 0; i < 8; i++) {
          int c = (i * 64 + lane) * 4;
          float4 gg = *(const float4*)&g2[c], sh = *(const float4*)&mv2[c], sc = *(const float4*)&mv2[2048 + c];
          uint2 o;
          o.x = pk_bf16(v[rr][i].x * rstd * gg.x * (1.f + sc.x) + sh.x, v[rr][i].y * rstd * gg.y * (1.f + sc.y) + sh.y);
          o.y = pk_bf16(v[rr][i].z * rstd * gg.z * (1.f + sc.z) + sh.z, v[rr][i].w * rstd * gg.w * (1.f + sc.w) + sh.w);
          *(uint2*)&hkv[(size_t)r * 2048 + c] = o;
        }
      }
    }
  }
}

DEVFN void phase_final(const int WID, PP p) {
  const int BID = opaque_bid();
  const int tid = opaque_tid(WID), lane = tid & 63, wave = tid >> 6;
  const float* xin = (const float*)(p->ws + OFF_XBUF);
  for (int r0 = (BID * 8 + wave) * 2; r0 < T_; r0 += gridDim.x * 16) {
    float4 v[2][8]; float ss[2] = {0.f, 0.f};
#pragma unroll
    for (int rr = 0; rr < 2; rr++) {
      const float* xr = xin + (size_t)(r0 + rr) * 2048;
#pragma unroll
      for (int i = 0; i < 8; i++) v[rr][i] = *(const float4*)&xr[(i * 64 + lane) * 4];
    }
#pragma unroll
    for (int rr = 0; rr < 2; rr++) {
#pragma unroll
      for (int i = 0; i < 8; i++) ss[rr] += v[rr][i].x * v[rr][i].x + v[rr][i].y * v[rr][i].y + v[rr][i].z * v[rr][i].z + v[rr][i].w * v[rr][i].w;
      ss[rr] = wave_sum(ss[rr], lane);
    }
#pragma unroll
    for (int rr = 0; rr < 2; rr++) {
      const float rstd = rsqrtf(ss[rr] * (1.f / 2048.f) + 1e-6f);
#pragma unroll
      for (int i = 0; i < 8; i++) {
        int c = (i * 64 + lane) * 4;
        float4 gg = *(const float4*)&p->final_g[c];
        float4 o = make_float4(v[rr][i].x * rstd * gg.x, v[rr][i].y * rstd * gg.y, v[rr][i].z * rstd * gg.z, v[rr][i].w * rstd * gg.w);
        *(float4*)&p->out[(size_t)(r0 + rr) * 2048 + c] = o;
      }
    }
  }
}

enum { EPI_S1 = 0, EPI_S3 = 1, EPI_RES = 2, EPI_KV = 3, EPI_QG = 4 };

__device__ __forceinline__ uint2 pack4(float a, float b, float c, float d) { uint2 o; o.x = pk_bf16(a, b); o.y = pk_bf16(c, d); return o; }
__device__ __forceinline__ float bflo(unsigned u) { return __uint_as_float(u << 16); }
__device__ __forceinline__ float bfhi(unsigned u) { return __uint_as_float(u & 0xffff0000u); }

struct EpiPre { float4 x; uint2 a, b; };
template <int EPI>
__device__ __forceinline__ EpiPre epi_pre(PP p, int row, int col, int aux) {
  EpiPre r; r.x = make_float4(0.f, 0.f, 0.f, 0.f); r.a = make_uint2(0u, 0u); r.b = r.a;
  char* ws = p->ws;
  if constexpr (EPI == EPI_S3) {
    const u16* uz = (const u16*)(ws + OFF_UZ); const u16* y = (const u16*)(ws + OFF_Y);
    r.a = *(const uint2*)&y[(size_t)row * 2048 + col];
    r.b = *(const uint2*)&uz[(size_t)row * 4096 + 2048 + col];
  } else if constexpr (EPI == EPI_RES) {
    const float* xo = (aux == 0) ? p->x : (const float*)(ws + OFF_XBUF);
    r.x = *(const float4*)&xo[(size_t)row * 2048 + col];
  }
  return r;
}
template <int EPI>
__device__ __forceinline__ void epi_row(PP p, int row, int col, f32x4 v, int aux, const EpiPre& pre) {
  char* ws = p->ws;
  if constexpr (EPI == EPI_S1) {
    u16* uz = (u16*)(ws + OFF_UZ);
    if (col >= 2048) { v[0] = siluf_(v[0]); v[1] = siluf_(v[1]); v[2] = siluf_(v[2]); v[3] = siluf_(v[3]); }
    *(uint2*)&uz[(size_t)row * 4096 + col] = pack4(v[0], v[1], v[2], v[3]);
  } else if constexpr (EPI == EPI_S3) {
    const u16* uz = (const u16*)(ws + OFF_UZ); const u16* y = (const u16*)(ws + OFF_Y); u16* vo = (u16*)(ws + OFF_V);
    float4 bg = *(const float4*)&p->b_glu[aux * 2048 + col];
    uint2 yy = pre.a;
    uint2 ss = pre.b;
    *(uint2*)&vo[(size_t)row * 2048 + col] = pack4(bflo(yy.x) * sigmoidf_(v[0] + bg.x) * bflo(ss.x), bfhi(yy.x) * sigmoidf_(v[1] + bg.y) * bfhi(ss.x),
                                                   bflo(yy.y) * sigmoidf_(v[2] + bg.z) * bflo(ss.y), bfhi(yy.y) * sigmoidf_(v[3] + bg.w) * bfhi(ss.y));
  } else if constexpr (EPI == EPI_RES) {
    const float* modv = (const float*)(ws + OFF_MODV);
    float* xb = (float*)(ws + OFF_XBUF);
    const float* xo = (aux == 0) ? p->x : xb;
    int b = row >> 12;
    float4 gate = *(const float4*)&modv[(size_t)(aux * 4 + b) * 6144 + 4096 + col];
    size_t idx = (size_t)row * 2048 + col;
    float4 xv = pre.x;
    *(float4*)&xb[idx] = make_float4(xv.x + gate.x * v[0], xv.y + gate.y * v[1], xv.z + gate.z * v[2], xv.w + gate.w * v[3]);
  } else if constexpr (EPI == EPI_KV) {
    u16* kvb = (u16*)(ws + OFF_KVB);
    *(uint2*)&kvb[(size_t)row * 3072 + col] = pack4(v[0], v[1], v[2], v[3]);
  } else if constexpr (EPI == EPI_QG) {
    if (col < 2048) {
      u16* q = (u16*)(ws + OFF_Q);
      const float sc = 0.08838834764831845f * 1.4426950408889634f;
      *(uint2*)&q[(size_t)row * 2048 + col] = pack4(v[0] * sc, v[1] * sc, v[2] * sc, v[3] * sc);
    } else if (col < 8192) {
      u16* sz3 = (u16*)(ws + OFF_SZ3);
      *(uint2*)&sz3[(size_t)row * 6144 + (col - 2048)] = pack4(siluf_(v[0]), siluf_(v[1]), siluf_(v[2]), siluf_(v[3]));
    } else if (col < 8240) {
      float* gates = (float*)(ws + OFF_GATES);
      *(float4*)&gates[(size_t)row * 48 + (col - 8192)] = make_float4(sigmoidf_(v[0]), sigmoidf_(v[1]), sigmoidf_(v[2]), sigmoidf_(v[3]));
    }
  }
}
__device__ __forceinline__ void epi_vt(PP p, int row0, int col, f32x4 v) {
  int br = col >> 9;
  int which = (br == 5) ? 1 : 0;
  int gg = (col >> 7) & 3, d = col & 127;
  int b = row0 >> 12, t = row0 & 4095;
  u16* vt = (u16*)(p->ws + OFF_VT);
  *(uint2*)&vt[((size_t)((which * 4 + b) * 4 + gg) * 128 + d) * 4096 + t] = pack4(v[0], v[1], v[2], v[3]);
}

typedef const __attribute__((address_space(1))) char* gptr_t;
constexpr int G_BM = 256, G_BK = 64, G_HALF = 128, G_NXCD = 8, G_WGM = 8, G_HT = G_HALF * G_BK;

__device__ __forceinline__ int lds_byte(int r, int c) {
  int st = (r >> 4) * 2 + (c >> 5), rr = r & 15, cc = c & 31, ob = rr * 64 + cc * 2;
  return st * 1024 + (ob ^ (((ob >> 9) & 1) << 5));
}
__device__ __forceinline__ void stage_rc(int b, int& R, int& C) {
  int st = b / 1024, sb = b % 1024, swz = sb ^ (((sb >> 9) & 1) << 5);
  R = (st >> 1) * 16 + swz / 64; C = (st & 1) * 32 + (swz % 64) / 2;
}

template <int EPI>
DEVFN void gemm_phase(const int WID, PP p, const u16* __restrict__ A, const u16* __restrict__ Bt, const int N, const int aux) {
  const int BID = opaque_bid();
  constexpr int K = 2048;
  u16* shm = (u16*)smem;
#define SA(b, h) (shm + ((b) * 2 + (h)) * G_HT)
#define SB(b, h) (shm + (4 + (b) * 2 + (h)) * G_HT)
#define STAGE(P, BASE, br, kt) do { const char* _ub = (const char*)(BASE + (long)(br) * K + (long)(kt) * G_BK); \
    unsigned _l0 = lds0 + (unsigned)((char*)(P) - smem) + wbase; \
    asm volatile("s_mov_b32 m0, %2\n\ts_nop 0\n\tglobal_load_lds_dwordx4 %0, %1" :: "v"(svoff[0]), "s"(_ub), "s"(_l0) : "memory"); \
    asm volatile("s_mov_b32 m0, %2\n\ts_nop 0\n\tglobal_load_lds_dwordx4 %0, %1" :: "v"(svoff[1]), "s"(_ub), "s"(_l0 + 8192u) : "memory"); } while (0)
#define LDA(dst, b, h) for (int m = 0; m < 4; ++m) for (int k = 0; k < 2; ++k) \
    dst[m][k] = *reinterpret_cast<const bf16x8*>((char*)SA(b, h) + lds_byte(wr * 64 + m * 16 + fr, k * 32 + fq * 8))
#define LDB(dst, b, h) for (int n = 0; n < 2; ++n) for (int k = 0; k < 2; ++k) \
    dst[n][k] = *reinterpret_cast<const bf16x8*>((char*)SB(b, h) + lds_byte(wc * 32 + n * 16 + fr, k * 32 + fq * 8))
#define MMA(ai, bj, At, Bt_) do { __builtin_amdgcn_s_setprio(1); \
    for (int m = 0; m < 4; ++m) for (int n = 0; n < 2; ++n) for (int k = 0; k < 2; ++k) \
      acc[ai][bj][m][n] = __builtin_amdgcn_mfma_f32_16x16x32_bf16(At[m][k], Bt_[n][k], acc[ai][bj][m][n], 0, 0, 0); \
    __builtin_amdgcn_s_setprio(0); } while (0)
#define WAIT_V(n) asm volatile("s_waitcnt vmcnt(" #n ")" ::: "memory")
#define WAIT_L(n) asm volatile("s_waitcnt lgkmcnt(" #n ")" ::: "memory")
#define BAR __builtin_amdgcn_s_barrier()
#define SCHED __builtin_amdgcn_sched_barrier(0)

  const int nM = T_ / G_BM, nN = N / G_BM, nwg = nM * nN;
  const int gtid = opaque_tid(WID);
  const int wid = gtid >> 6, lane = gtid & 63, wr = wid >> 2, wc = wid & 3, fr = lane & 15, fq = lane >> 4;
  constexpr int nt = K / G_BK;
  const int wbase = __builtin_amdgcn_readfirstlane((gtid >> 6) << 10);
  const unsigned lds0 = (unsigned)(unsigned long)(__attribute__((address_space(3))) char*)smem;
  unsigned svoff[2];
#pragma unroll
  for (int i = 0; i < 2; ++i) { int r_, c_; stage_rc(gtid * 16 + i * 8192, r_, c_); svoff[i] = (unsigned)(r_ * K + c_) * 2u; }
  for (int vt = BID; vt < nwg; vt += gridDim.x) {
    int wgid = vt;
    { int q = nwg / G_NXCD, r = nwg % G_NXCD, xcd = wgid % G_NXCD, off = wgid / G_NXCD;
      wgid = (xcd < r ? xcd * (q + 1) : r * (q + 1) + (xcd - r) * q) + off; }
    int nig = G_WGM * nN, gid = wgid / nig, fm = gid * G_WGM, gsz = min(nM - fm, G_WGM);
    int pm = fm + ((wgid % nig) % gsz), pn = (wgid % nig) / gsz, brow = pm * G_BM, bcol = pn * G_BM;
    f32x4 acc[2][2][4][2] = {};
    bf16x8 At[4][2], B0[2][2], B1[2][2];
    asm volatile("s_waitcnt vmcnt(0)" ::: "memory");
    STAGE(SB(0, 0), Bt, bcol, 0); STAGE(SA(0, 0), A, brow, 0);
    STAGE(SB(0, 1), Bt, bcol + G_HALF, 0); STAGE(SA(0, 1), A, brow + G_HALF, 0);
    if (wr == 1) BAR;
    WAIT_V(4); BAR;
    STAGE(SB(1, 0), Bt, bcol, 1); STAGE(SA(1, 0), A, brow, 1); STAGE(SB(1, 1), Bt, bcol + G_HALF, 1);
    WAIT_V(6); BAR;
#pragma nounroll
    for (int t = 0; t < nt - 2; t += 2) {
      LDB(B0, 0, 0); SCHED; LDA(At, 0, 0); STAGE(SA(1, 1), A, brow + G_HALF, t + 1);
      WAIT_L(8); BAR; WAIT_L(0); MMA(0, 0, At, B0); BAR; SCHED;
      LDB(B1, 0, 1); STAGE(SB(0, 0), Bt, bcol, t + 2);
      BAR; WAIT_L(0); MMA(0, 1, At, B1); BAR;
      LDA(At, 0, 1); STAGE(SA(0, 0), A, brow, t + 2);
      BAR; WAIT_L(0); MMA(1, 0, At, B0); BAR; SCHED;
      STAGE(SB(0, 1), Bt, bcol + G_HALF, t + 2);
      WAIT_V(6); BAR; MMA(1, 1, At, B1); BAR;
      LDB(B0, 1, 0); SCHED; LDA(At, 1, 0); STAGE(SA(0, 1), A, brow + G_HALF, t + 2);
      WAIT_L(8); BAR; WAIT_L(0); MMA(0, 0, At, B0); BAR; SCHED;
      LDB(B1, 1, 1); STAGE(SB(1, 0), Bt, bcol, t + 3);
      BAR; WAIT_L(0); MMA(0, 1, At, B1); BAR;
      LDA(At, 1, 1); STAGE(SA(1, 0), A, brow, t + 3);
      BAR; WAIT_L(0); MMA(1, 0, At, B0); BAR; SCHED;
      STAGE(SB(1, 1), Bt, bcol + G_HALF, t + 3);
      WAIT_V(6); BAR; MMA(1, 1, At, B1); BAR;
    }
    { LDB(B0, 0, 0); LDA(At, 0, 0); STAGE(SA(1, 1), A, brow + G_HALF, nt - 1);
      BAR; WAIT_L(0); MMA(0, 0, At, B0); BAR;
      LDB(B1, 0, 1); BAR; WAIT_L(0); MMA(0, 1, At, B1); BAR;
      LDA(At, 0, 1); WAIT_V(4); BAR; WAIT_L(0); MMA(1, 0, At, B0); MMA(1, 1, At, B1); BAR; }
    { LDB(B0, 1, 0); LDA(At, 1, 0); WAIT_V(2); BAR; WAIT_L(0); MMA(0, 0, At, B0); BAR;
      LDB(B1, 1, 1); WAIT_V(0); BAR; WAIT_L(0); MMA(0, 1, At, B1); BAR;
      LDA(At, 1, 1); BAR; WAIT_L(0); MMA(1, 0, At, B0); MMA(1, 1, At, B1); BAR; }
    if (wr == 0) BAR;
    {
      float* et = (float*)(smem + wid * 16384);
      const int te = opaque_tid(WID);
      const int fr = te & 15, fq = (te >> 4) & 3, wr = te >> 8, wc = (te >> 6) & 3;
      bool vtb = false;
      if constexpr (EPI == EPI_KV) { int br = bcol >> 9; vtb = (br == 3) || (br == 5); }
#pragma unroll
      for (int ai = 0; ai < 2; ++ai) {
#pragma unroll
        for (int bj = 0; bj < 2; ++bj)
#pragma unroll
          for (int m = 0; m < 4; ++m)
#pragma unroll
            for (int n = 0; n < 2; ++n)
#pragma unroll
              for (int j = 0; j < 4; ++j)
                et[(m * 16 + fq * 4 + j) * 64 + ((bj * 32 + n * 16 + fr) ^ (fq << 4))] = acc[ai][bj][m][n][j];
        const int rbase = brow + ai * G_HALF + wr * 64;
        if (!vtb) {
#pragma unroll 1
          for (int it0 = 0; it0 < 16; it0 += 4) {
            const int c4 = fr * 4;
            const int gcol = bcol + (c4 >> 5) * G_HALF + wc * 32 + (c4 & 31);
            EpiPre pre[4];
#pragma unroll
            for (int u = 0; u < 4; ++u) pre[u] = epi_pre<EPI>(p, rbase + (it0 + u) * 4 + fq, gcol, aux);
#pragma unroll
            for (int u = 0; u < 4; ++u) {
              int row = (it0 + u) * 4 + fq;
              f32x4 v = *(const f32x4*)&et[row * 64 + (c4 ^ (((row >> 2) & 3) << 4))];
              epi_row<EPI>(p, rbase + row, gcol, v, aux, pre[u]);
            }
          }
        } else {
#pragma unroll 1
          for (int it = 0; it < 16; ++it) {
            int c = it * 4 + fq, r4 = fr * 4;
            int sw = (fr & 3) << 4;
            f32x4 v;
            v[0] = et[(r4 + 0) * 64 + (c ^ sw)]; v[1] = et[(r4 + 1) * 64 + (c ^ sw)];
            v[2] = et[(r4 + 2) * 64 + (c ^ sw)]; v[3] = et[(r4 + 3) * 64 + (c ^ sw)];
            int gcol = bcol + (c >> 5) * G_HALF + wc * 32 + (c & 31);
            epi_vt(p, rbase + r4, gcol, v);
          }
        }
      }
    }
    __syncthreads();
  }
#undef SA
#undef SB
#undef STAGE
#undef LDA
#undef LDB
#undef MMA
}

DEVFN void phase_ssm_a(const int WID, PP p, int layer) {
  const int BID = opaque_bid();
  const int tid = opaque_tid(WID), lane = tid & 63, wave = tid >> 6;
  char* ws = p->ws;
  const u16* uz = (const u16*)(ws + OFF_UZ);
  const float2* abar = (const float2*)(ws + OFF_ABAR);
  const float* bbre = (const float*)(ws + OFF_BBRE); const float* bbim = (const float*)(ws + OFF_BBIM);
  float2* st = (float2*)(ws + OFF_ST);
  float* uw = (float*)smem + wave * 1024;
  for (int task = BID; task < 4096; task += gridDim.x) {
    int bg = task >> 3, co = task & 7; int b = bg >> 7, g = bg & 127;
    int c = co * 8 + wave;
    {
      int t = c * 64 + lane;
      const u16* up = uz + (size_t)(b * 4096 + t) * 4096 + g * 16;
      bf16x8 u0 = *(const bf16x8*)up, u1 = *(const bf16x8*)(up + 8);
#pragma unroll
      for (int j = 0; j < 8; j++) { uw[lane * 16 + j] = bf2f((u16)u0[j]); uw[lane * 16 + 8 + j] = bf2f((u16)u1[j]); }
    }
    int gi = (layer * 128 + g) * 64 + lane;
    float br[16], bi[16];
#pragma unroll
    for (int k = 0; k < 16; k++) { br[k] = bbre[(size_t)gi * 16 + k]; bi[k] = bbim[(size_t)gi * 16 + k]; }
    float2 a = abar[gi];
    __syncthreads();
    float xr = 0, xi = 0;
    for (int s = 0; s < 64; s++) {
      float bur = 0, bui = 0;
#pragma unroll
      for (int k4 = 0; k4 < 4; k4++) {
        float4 u = *(const float4*)&uw[s * 16 + k4 * 4];
        bur += br[k4 * 4 + 0] * u.x + br[k4 * 4 + 1] * u.y + br[k4 * 4 + 2] * u.z + br[k4 * 4 + 3] * u.w;
        bui += bi[k4 * 4 + 0] * u.x + bi[k4 * 4 + 1] * u.y + bi[k4 * 4 + 2] * u.z + bi[k4 * 4 + 3] * u.w;
      }
      float nr = a.x * xr - a.y * xi + bur;
      float ni = a.x * xi + a.y * xr + bui;
      xr = nr; xi = ni;
    }
    st[((size_t)bg * 64 + c) * 64 + lane] = make_float2(xr, xi);
    __syncthreads();
  }
}


DEVFN void phase_ssm_gen(const int WID, PP p, int layer) {
  const int BID = opaque_bid();
  const int tid = opaque_tid(WID);
  char* ws = p->ws;
  float2* pwr = (float2*)smem;
  float2* Cc = (float2*)(smem + 33280);
  float2* Bb = (float2*)(smem + 41472);
  const float* bbre = (const float*)(ws + OFF_BBRE); const float* bbim = (const float*)(ws + OFF_BBIM);
  for (int task = BID; task < 256; task += gridDim.x) {
    const int g = task >> 1, hf = task & 1;
    const int lg = layer * 128 + g;
    for (int i = tid; i < 1024; i += 512) {
      Cc[i] = make_float2(p->c_re[(size_t)lg * 1024 + i], p->c_im[(size_t)lg * 1024 + i]);
      Bb[i] = make_float2(bbre[(size_t)lg * 1024 + i], bbim[(size_t)lg * 1024 + i]);
    }
    {
      float dt = expf(p->log_step[lg]);
      for (int i = tid; i < 65 * 64; i += 512) {
        int d = i >> 6, n = i & 63;
        float lr = p->lam_re[lg * 64 + n], li = p->lam_im[lg * 64 + n];
        float mag = expf(lr * dt * (float)d);
        float sn, cs; sincosf(li * dt * (float)d, &sn, &cs);
        pwr[i] = make_float2(mag * cs, mag * sn);
      }
    }
    __syncthreads();
    {
      u16* kt = (u16*)(ws + OFF_SSM_KT) + (size_t)g * 16384;
      int d = hf * 32 + (tid >> 4), cp = tid & 15;
      float acc[16];
#pragma unroll
      for (int c = 0; c < 16; c++) acc[c] = 0.f;
      for (int n = 0; n < 64; n++) {
        float2 C = Cc[cp * 64 + n], P = pwr[d * 64 + n];
        float tr = C.x * P.x - C.y * P.y, ti = C.x * P.y + C.y * P.x;
#pragma unroll
        for (int c = 0; c < 16; c++) { float2 B = Bb[n * 16 + c]; acc[c] += tr * B.x - ti * B.y; }
      }
      uint4 o0, o1;
      o0.x = pk_bf16(acc[0], acc[1]); o0.y = pk_bf16(acc[2], acc[3]); o0.z = pk_bf16(acc[4], acc[5]); o0.w = pk_bf16(acc[6], acc[7]);
      o1.x = pk_bf16(acc[8], acc[9]); o1.y = pk_bf16(acc[10], acc[11]); o1.z = pk_bf16(acc[12], acc[13]); o1.w = pk_bf16(acc[14], acc[15]);
      *(uint4*)&kt[(d * 16 + cp) * 16] = o0;
      *(uint4*)&kt[(d * 16 + cp) * 16 + 8] = o1;
    }
    unsigned* w1 = (unsigned*)((u16*)(ws + OFF_SSM_W1) + (size_t)g * 131072);
    for (int e2 = hf * 32768 + tid; e2 < hf * 32768 + 32768; e2 += 512) {
      int e = e2 * 2; int row = e >> 10, k = e & 1023; int sidx = k >> 4, c = k & 15, n = row & 63;
      float2 P = pwr[(63 - sidx) * 64 + n];
      float2 B0 = Bb[n * 16 + c], B1 = Bb[n * 16 + c + 1];
      float v0, v1;
      if (row < 64) { v0 = P.x * B0.x - P.y * B0.y; v1 = P.x * B1.x - P.y * B1.y; }
      else { v0 = P.x * B0.y + P.y * B0.x; v1 = P.x * B1.y + P.y * B1.x; }
      w1[e2] = pk_bf16(v0, v1);
    }
    unsigned* w2 = (unsigned*)((u16*)(ws + OFF_SSM_W2) + (size_t)g * 131072);
    for (int e2 = hf * 32768 + tid; e2 < hf * 32768 + 32768; e2 += 512) {
      int e = e2 * 2; int row = e >> 7, k2 = e & 127; int sidx = row >> 4, cp = row & 15, n = k2 & 63;
      float2 C0 = Cc[cp * 64 + n], C1 = Cc[cp * 64 + n + 1];
      float2 P0 = pwr[(sidx + 1) * 64 + n], P1 = pwr[(sidx + 1) * 64 + n + 1];
      float v0, v1;
      if (k2 < 64) { v0 = C0.x * P0.x - C0.y * P0.y; v1 = C1.x * P1.x - C1.y * P1.y; }
      else { v0 = -(C0.x * P0.y + C0.y * P0.x); v1 = -(C1.x * P1.y + C1.y * P1.x); }
      w2[e2] = pk_bf16(v0, v1);
    }
    __syncthreads();
  }
}

DEVFN void phase_ssm_x1(const int WID, PP p, int layer) {
  const int BID = opaque_bid();
  const int tid = opaque_tid(WID), lane = tid & 63, wave = tid >> 6;
  char* ws = p->ws;
  const u16* uz = (const u16*)(ws + OFF_UZ);
  float* st = (float*)(ws + OFF_ST);
  const int l15 = lane & 15, l4 = lane >> 4;
  for (int bt = BID; bt < 256; bt += gridDim.x) {
    int wt = bt * 8 + wave; int g = wt >> 4, ct = wt & 15;
    int col = ct * 16 + l15; int b = col >> 6, chunk = col & 63;
    const u16* ub = uz + (size_t)(b * 4096 + chunk * 64) * 4096 + g * 16;
    const u16* w1 = (const u16*)(ws + OFF_SSM_W1) + (size_t)g * 131072;
    f32x4 acc[8];
#pragma unroll
    for (int mt = 0; mt < 8; mt++) acc[mt] = f32x4{0.f, 0.f, 0.f, 0.f};
#pragma unroll 4
    for (int ks = 0; ks < 32; ks++) {
      int sidx = ks * 2 + (l4 >> 1), c0 = (l4 & 1) * 8;
      bf16x8 bfr = *(const bf16x8*)&ub[(size_t)sidx * 4096 + c0];
#pragma unroll
      for (int mt = 0; mt < 8; mt++) {
        bf16x8 afr = *(const bf16x8*)&w1[(size_t)(mt * 16 + l15) * 1024 + ks * 32 + l4 * 8];
        acc[mt] = __builtin_amdgcn_mfma_f32_16x16x32_bf16(afr, bfr, acc[mt], 0, 0, 0);
      }
    }
    float* sb = st + (((size_t)(b * 128 + g) * 64 + chunk) * 64) * 2;
#pragma unroll
    for (int mt = 0; mt < 8; mt++)
#pragma unroll
      for (int j = 0; j < 4; j++) {
        int n2 = mt * 16 + l4 * 4 + j;
        sb[(n2 & 63) * 2 + (n2 >> 6)] = acc[mt][j];
      }
  }
}


DEVFN void phase_ssm_x3(const int WID, PP p, int layer) {
  const int BID = opaque_bid();
  const int tid = opaque_tid(WID), lane = tid & 63, wave = tid >> 6;
  char* ws = p->ws;
  const u16* uz = (const u16*)(ws + OFF_UZ);
  u16* yb = (u16*)(ws + OFF_Y);
  char* Kl = smem + 512;
  char* Wl = smem + 33280;
  const int l15 = lane & 15, l4 = lane >> 4;
  for (int bt = BID; bt < 256; bt += gridDim.x) {
    int wt = bt * 8 + wave; int g = wt >> 4, ct = wt & 15;
    int col = ct * 16 + l15; int b = col >> 6, chunk = col & 63;
    const u16* ub = uz + (size_t)(b * 4096 + chunk * 64) * 4096 + g * 16;
    const u16* kt = (const u16*)(ws + OFF_SSM_KT) + (size_t)g * 16384;
    const u16* w2 = (const u16*)(ws + OFF_SSM_W2) + (size_t)g * 131072;
    const u16* xpb = (const u16*)(ws + OFF_SSM_XP) + ((size_t)(b * 128 + g) * 64 + chunk) * 128;
    const int c0 = (l4 & 1) * 8;
    const char* kbase_l = Kl + (l15 - (l4 >> 1) * 16) * 32 + c0 * 2;
    float4 dsk = *(const float4*)&p->dskip[layer * 2048 + g * 16 + l4 * 4];
    __syncthreads();
#pragma unroll
    for (int i = 0; i < 4; i++) {
      int ci = tid + 512 * i;
      *(uint4*)(Kl + ci * 16) = *(const uint4*)&kt[ci * 8];
    }
    if (tid < 32) { unsigned zz = 0; asm volatile("" : "+v"(zz)); *(uint4*)(smem + tid * 16) = make_uint4(zz, zz, zz, zz); }
#pragma unroll 1
    for (int qd = 0; qd < 4; qd++) {
      if (qd) __syncthreads();
#pragma unroll
      for (int i = 0; i < 8; i++) {
        int ci = tid + 512 * i; int row = ci >> 4, c16 = ci & 15;
        *(uint4*)(Wl + row * 272 + c16 * 16) = *(const uint4*)&w2[(size_t)(qd * 256 + row) * 128 + c16 * 8];
      }
      __syncthreads();
      f32x4 acc[16];
#pragma unroll
      for (int sl = 0; sl < 16; sl++) acc[sl] = f32x4{0.f, 0.f, 0.f, 0.f};
      const int nks = 8 * qd + 8;
      bf16x8 ucur[4], unxt[4];
#pragma unroll
      for (int i = 0; i < 4; i++) ucur[i] = *(const bf16x8*)&ub[(size_t)(2 * i + (l4 >> 1)) * 4096 + c0];
#pragma unroll 1
      for (int ks0 = 0; ks0 < nks; ks0 += 4) {
#pragma unroll
        for (int i = 0; i < 4; i++) {
          int ksn = min(ks0 + 4 + i, nks - 1);
          unxt[i] = *(const bf16x8*)&ub[(size_t)(2 * ksn + (l4 >> 1)) * 4096 + c0];
        }
#pragma unroll
        for (int i = 0; i < 4; i++) {
          const int ks = ks0 + i;
#pragma unroll
          for (int sl = 0; sl < 16; sl++) {
            int sidx = qd * 16 + sl;
            if (sidx >= 2 * ks) {
              bf16x8 afr = *(const bf16x8*)(kbase_l + (sidx - 2 * ks) * 512);
              acc[sl] = __builtin_amdgcn_mfma_f32_16x16x32_bf16(afr, ucur[i], acc[sl], 0, 0, 0);
            }
          }
        }
#pragma unroll
        for (int i = 0; i < 4; i++) ucur[i] = unxt[i];
      }
#pragma unroll
      for (int kk = 0; kk < 4; kk++) {
        bf16x8 bfr = *(const bf16x8*)&xpb[kk * 32 + l4 * 8];
#pragma unroll
        for (int sl = 0; sl < 16; sl++) {
          bf16x8 afr = *(const bf16x8*)(Wl + (sl * 16 + l15) * 272 + (kk * 32 + l4 * 8) * 2);
          acc[sl] = __builtin_amdgcn_mfma_f32_16x16x32_bf16(afr, bfr, acc[sl], 0, 0, 0);
        }
      }
      {
        uint2 uuv[16];
#pragma unroll
        for (int sl = 0; sl < 16; sl++) {
          int t = chunk * 64 + qd * 16 + sl;
          uuv[sl] = *(const uint2*)&uz[(size_t)(b * 4096 + t) * 4096 + g * 16 + l4 * 4];
        }
#pragma unroll
        for (int sl = 0; sl < 16; sl++) {
          int t = chunk * 64 + qd * 16 + sl;
          uint2 uu = uuv[sl];
          float y0 = gelu_tanh(acc[sl][0] + dsk.x * __uint_as_float(uu.x << 16));
          float y1 = gelu_tanh(acc[sl][1] + dsk.y * __uint_as_float(uu.x & 0xffff0000u));
          float y2 = gelu_tanh(acc[sl][2] + dsk.z * __uint_as_float(uu.y << 16));
          float y3 = gelu_tanh(acc[sl][3] + dsk.w * __uint_as_float(uu.y & 0xffff0000u));
          uint2 o;
          o.x = pk_bf16(y0, y1);
          o.y = pk_bf16(y2, y3);
          *(uint2*)&yb[(size_t)(b * 4096 + t) * 2048 + g * 16 + l4 * 4] = o;
        }
      }
    }
  }
}

DEVFN void phase_ssm_b(const int WID, PP p, int layer) {
  const int BID = opaque_bid();
  const int tid = opaque_tid(WID);
  char* ws = p->ws;
  const float2* aq = (const float2*)(ws + OFF_AQ);
  float2* st = (float2*)(ws + OFF_ST);
  u16* xp = (u16*)(ws + OFF_SSM_XP);
  for (int i = BID * 512 + tid; i < 4 * 128 * 64; i += gridDim.x * 512) {
    int n = i & 63, bg = i >> 6, g = bg & 127;
    float2 a = aq[(layer * 128 + g) * 64 + n];
    float xr = 0, xi = 0;
#pragma unroll 1
    for (int c0 = 0; c0 < 64; c0 += 32) {
      float2 sv[32];
#pragma unroll
      for (int k = 0; k < 32; k++) sv[k] = st[((size_t)bg * 64 + c0 + k) * 64 + n];
#pragma unroll
      for (int k = 0; k < 32; k++) {
        xp[((size_t)bg * 64 + c0 + k) * 128 + n] = f2bf(xr);
        xp[((size_t)bg * 64 + c0 + k) * 128 + 64 + n] = f2bf(xi);
        float nr = a.x * xr - a.y * xi + sv[k].x;
        float ni = a.x * xi + a.y * xr + sv[k].y;
        xr = nr; xi = ni;
      }
    }
  }
}

DEVFN void phase_ssm_c(const int WID, PP p, int layer) {
  const int BID = opaque_bid();
  const int tid = opaque_tid(WID), lane = tid & 63, wave = tid >> 6;
  char* ws = p->ws;
  const u16* uz = (const u16*)(ws + OFF_UZ);
  u16* yb = (u16*)(ws + OFF_Y);
  const float2* abar = (const float2*)(ws + OFF_ABAR);
  const float* bbre = (const float*)(ws + OFF_BBRE); const float* bbim = (const float*)(ws + OFF_BBIM);
  const float2* st = (const float2*)(ws + OFF_ST);
  float* Cs = (float*)smem;
  float* uw = (float*)(smem + 8192 + wave * 12416);
  float* xs = uw + 1024;
  for (int task = BID; task < 4096; task += gridDim.x) {
    int bg = task >> 3, co = task & 7; int b = bg >> 7, g = bg & 127;
    int c = co * 8 + wave;
    for (int i = tid; i < 2048; i += 512) {
      int im = i >> 10, cp = (i >> 6) & 15, n = i & 63;
      const float* src = im ? p->c_im : p->c_re;
      Cs[n * 32 + im * 16 + cp] = src[((size_t)(layer * 128 + g) * 16 + cp) * 64 + n];
    }
    {
      int t = c * 64 + lane;
      const u16* up = uz + (size_t)(b * 4096 + t) * 4096 + g * 16;
      bf16x8 u0 = *(const bf16x8*)up, u1 = *(const bf16x8*)(up + 8);
#pragma unroll
      for (int j = 0; j < 8; j++) { uw[lane * 16 + j] = bf2f((u16)u0[j]); uw[lane * 16 + 8 + j] = bf2f((u16)u1[j]); }
    }
    int gi = (layer * 128 + g) * 64 + lane;
    float br[16], bi[16];
#pragma unroll
    for (int k = 0; k < 16; k++) { br[k] = bbre[(size_t)gi * 16 + k]; bi[k] = bbim[(size_t)gi * 16 + k]; }
    float2 a = abar[gi];
    float2 x0 = st[((size_t)bg * 64 + c) * 64 + lane];
    float xr = x0.x, xi = x0.y;
    const int s16 = lane >> 2, cq = lane & 3;
    float4 dsk = *(const float4*)&p->dskip[layer * 2048 + g * 16 + cq * 4];
    __syncthreads();
    for (int sub = 0; sub < 4; sub++) {
      for (int s = 0; s < 16; s++) {
        int sg = sub * 16 + s;
        float bur = 0, bui = 0;
#pragma unroll
        for (int k4 = 0; k4 < 4; k4++) {
          float4 u = *(const float4*)&uw[sg * 16 + k4 * 4];
          bur += br[k4 * 4 + 0] * u.x + br[k4 * 4 + 1] * u.y + br[k4 * 4 + 2] * u.z + br[k4 * 4 + 3] * u.w;
          bui += bi[k4 * 4 + 0] * u.x + bi[k4 * 4 + 1] * u.y + bi[k4 * 4 + 2] * u.z + bi[k4 * 4 + 3] * u.w;
        }
        float nr = a.x * xr - a.y * xi + bur;
        float ni = a.x * xi + a.y * xr + bui;
        xr = nr; xi = ni;
        *(float2*)&xs[s * 130 + 2 * lane] = make_float2(xr, xi);
      }
      __syncthreads();
      float y0 = 0, y1 = 0, y2 = 0, y3 = 0;
#pragma unroll 8
      for (int n = 0; n < 64; n++) {
        float2 xv = *(const float2*)&xs[s16 * 130 + 2 * n];
        float4 cr = *(const float4*)&Cs[n * 32 + cq * 4];
        float4 ci = *(const float4*)&Cs[n * 32 + 16 + cq * 4];
        y0 += cr.x * xv.x - ci.x * xv.y; y1 += cr.y * xv.x - ci.y * xv.y;
        y2 += cr.z * xv.x - ci.z * xv.y; y3 += cr.w * xv.x - ci.w * xv.y;
      }
      int sg = sub * 16 + s16;
      float4 u = *(const float4*)&uw[sg * 16 + cq * 4];
      y0 = gelu_tanh(y0 + dsk.x * u.x); y1 = gelu_tanh(y1 + dsk.y * u.y);
      y2 = gelu_tanh(y2 + dsk.z * u.z); y3 = gelu_tanh(y3 + dsk.w * u.w);
      int t = c * 64 + sg;
      uint2 o;
      o.x = (unsigned)f2bf(y0) | ((unsigned)f2bf(y1) << 16);
      o.y = (unsigned)f2bf(y2) | ((unsigned)f2bf(y3) << 16);
      *(uint2*)&yb[(size_t)(b * 4096 + t) * 2048 + g * 16 + cq * 4] = o;
      __syncthreads();
    }
  }
}

DEVFN void phase_compress(const int WID, PP p) {
  const int BID = opaque_bid();
  const int tid = opaque_tid(WID), lane = tid & 63, wave = tid >> 6;
  char* ws = p->ws;
  const u16* kvb = (const u16*)(ws + OFF_KVB);
  const float* peb = (const float*)(ws + OFF_PEB);
  u16* kc = (u16*)(ws + OFF_KC); u16* vct = (u16*)(ws + OFF_VCT);
  float* red = (float*)smem;
  float* hm = red + 8 * 2048;
  for (int task = BID; task < 510; task += gridDim.x) {
    int kvi = task / 255, tile = task % 255;
    const u16* w1t = (const u16*)(ws + OFF_W1T) + (size_t)kvi * 128 * 4096;
    int R = tile * 16 + (lane & 15);
    int b = R / 1020, rem = R % 1020, n = rem >> 2, g = rem & 3;
    const u16* arow = kvb + (size_t)(b * 4096 + 16 * n) * 3072 + kvi * 512 + g * 128;
    f32x4 acc[8] = {};
#pragma unroll 4
    for (int ks = 0; ks < 16; ks++) {
      int s = wave * 4 + (ks >> 2), d = (ks & 3) * 32 + (lane >> 4) * 8;
      bf16x8 af = *(const bf16x8*)&arow[(size_t)s * 3072 + d];
      int k = wave * 512 + ks * 32 + (lane >> 4) * 8;
#pragma unroll
      for (int nt = 0; nt < 8; nt++) {
        bf16x8 bfr = *(const bf16x8*)&w1t[(size_t)(nt * 16 + (lane & 15)) * 4096 + k];
        acc[nt] = __builtin_amdgcn_mfma_f32_16x16x32_bf16(af, bfr, acc[nt], 0, 0, 0);
      }
    }
#pragma unroll
    for (int nt = 0; nt < 8; nt++)
#pragma unroll
      for (int j = 0; j < 4; j++) red[wave * 2048 + ((lane >> 4) * 4 + j) * 128 + nt * 16 + (lane & 15)] = acc[nt][j];
    __syncthreads();
    for (int i = tid; i < 2048; i += 512) {
      float s = 0;
#pragma unroll
      for (int w = 0; w < 8; w++) s += red[w * 2048 + i];
      hm[i] = gelu_tanh(s + peb[kvi * 128 + (i & 127)]);
    }
    __syncthreads();
    {
      int r = tid >> 5, c0 = (tid & 31) * 4;
      const float* w2 = p->cmp_w2 + (size_t)kvi * 128 * 128;
      float4 o = *(const float4*)&p->cmp_b2[kvi * 128 + c0];
#pragma unroll 16
      for (int k = 0; k < 128; k++) {
        float hv = hm[r * 128 + k];
        float4 w = *(const float4*)&w2[k * 128 + c0];
        o.x += hv * w.x; o.y += hv * w.y; o.z += hv * w.z; o.w += hv * w.w;
      }
      int R2 = tile * 16 + r;
      int b2 = R2 / 1020, rem2 = R2 % 1020, n2 = rem2 >> 2, g2 = rem2 & 3;
      if (kvi == 0) {
        u16* dst = kc + ((size_t)((b2 * 4 + g2) * 256 + n2)) * 128 + c0;
        uint2 pk;
        pk.x = (unsigned)f2bf(o.x) | ((unsigned)f2bf(o.y) << 16);
        pk.y = (unsigned)f2bf(o.z) | ((unsigned)f2bf(o.w) << 16);
        *(uint2*)dst = pk;
      } else {
        u16* dst = vct + ((size_t)((b2 * 4 + g2) * 128 + c0)) * 256 + n2;
        dst[0] = f2bf(o.x); dst[256] = f2bf(o.y); dst[512] = f2bf(o.z); dst[768] = f2bf(o.w);
      }
    }
    __syncthreads();
  }
}

__device__ __forceinline__ float quad_sum(float v) {
  float a = v + __int_as_float(__builtin_amdgcn_update_dpp(0, __float_as_int(v), 0xB1, 0xF, 0xF, false));
  return a + __int_as_float(__builtin_amdgcn_update_dpp(0, __float_as_int(a), 0x4E, 0xF, 0xF, false));
}

DEVFN void phase_n2(const int WID, PP p) {
  const int BID = opaque_bid();
  const int tid = opaque_tid(WID), lane = tid & 63, wave = tid >> 6;
  char* ws = p->ws;
  const u16* q = (const u16*)(ws + OFF_Q);
  const u16* kc = (const u16*)(ws + OFF_KC); const u16* vct = (const u16*)(ws + OFF_VCT);
  u16* sz3 = (u16*)(ws + OFF_SZ3);
  const float* gates = (const float*)(ws + OFF_GATES);
  u64* selm = (u64*)(ws + OFF_SELM);
  char* Kl = smem;
  char* Vl = smem + 69632;
  float* psl = (float*)(smem + 137216) + wave * 256;
  const int l15 = lane & 15, l4 = lane >> 4;
  for (int task = BID; task < 256; task += gridDim.x) {
    const int bg = task >> 4, rr = task & 15;
    const int b = bg >> 2, g = bg & 3;
    const int thi = (31 - rr) * 128;
    const int NTb = min(16, (((thi + 127 - 31) >> 4) + 1 + 15) >> 4);
    __syncthreads();
    for (int ci = tid; ci < ((NTb + 1) & ~1) * 256; ci += 512) {
      int row = ci >> 4, c16 = ci & 15;
      *(uint4*)(Kl + row * 272 + c16 * 16) = *(const uint4*)&kc[((size_t)bg * 256 + row) * 128 + c16 * 8];
    }
    {
      const int cpr = ((NTb + 1) >> 1) * 4;
      for (int ci = tid; ci < 128 * cpr; ci += 512) {
        int row = ci / cpr, ch = ci - row * cpr;
        *(uint4*)(Vl + row * 528 + ch * 16) = *(const uint4*)&vct[((size_t)bg * 128 + row) * 256 + ch * 8];
      }
    }
    __syncthreads();
    const int head = g * 4 + (l15 & 3);
    bf16x8 Qf[4];
    {
      const int tl0 = thi + wave * 16 + (l15 >> 2);
#pragma unroll
      for (int kk = 0; kk < 4; kk++)
        Qf[kk] = *(const bf16x8*)&q[(size_t)(b * 4096 + tl0) * 2048 + head * 128 + kk * 32 + l4 * 8];
    }
#pragma unroll 1
    for (int it = 0; it < 8; it++) {
      const int t0 = ((it < 4) ? thi : rr * 128) + wave * 16 + (it & 3) * 4;
      const int tl = t0 + (l15 >> 2);
      const int tmax = t0 + 3;
      const int nvmax = (tmax >= 31) ? ((tmax - 31) >> 4) + 1 : 0;
      const int NT = (nvmax + 15) >> 4;
      const int nvalid = (tl >= 31) ? ((tl - 31) >> 4) + 1 : 0;
      f32x4 S[16];
#pragma unroll
      for (int kt = 0; kt < 16; kt++) S[kt] = f32x4{0.f, 0.f, 0.f, 0.f};
#pragma unroll
      for (int kp = 0; kp < 8; kp++) {
        if (2 * kp < NT) {
          bf16x8 kf[2][4];
#pragma unroll
          for (int h = 0; h < 2; h++)
#pragma unroll
            for (int kk = 0; kk < 4; kk++)
              kf[h][kk] = *(const bf16x8*)(Kl + ((2 * kp + h) * 16 + l15) * 272 + (kk * 32 + l4 * 8) * 2);
          asm volatile("" ::: "memory");
#pragma unroll
          for (int kk = 0; kk < 4; kk++)
#pragma unroll
            for (int h = 0; h < 2; h++)
              S[2 * kp + h] = __builtin_amdgcn_mfma_f32_16x16x32_bf16(kf[h][kk], Qf[kk], S[2 * kp + h], 0, 0, 0);
        }
      }
      {
        const int itn = (it < 7) ? it + 1 : 7;
        const int tln = ((itn < 4) ? thi : rr * 128) + wave * 16 + (itn & 3) * 4 + (l15 >> 2);
#pragma unroll
        for (int kk = 0; kk < 4; kk++)
          Qf[kk] = *(const bf16x8*)&q[(size_t)(b * 4096 + tln) * 2048 + head * 128 + kk * 32 + l4 * 8];
      }
      float mx = -1e30f;
#pragma unroll
      for (int kt = 0; kt < 16; kt++)
#pragma unroll
        for (int j = 0; j < 4; j++) { bool ok = (kt * 16 + l4 * 4 + j) < nvalid; mx = fmaxf(mx, ok ? S[kt][j] : -1e30f); }
      mx = fmaxf(mx, shx(mx, 16, lane));
      mx = fmaxf(mx, shx(mx, 32, lane));
      float sm = 0.f;
#pragma unroll
      for (int kt = 0; kt < 16; kt++)
#pragma unroll
        for (int j = 0; j < 4; j++) {
          bool ok = (kt * 16 + l4 * 4 + j) < nvalid;
          float e = ok ? __builtin_amdgcn_exp2f(S[kt][j] - mx) : 0.f; S[kt][j] = e; sm += e;
        }
      sm += shx(sm, 16, lane);
      sm += shx(sm, 32, lane);
      const float inv = (sm > 0.f) ? 1.f / sm : 0.f;
#pragma unroll
      for (int kt = 0; kt < 16; kt++)
#pragma unroll
        for (int j = 0; j < 4; j++) S[kt][j] *= inv;
      {
        float v3q[16], wq[16];
#pragma unroll
        for (int kt = 0; kt < 16; kt++) {
          wq[kt] = quad_sum(2.f * (S[kt][0] + S[kt][1] + S[kt][2]) + S[kt][3]);
          v3q[kt] = quad_sum(S[kt][3]);
        }
        const int srcl = (l4 > 0) ? lane - 16 : lane + 48;
#pragma unroll
        for (int kt = 0; kt < 16; kt++) {
          float pub = (l4 == 3) ? ((kt > 0) ? v3q[kt > 0 ? kt - 1 : 0] : 0.f) : v3q[kt];
          float prev = __int_as_float(__builtin_amdgcn_ds_bpermute(srcl << 2, __float_as_int(pub)));
          if ((l15 & 3) == 0) psl[(l15 >> 2) * 64 + kt * 4 + l4] = wq[kt] + prev;
        }
      }
      f32x4 O[8];
#pragma unroll
      for (int dt = 0; dt < 8; dt++) O[dt] = f32x4{0.f, 0.f, 0.f, 0.f};
      const int nks = (NT + 1) >> 1;
      const size_t tok = (size_t)(b * 4096 + tl);
      const float gate = gates[tok * 48 + head];
      uint2 zz[8];
#pragma unroll
      for (int dt = 0; dt < 8; dt++) zz[dt] = *(const uint2*)&sz3[tok * 6144 + head * 128 + dt * 16 + l4 * 4];
#pragma unroll
      for (int ks = 0; ks < 8; ks++) {
        if (ks < nks) {
          bf16x8 pf = mk8(pk_bf16(S[2 * ks][0], S[2 * ks][1]), pk_bf16(S[2 * ks][2], S[2 * ks][3]),
                          pk_bf16(S[2 * ks + 1][0], S[2 * ks + 1][1]), pk_bf16(S[2 * ks + 1][2], S[2 * ks + 1][3]));
          bf16x8 vf[8];
#pragma unroll
          for (int dt = 0; dt < 8; dt++) {
            const char* vrow = Vl + (dt * 16 + l15) * 528 + (ks * 32 + l4 * 4) * 2;
            uint2 h0 = *(const uint2*)(vrow);
            uint2 h1 = *(const uint2*)(vrow + 32);
            vf[dt] = mk8(h0.x, h0.y, h1.x, h1.y);
          }
          asm volatile("" ::: "memory");
#pragma unroll
          for (int dt = 0; dt < 8; dt++) O[dt] = __builtin_amdgcn_mfma_f32_16x16x32_bf16(vf[dt], pf, O[dt], 0, 0, 0);
        }
      }
      {
#pragma unroll
        for (int dt = 0; dt < 8; dt++) {
          size_t zi = tok * 6144 + head * 128 + dt * 16 + l4 * 4;
          uint2 o;
          o.x = pk_bf16(O[dt][0] * gate * __uint_as_float(zz[dt].x << 16), O[dt][1] * gate * __uint_as_float(zz[dt].x & 0xffff0000u));
          o.y = pk_bf16(O[dt][2] * gate * __uint_as_float(zz[dt].y << 16), O[dt][3] * gate * __uint_as_float(zz[dt].y & 0xffff0000u));
          *(uint2*)&sz3[zi] = o;
        }
      }
      __builtin_amdgcn_fence(__ATOMIC_SEQ_CST, "wavefront");
      __builtin_amdgcn_wave_barrier();
#pragma unroll 1
      for (int tk = 0; tk < 4; tk++) {
        int t = t0 + tk, cur = t >> 6;
        float pslv = psl[tk * 64 + lane];
        bool valid = lane <= cur;
        bool forced = (lane == 0) || (lane == cur) || (lane == cur - 1);
        float key = valid ? (forced ? 3e38f : pslv) : -1.f;
        int cnt = 0;
#pragma unroll 4
        for (int jp = 0; jp < 64; jp++) {
          float kp = __int_as_float(__builtin_amdgcn_readlane(__float_as_int(key), jp));
          cnt += ((kp > key) || (kp == key && jp < lane)) ? 1 : 0;
        }
        bool sel = valid && (cnt < 16);
        u64 m = __ballot(sel);
        if (lane == 0) selm[(size_t)bg * 4096 + t] = m;
      }
      __builtin_amdgcn_fence(__ATOMIC_SEQ_CST, "wavefront");
      __builtin_amdgcn_wave_barrier();
    }
  }
}


DEVFN void phase_gates(const int WID, PP p, int j) {
  const int BID = opaque_bid();
  const int tid = opaque_tid(WID), lane = tid & 63, wave = tid >> 6;
  char* ws = p->ws;
  const u16* h = (const u16*)(ws + OFF_HBUF);
  const u16* wg = (const u16*)(ws + OFF_WT_QG) + (size_t)j * 8448 * 2048 + (size_t)8192 * 2048;
  float* gates = (float*)(ws + OFF_GATES);
  float* red = (float*)smem;
  const int l15 = lane & 15, l4 = lane >> 4;
  const int mt = wave & 3, kh = wave >> 2;
  for (int bt = BID; bt < 256; bt += gridDim.x) {
    const int row0 = bt * 64 + mt * 16;
    f32x4 acc[3];
#pragma unroll
    for (int nt = 0; nt < 3; nt++) acc[nt] = f32x4{0.f, 0.f, 0.f, 0.f};
    const u16* ap = h + (size_t)(row0 + l15) * 2048 + kh * 1024 + l4 * 8;
    const u16* bp = wg + (size_t)l15 * 2048 + kh * 1024 + l4 * 8;
#pragma unroll 8
    for (int ks = 0; ks < 32; ks++) {
      bf16x8 af = *(const bf16x8*)&ap[ks * 32];
#pragma unroll
      for (int nt = 0; nt < 3; nt++) {
        bf16x8 bfr = *(const bf16x8*)&bp[(size_t)nt * 16 * 2048 + ks * 32];
        acc[nt] = __builtin_amdgcn_mfma_f32_16x16x32_bf16(af, bfr, acc[nt], 0, 0, 0);
      }
    }
    __syncthreads();
    if (kh == 1) {
#pragma unroll
      for (int nt = 0; nt < 3; nt++)
#pragma unroll
        for (int jj = 0; jj < 4; jj++) red[(mt * 16 + l4 * 4 + jj) * 48 + nt * 16 + l15] = acc[nt][jj];
    }
    __syncthreads();
    if (kh == 0) {
#pragma unroll
      for (int nt = 0; nt < 3; nt++)
#pragma unroll
        for (int jj = 0; jj < 4; jj++) {
          float v = acc[nt][jj] + red[(mt * 16 + l4 * 4 + jj) * 48 + nt * 16 + l15];
          gates[(size_t)(row0 + l4 * 4 + jj) * 48 + nt * 16 + l15] = sigmoidf_(v);
        }
    }
  }
}


DEVFN void phase_n3(const int WID, PP p) {
  const int BID = opaque_bid();
  const int tid = opaque_tid(WID), lane = tid & 63, wave = tid >> 6;
  char* ws = p->ws;
  const u16* q = (const u16*)(ws + OFF_Q);
  const u16* kvb = (const u16*)(ws + OFF_KVB);
  const u16* vt = (const u16*)(ws + OFF_VT);
  u16* sz3 = (u16*)(ws + OFF_SZ3);
  u16* ocomb = (u16*)(ws + OFF_HBUF);
  const float* gates = (const float*)(ws + OFF_GATES);
  const u64* selm = (const u64*)(ws + OFF_SELM);
  char* Ks = smem;
  char* Vs = smem + 32768;
  char* Qs = smem + 65536 + wave * 8704;
  const unsigned lds0 = (unsigned)(unsigned long)(__attribute__((address_space(3))) char*)smem;
  const int l15 = lane & 15, l4 = lane >> 4;
  unsigned koff[2], voff[2];
#pragma unroll
  for (int i = 0; i < 2; i++) {
    int slab = i * 8 + wave;
    int rk = slab * 4 + (lane >> 4), ck = (lane & 15) ^ (rk & 15);
    koff[i] = (unsigned)(rk * 3072 + ck * 8) * 2u;
    int rv = slab * 8 + (lane >> 3), cv = (lane & 7) ^ ((rv >> 1) & 7);
    voff[i] = (unsigned)(rv * 4096 + cv * 8) * 2u;
  }
  const unsigned slab0 = (unsigned)__builtin_amdgcn_readfirstlane(wave * 1024);
#define N3_DMA(voffv, sbase, ldsa) asm volatile("s_mov_b32 m0, %2\n\ts_nop 0\n\tglobal_load_lds_dwordx4 %0, %1" :: "v"(voffv), "s"(sbase), "s"(ldsa) : "memory")
  int kofs[4], vofs[4];
#pragma unroll
  for (int kk = 0; kk < 4; kk++) kofs[kk] = l15 * 256 + (((kk * 4 + l4) ^ l15) & 15) * 16;
#pragma unroll
  for (int c = 0; c < 4; c++) {
    int logical = (c >> 1) * 4 + (l4 >> 1) + (c & 1) * 2;
    vofs[c] = l15 * 128 + ((logical ^ ((l15 >> 1) & 7)) & 7) * 16 + (l4 & 1) * 8;
  }
  const int qofs = l15 * 272 + l4 * 16;
  for (int task = BID; task < 512; task += gridDim.x) {
    int bg = task >> 5, pp = task & 31; int b = bg >> 2, g = bg & 3;
#pragma unroll 1
    for (int half = 0; half < 2; half++) {
      int cur = half ? pp : 63 - pp;
      int tq0 = cur * 64 + wave * 8;
#pragma unroll
      for (int i = 0; i < 8; i++) {
        int ci = lane + 64 * i; int row = ci >> 4, c16 = ci & 15;
        uint4 v = *(const uint4*)&q[(size_t)(b * 4096 + tq0 + (row >> 2)) * 2048 + (g * 4 + (row & 3)) * 128 + c16 * 8];
        *(uint4*)(Qs + row * 272 + c16 * 16) = v;
      }
      __builtin_amdgcn_fence(__ATOMIC_SEQ_CST, "wavefront");
      __builtin_amdgcn_wave_barrier();
      int tokL[2]; u64 sm_[2];
#pragma unroll
      for (int mt = 0; mt < 2; mt++) { tokL[mt] = tq0 + mt * 4 + (l15 >> 2); sm_[mt] = selm[(size_t)bg * 4096 + tokL[mt]]; }
      u64 wm = 0;
#pragma unroll
      for (int i = 0; i < 8; i++) wm |= selm[(size_t)bg * 4096 + tq0 + i];
      const int head = g * 4 + (l15 & 3);
#pragma unroll 1
      for (int mode = 0; mode < 2; mode++) {
        int jb0 = (mode == 0) ? 0 : max(0, cur - 8);
        int ntile = cur - jb0 + 1;
        int kbr = (mode == 0) ? 2 : 4;
        const u16* kbase = kvb + (size_t)b * 4096 * 3072 + kbr * 512 + g * 128;
        const u16* vbase = vt + (size_t)((mode * 4 + b) * 4 + g) * 128 * 4096;
        f32x4 O[8][2];
        float mrow[2], ls[2];
#pragma unroll
        for (int mt = 0; mt < 2; mt++) {
#pragma unroll
          for (int dt = 0; dt < 8; dt++) O[dt][mt] = f32x4{0.f, 0.f, 0.f, 0.f};
          mrow[mt] = -1e30f; ls[mt] = 0.f;
        }
        __syncthreads();
        {
          const char* kb_ = (const char*)(kbase + (size_t)jb0 * 64 * 3072);
          const char* vb_ = (const char*)(vbase + (size_t)jb0 * 64);
          N3_DMA(koff[0], kb_, lds0 + slab0);
          N3_DMA(koff[1], kb_, lds0 + slab0 + 8192u);
          N3_DMA(voff[0], vb_, lds0 + 32768u + slab0);
          N3_DMA(voff[1], vb_, lds0 + 32768u + slab0 + 8192u);
        }
        asm volatile("s_waitcnt vmcnt(0)" ::: "memory");
        __syncthreads();
        for (int it = 0; it < ntile; it++) {
          int jb = jb0 + it;
          const int jn = (it + 1 < ntile) ? jb + 1 : jb;
          {
            const unsigned nb = (unsigned)((it + 1) & 1) * 16384u;
            const char* kb_ = (const char*)(kbase + (size_t)jn * 64 * 3072);
            const char* vb_ = (const char*)(vbase + (size_t)jn * 64);
            N3_DMA(koff[0], kb_, lds0 + nb + slab0);
            N3_DMA(koff[1], kb_, lds0 + nb + slab0 + 8192u);
            N3_DMA(voff[0], vb_, lds0 + 32768u + nb + slab0);
            N3_DMA(voff[1], vb_, lds0 + 32768u + nb + slab0 + 8192u);
          }
          const char* Kc = Ks + (it & 1) * 16384;
          const char* Vc = Vs + (it & 1) * 16384;
          bool act = (mode == 1) || ((wm >> jb) & 1ull);
          if (act) {
            f32x4 S[4][2];
#pragma unroll
            for (int nt = 0; nt < 4; nt++)
#pragma unroll
              for (int mt = 0; mt < 2; mt++) S[nt][mt] = f32x4{0.f, 0.f, 0.f, 0.f};
#define N3_LOADKQ(kk, qf, kf) do { \
              _Pragma("unroll") for (int mt = 0; mt < 2; mt++) qf[mt] = *(const bf16x8*)(Qs + qofs + mt * 4352 + (kk) * 64); \
              _Pragma("unroll") for (int nt = 0; nt < 4; nt++) kf[nt] = *(const bf16x8*)(Kc + kofs[kk] + nt * 4096); } while (0)
#define N3_MMAS(qf, kf) do { \
              _Pragma("unroll") for (int nt = 0; nt < 4; nt++) \
              _Pragma("unroll") for (int mt = 0; mt < 2; mt++) S[nt][mt] = __builtin_amdgcn_mfma_f32_16x16x32_bf16(kf[nt], qf[mt], S[nt][mt], 0, 0, 0); } while (0)
#define CBAR asm volatile("" ::: "memory")
            {
              bf16x8 qa[2], ka[4], qb[2], kb[4];
              N3_LOADKQ(0, qa, ka); CBAR;
              N3_LOADKQ(1, qb, kb); CBAR;
              N3_MMAS(qa, ka);
              N3_LOADKQ(2, qa, ka); CBAR;
              N3_MMAS(qb, kb);
              N3_LOADKQ(3, qb, kb); CBAR;
              N3_MMAS(qa, ka);
              N3_MMAS(qb, kb);
            }
            const bool interior = (mode == 0) ? (jb < cur) : (jb < cur && jb > cur - 8);
            bf16x8 Pf[2][2];
            float alpha[2];
#pragma unroll
            for (int mt = 0; mt < 2; mt++) {
              const bool rowok = (mode == 1) || ((sm_[mt] >> jb) & 1ull);
              const int tt = tokL[mt];
              float mx = -1e30f;
              float psum = 0.f;
              if (interior) {
#pragma unroll
                for (int nt = 0; nt < 4; nt++)
#pragma unroll
                  for (int j = 0; j < 4; j++) mx = fmaxf(mx, S[nt][mt][j]);
                mx = rowok ? mx : -1e30f;
                mx = fmaxf(mx, shx(mx, 16, lane));
                mx = fmaxf(mx, shx(mx, 32, lane));
                float mnew = fmaxf(mrow[mt], mx);
                alpha[mt] = __builtin_amdgcn_exp2f(mrow[mt] - mnew);
                mrow[mt] = mnew;
                const float msub = rowok ? mnew : 1e30f;
#pragma unroll
                for (int nt = 0; nt < 4; nt++)
#pragma unroll
                  for (int j = 0; j < 4; j++) { float pv = __builtin_amdgcn_exp2f(S[nt][mt][j] - msub); S[nt][mt][j] = pv; psum += pv; }
              } else {
#pragma unroll
                for (int nt = 0; nt < 4; nt++)
#pragma unroll
                  for (int j = 0; j < 4; j++) {
                    int kp = jb * 64 + nt * 16 + l4 * 4 + j;
                    bool ok = rowok && (kp <= tt) && ((mode == 0) || (kp + 512 > tt));
                    float sv = ok ? S[nt][mt][j] : -1e30f; S[nt][mt][j] = sv; mx = fmaxf(mx, sv);
                  }
                mx = fmaxf(mx, shx(mx, 16, lane));
                mx = fmaxf(mx, shx(mx, 32, lane));
                float mnew = fmaxf(mrow[mt], mx);
                alpha[mt] = __builtin_amdgcn_exp2f(mrow[mt] - mnew);
                mrow[mt] = mnew;
#pragma unroll
                for (int nt = 0; nt < 4; nt++)
#pragma unroll
                  for (int j = 0; j < 4; j++) {
                    float sv = S[nt][mt][j];
                    float pv = (sv > -1e29f) ? __builtin_amdgcn_exp2f(sv - mnew) : 0.f;
                    S[nt][mt][j] = pv; psum += pv;
                  }
              }
              ls[mt] = ls[mt] * alpha[mt] + psum;
#pragma unroll
              for (int ks = 0; ks < 2; ks++) {
                Pf[mt][ks] = mk8(pk_bf16(S[2 * ks][mt][0], S[2 * ks][mt][1]), pk_bf16(S[2 * ks][mt][2], S[2 * ks][mt][3]),
                                 pk_bf16(S[2 * ks + 1][mt][0], S[2 * ks + 1][mt][1]), pk_bf16(S[2 * ks + 1][mt][2], S[2 * ks + 1][mt][3]));
              }
            }
            if (__builtin_amdgcn_ballot_w64((alpha[0] != 1.f) || (alpha[1] != 1.f)) != 0ull) {
#pragma unroll
              for (int mt = 0; mt < 2; mt++)
#pragma unroll
                for (int dt = 0; dt < 8; dt++)
#pragma unroll
                  for (int j = 0; j < 4; j++) O[dt][mt][j] *= alpha[mt];
            }
#define N3_LOADV(ks, d0, vf) do { \
              _Pragma("unroll") for (int dd = 0; dd < 4; dd++) { \
                uint2 h0 = *(const uint2*)(Vc + vofs[(ks) * 2] + ((d0) + dd) * 2048); uint2 h1 = *(const uint2*)(Vc + vofs[(ks) * 2 + 1] + ((d0) + dd) * 2048); \
                vf[dd] = mk8(h0.x, h0.y, h1.x, h1.y); } } while (0)
#define N3_MMAV(ks, d0, vf) do { \
              _Pragma("unroll") for (int dd = 0; dd < 4; dd++) \
              _Pragma("unroll") for (int mt = 0; mt < 2; mt++) O[(d0) + dd][mt] = __builtin_amdgcn_mfma_f32_16x16x32_bf16(vf[dd], Pf[mt][ks], O[(d0) + dd][mt], 0, 0, 0); } while (0)
            {
              bf16x8 va[4], vb[4];
              N3_LOADV(0, 0, va); CBAR;
              N3_LOADV(0, 4, vb); CBAR;
              N3_MMAV(0, 0, va);
              N3_LOADV(1, 0, va); CBAR;
              N3_MMAV(0, 4, vb);
              N3_LOADV(1, 4, vb); CBAR;
              N3_MMAV(1, 0, va);
              N3_MMAV(1, 4, vb);
            }
          }
          asm volatile("s_waitcnt vmcnt(0)" ::: "memory");
          __syncthreads();
        }
#pragma unroll
        for (int mt = 0; mt < 2; mt++) {
          size_t tok = (size_t)(b * 4096 + tokL[mt]);
          float l = ls[mt];
          l += shx(l, 16, lane);
          l += shx(l, 32, lane);
          float inv = (l > 0.f) ? 1.f / l : 0.f;
          float gate = gates[tok * 48 + (mode + 1) * 16 + head] * inv;
#pragma unroll
          for (int dt = 0; dt < 8; dt++) {
            int d0 = dt * 16 + l4 * 4;
            size_t zi = tok * 6144 + (size_t)(mode + 1) * 2048 + head * 128 + d0;
            uint2 zz = *(const uint2*)&sz3[zi];
            float v0 = O[dt][mt][0] * gate * __uint_as_float(zz.x << 16);
            float v1 = O[dt][mt][1] * gate * __uint_as_float(zz.x & 0xffff0000u);
            float v2 = O[dt][mt][2] * gate * __uint_as_float(zz.y << 16);
            float v3 = O[dt][mt][3] * gate * __uint_as_float(zz.y & 0xffff0000u);
            if (mode == 0) {
              uint2 o; o.x = pk_bf16(v0, v1); o.y = pk_bf16(v2, v3);
              *(uint2*)&ocomb[tok * 2048 + head * 128 + d0] = o;
            } else {
              uint2 c0 = *(const uint2*)&sz3[tok * 6144 + head * 128 + d0];
              uint2 c1 = *(const uint2*)&ocomb[tok * 2048 + head * 128 + d0];
              v0 += __uint_as_float(c0.x << 16) + __uint_as_float(c1.x << 16);
              v1 += __uint_as_float(c0.x & 0xffff0000u) + __uint_as_float(c1.x & 0xffff0000u);
              v2 += __uint_as_float(c0.y << 16) + __uint_as_float(c1.y << 16);
              v3 += __uint_as_float(c0.y & 0xffff0000u) + __uint_as_float(c1.y & 0xffff0000u);
              uint2 o; o.x = pk_bf16(v0, v1); o.y = pk_bf16(v2, v3);
              *(uint2*)&ocomb[tok * 2048 + head * 128 + d0] = o;
            }
          }
        }
      }
    }
  }
}

constexpr int N_PHASES = 27;

DEVFN void decode_phase(int ph, int& kind, int& arg) {
  arg = 0;
  if (ph == 0) kind = 0;
  else if (ph <= 14) { arg = (ph - 1) / 7; kind = 1 + (ph - 1) % 7; }
  else {
    switch (ph) {
      case 15: kind = 1; arg = 2; break;
      case 16: kind = 8; break;
      case 17: kind = 10; arg = 0; break;
      case 18: kind = 11; break;
      case 19: kind = 12; break;
      case 20: kind = 7; arg = 2; break;
      case 21: kind = 1; arg = 3; break;
      case 22: kind = 10; arg = 1; break;
      case 23: kind = 11; break;
      case 24: kind = 12; break;
      case 25: kind = 7; arg = 3; break;
      default: kind = 13; break;
    }
  }
}
static void decode_phase_host(int ph, int& kind, int& arg) {
  arg = 0;
  if (ph == 0) kind = 0;
  else if (ph <= 14) { arg = (ph - 1) / 7; kind = 1 + (ph - 1) % 7; }
  else {
    const int kk[12] = {1, 8, 10, 11, 12, 7, 1, 10, 11, 12, 7, 13};
    const int aa[12] = {2, 0, 0, 0, 0, 2, 3, 1, 0, 0, 3, 0};
    kind = kk[ph - 15]; arg = aa[ph - 15];
  }
}

template <int KIND>
DEVFN void run_kind(const int WID, PP p, int arg) {
  char* ws = p->ws;
  if constexpr (KIND == 0) phase_prep(WID, p);
  else if constexpr (KIND == 1) { phase_prenorm(WID, p, arg, arg == 2); if (arg < 2) phase_ssm_gen(WID, p, arg); if (arg == 2) phase_peb_final(WID, p); }
  else if constexpr (KIND == 2) gemm_phase<EPI_S1>(WID, p, (const u16*)(ws + OFF_HBUF), (const u16*)(ws + OFF_WT_IN) + (size_t)arg * 4096 * 2048, 4096, arg);
  else if constexpr (KIND == 3) phase_ssm_x1(WID, p, arg);
  else if constexpr (KIND == 4) phase_ssm_b(WID, p, arg);
  else if constexpr (KIND == 5) phase_ssm_x3(WID, p, arg);
  else if constexpr (KIND == 6) gemm_phase<EPI_S3>(WID, p, (const u16*)(ws + OFF_Y), (const u16*)(ws + OFF_WT_GLU) + (size_t)arg * 2048 * 2048, 2048, arg);
  else if constexpr (KIND == 7) {
    const u16* A = (arg < 2) ? (const u16*)(ws + OFF_V) : (const u16*)(ws + OFF_HBUF);
    const u16* B = (arg < 2) ? (const u16*)(ws + OFF_WT_OUT) + (size_t)arg * 2048 * 2048
                             : (const u16*)(ws + OFF_WT_O) + (size_t)(arg - 2) * 2048 * 2048;
    gemm_phase<EPI_RES>(WID, p, A, B, 2048, arg);
  }
  else if constexpr (KIND == 8) gemm_phase<EPI_KV>(WID, p, (const u16*)(ws + OFF_HKV), (const u16*)(ws + OFF_WT_KV), 3072, 0);
  else if constexpr (KIND == 9) { }
  else if constexpr (KIND == 10) {
    if (arg == 0) phase_compress(WID, p);
    __syncthreads();
    phase_gates(WID, p, arg);
    __syncthreads();
    gemm_phase<EPI_QG>(WID, p, (const u16*)(ws + OFF_HBUF), (const u16*)(ws + OFF_WT_QG) + (size_t)arg * 8448 * 2048, 8192, arg);
  }
  else if constexpr (KIND == 11) phase_n2(WID, p);
  else if constexpr (KIND == 12) phase_n3(WID, p);
  else phase_final(WID, p);
}


#define XB_TMO      128
#define XB_XCNT(j)  (256  + 64 * (j))
#define XB_XSUB(j)  (1280 + 64 * (j))
#define XB_XGEN(j)  (2304 + 64 * (j))
#define XB_TOP      3328
#define XB_TOPGEN   3392
#define XCD_BAR_WORDS 3456
#define XB_SPIN_CAP (1u << 20)
#define LAS __attribute__((address_space(3)))
__device__ __forceinline__ unsigned xb_ld(unsigned* p)              { return __hip_atomic_load(p, __ATOMIC_RELAXED, __HIP_MEMORY_SCOPE_AGENT); }
__device__ __forceinline__ unsigned xb_add(unsigned* p, unsigned v) { return __hip_atomic_fetch_add(p, v, __ATOMIC_RELAXED, __HIP_MEMORY_SCOPE_AGENT); }
__device__ __forceinline__ unsigned xb_xcc_id() { return (unsigned)__builtin_amdgcn_s_getreg((3 << 11) | 20) & 0xFu; }
#define XB_SPIN(cond, bar) do { unsigned _sp = 0; while (cond) { __builtin_amdgcn_s_sleep(1); \
    if ((++_sp & 255u) == 0u) { if (xb_ld(&(bar)[XB_TMO])) break; if (_sp > XB_SPIN_CAP) { atomicAdd(&(bar)[XB_TMO], 1u); break; } } } } while (0)
struct XcdBarrier { unsigned* bar; unsigned x; volatile LAS unsigned* st; };
__device__ __forceinline__ XcdBarrier xcd_barrier_post(unsigned* bar, volatile LAS unsigned* st) {
  XcdBarrier b; b.bar = bar; b.x = xb_xcc_id(); b.st = st;
  if (threadIdx.x == 0) (void)xb_add(&bar[XB_XCNT(b.x)], 1u);
  return b;
}
__device__ __forceinline__ void xcd_barrier_complete(unsigned* bar, unsigned x, unsigned& nloc, unsigned& nx) {
  const unsigned G = gridDim.x * gridDim.y * gridDim.z;
  unsigned sum, cnt, mine, sp = 0u;
  for (;;) {
    sum = 0u; cnt = 0u; mine = 0u;
#pragma unroll
    for (unsigned j = 0; j < 16; ++j) { const unsigned c = xb_ld(&bar[XB_XCNT(j)]); sum += c; cnt += (c > 0u) ? 1u : 0u; mine = (j == x) ? c : mine; }
    if (sum == G) break;
    __builtin_amdgcn_s_sleep(1);
    if ((++sp & 255u) == 0u) { if (xb_ld(&bar[XB_TMO])) break; if (sp > XB_SPIN_CAP) { atomicAdd(&bar[XB_TMO], 1u); break; } }
  }
  nloc = mine > 0u ? mine : 1u; nx = cnt > 0u ? cnt : 1u;
}
__device__ __forceinline__ void xcd_barrier(const XcdBarrier& b, const int WID) {
  asm volatile("s_waitcnt vmcnt(0)" ::: "memory");
  __syncthreads();
  if (opaque_tid(WID) == 0) {
    unsigned* bar = b.bar; asm volatile("" : "+s"(bar));
    __builtin_amdgcn_s_waitcnt(0);
    unsigned nloc = b.st[0], nx = b.st[1];
    if (nloc == 0u) { xcd_barrier_complete(bar, b.x, nloc, nx); b.st[0] = nloc; b.st[1] = nx; }
    const unsigned old = xb_add(&bar[XB_XSUB(b.x)], 1u);
    const unsigned gen = old / nloc;
    if (old + 1u == (gen + 1u) * nloc) {
      __builtin_amdgcn_fence(__ATOMIC_RELEASE, "agent");
      asm volatile("s_waitcnt vmcnt(0)" ::: "memory");
      const unsigned og = xb_add(&bar[XB_TOP], 1u);
      const unsigned tg = og / nx;
      if (og + 1u == (tg + 1u) * nx) xb_add(&bar[XB_TOPGEN], 1u);
      else XB_SPIN(xb_ld(&bar[XB_TOPGEN]) == tg, bar);
      __builtin_amdgcn_fence(__ATOMIC_ACQUIRE, "agent");
      xb_add(&bar[XB_XGEN(b.x)], 1u);
      asm volatile("s_waitcnt vmcnt(0)" ::: "memory");
    } else {
      XB_SPIN(xb_ld(&bar[XB_XGEN(b.x)]) == gen, bar);
      __builtin_amdgcn_fence(__ATOMIC_ACQUIRE, "agent");
      asm volatile("s_waitcnt vmcnt(0)" ::: "memory");
    }
  }
  __syncthreads();
}

#if ONE_LAUNCH
__global__ void __launch_bounds__(512) mega(Params pv, int lo, int hi) {
  cg::grid_group grid = cg::this_grid();
  PP pp = (PP)__builtin_amdgcn_kernarg_segment_ptr();
  const int WID = __builtin_amdgcn_readfirstlane((int)(threadIdx.x >> 6));
  __shared__ uint4 xb_words;
  if (threadIdx.x == 0) xb_words = make_uint4(0u, 0u, 0u, 0u);
  __syncthreads();
  XcdBarrier xb = xcd_barrier_post((unsigned*)(pp->ws + OFF_BAR), (volatile LAS unsigned*)&xb_words);
  for (int ph = lo; ph < hi; ph++) {
    PP p = opaque_pp(pp);
    int kind, arg;
    decode_phase(ph, kind, arg);
#if REPEAT_MASK
    for (int rep = 0; rep < (((REPEAT_MASK >> kind) & 1) ? 2 : 1); rep++) {
    if (rep) xcd_barrier(xb, WID);
#endif
    switch (kind) {
      case 0: run_kind<0>(WID, p, arg); break;
      case 1: run_kind<1>(WID, p, arg); break;
      case 2: run_kind<2>(WID, p, arg); break;
      case 3: run_kind<3>(WID, p, arg); break;
      case 4: run_kind<4>(WID, p, arg); break;
      case 5: run_kind<5>(WID, p, arg); break;
      case 6: run_kind<6>(WID, p, arg); break;
      case 7: run_kind<7>(WID, p, arg); break;
      case 8: run_kind<8>(WID, p, arg); break;
      case 9: run_kind<9>(WID, p, arg); break;
      case 10: run_kind<10>(WID, p, arg); break;
      case 11: run_kind<11>(WID, p, arg); break;
      case 12: run_kind<12>(WID, p, arg); break;
      default: run_kind<13>(WID, p, arg); break;
    }
#if REPEAT_MASK
    }
#endif
    if (ph + 1 < hi) {
      if (hi > 1000) grid.sync();
      xcd_barrier(xb, WID);
    }
  }
}
#else
template <int KIND>
__global__ void __launch_bounds__(512) pk(Params pv, int arg) {
  PP p = opaque_pp((PP)__builtin_amdgcn_kernarg_segment_ptr());
  const int WID = __builtin_amdgcn_readfirstlane((int)(threadIdx.x >> 6));
  run_kind<KIND>(WID, p, arg);
}
template <int KIND>
static void launch_kind(const Params& p, int arg, int grid, hipStream_t stream) {
  static bool attr_set = false;
  if (!attr_set) { (void)hipFuncSetAttribute((const void*)pk<KIND>, hipFuncAttributeMaxDynamicSharedMemorySize, LDS_BYTES); attr_set = true; }
  hipLaunchKernelGGL(pk<KIND>, dim3(grid), dim3(512), LDS_BYTES, stream, p, arg);
}
#endif

extern "C" void kernel_launch(void* const* d_in, const int* in_sizes, int n_in, void* d_out, int out_size, void* d_ws,
                              size_t ws_size, hipStream_t stream) {
  Params p{};
  const float** f = (const float**)&p;
  for (int i = 0; i < 29; i++) f[i] = (const float*)d_in[i];
  p.out = (float*)d_out;
  p.ws = (char*)d_ws;
#if ONE_LAUNCH
  static int grid_blocks = 0;
  if (!grid_blocks) {
    (void)hipFuncSetAttribute((const void*)mega, hipFuncAttributeMaxDynamicSharedMemorySize, LDS_BYTES);
    int dev = 0, cus = 0, per_cu = 0;
    (void)hipGetDevice(&dev);
    (void)hipDeviceGetAttribute(&cus, hipDeviceAttributeMultiprocessorCount, dev);
    (void)hipOccupancyMaxActiveBlocksPerMultiprocessor(&per_cu, mega, 512, LDS_BYTES);
    if (per_cu < 1) per_cu = 1;
    grid_blocks = cus * per_cu;
    if (ws_size < WS_NEEDED) fprintf(stderr, "workspace too small: %zu < %zu\n", ws_size, (size_t)WS_NEEDED);
  }
  (void)hipMemsetAsync((char*)d_ws + OFF_BAR, 0, 16384, stream);
  int lo = 0, hi = N_PHASES;
  void* args[] = {&p, &lo, &hi};
  hipError_t e = hipLaunchCooperativeKernel((void*)mega, dim3(grid_blocks), dim3(512), args, LDS_BYTES, stream);
  if (e != hipSuccess) fprintf(stderr, "cooperative launch failed: %s (grid %d)\n", hipGetErrorString(e), grid_blocks);
#else
  const int grid = 256;
  for (int ph = 0; ph < N_PHASES; ph++) {
    int kind, arg;
    decode_phase_host(ph, kind, arg);
    for (int rep = 0; rep < (((REPEAT_MASK >> kind) & 1) ? 2 : 1); rep++)
    switch (kind) {
      case 0: launch_kind<0>(p, arg, grid, stream); break;
      case 1: launch_kind<1>(p, arg, grid, stream); break;
      case 2: launch_kind<2>(p, arg, grid, stream); break;
      case 3: launch_kind<3>(p, arg, grid, stream); break;
      case 4: launch_kind<4>(p, arg, grid, stream); break;
      case 5: launch_kind<5>(p, arg, grid, stream); break;
      case 6: launch_kind<6>(p, arg, grid, stream); break;
      case 7: launch_kind<7>(p, arg, grid, stream); break;
      case 8: launch_kind<8>(p, arg, grid, stream); break;
      case 9: launch_kind<9>(p, arg, grid, stream); break;
      case 10: launch_kind<10>(p, arg, grid, stream); break;
      case 11: launch_kind<11>(p, arg, grid, stream); break;
      case 12: launch_kind<12>(p, arg, grid, stream); break;
      default: launch_kind<13>(p, arg, grid, stream); break;
    }
  }
#endif
}
```

```cpp
#include <hip/hip_runtime.h>
#include <hip/hip_bf16.h>
#include <hip/hip_cooperative_groups.h>
#include <cstdio>
namespace cg = cooperative_groups;

typedef unsigned short u16;
typedef unsigned long long u64;
using bf16x8 = __attribute__((ext_vector_type(8))) short;
using f32x4 = __attribute__((ext_vector_type(4))) float;

#ifndef ONE_LAUNCH
#define ONE_LAUNCH 1
#endif
#ifndef REPEAT_MASK
#define REPEAT_MASK 0
#endif

constexpr int T_ = 16384, L_ = 4096, D_ = 2048;
constexpr size_t MB = 1ull << 20;
constexpr size_t OFF_WT_IN = 0;
constexpr size_t OFF_WT_GLU = 32 * MB;
constexpr size_t OFF_WT_OUT = 48 * MB;
constexpr size_t OFF_WT_KV = 64 * MB;
constexpr size_t OFF_WT_QG = 76 * MB;
constexpr size_t OFF_WT_O = 142 * MB;
constexpr size_t OFF_W1T = 158 * MB;
constexpr size_t OFF_SMALL = 160 * MB;
constexpr size_t OFF_MODV = OFF_SMALL;
constexpr size_t OFF_KVMOD = OFF_SMALL + 512 * 1024;
constexpr size_t OFF_ABAR = OFF_SMALL + 1 * MB;
constexpr size_t OFF_AQ = OFF_ABAR + 256 * 1024;
constexpr size_t OFF_PEB = OFF_AQ + 256 * 1024;
constexpr size_t OFF_PEBP = OFF_SMALL + 6 * MB;
constexpr size_t OFF_BBRE = OFF_SMALL + 2 * MB;
constexpr size_t OFF_BBIM = OFF_SMALL + 3 * MB;
constexpr size_t OFF_BAR = OFF_SMALL + 5 * MB;
constexpr size_t OFF_KC = 168 * MB;
constexpr size_t OFF_VCT = 169 * MB;
constexpr size_t OFF_SELM = 170 * MB;
constexpr size_t OFF_XBUF = 172 * MB;
constexpr size_t OFF_HBUF = 300 * MB;
constexpr size_t OFF_R = 364 * MB;
constexpr size_t OFF_UZ = OFF_R;
constexpr size_t OFF_Y = OFF_R + 128 * MB;
constexpr size_t OFF_V = OFF_R + 192 * MB;
constexpr size_t OFF_ST = OFF_R + 256 * MB;
constexpr size_t OFF_SSM_KT = OFF_R + 272 * MB;
constexpr size_t OFF_SSM_W1 = OFF_R + 276 * MB;
constexpr size_t OFF_SSM_W2 = OFF_R + 308 * MB;
constexpr size_t OFF_SSM_XP = OFF_R + 340 * MB;
constexpr size_t OFF_KVB = OFF_R;
constexpr size_t OFF_VT = OFF_R + 96 * MB;
constexpr size_t OFF_Q = OFF_R + 128 * MB;
constexpr size_t OFF_SZ3 = OFF_R + 192 * MB;
constexpr size_t OFF_HKV = OFF_SZ3;
constexpr size_t OFF_GATES = OFF_R + 384 * MB;
constexpr size_t WS_NEEDED = OFF_GATES + 4 * MB;

constexpr int LDS_BYTES = 145408;

struct Params {
  const float *x, *c, *norm_g, *mod_w, *mod_b, *w_in, *lam_re, *lam_im, *log_step, *b_re, *b_im, *c_re, *c_im,
      *dskip, *w_glu, *b_glu, *w_out, *kv_norm_g, *kv_mod_w, *kv_mod_b, *w_kv, *cmp_pe, *cmp_w1, *cmp_b1, *cmp_w2,
      *cmp_b2, *w_qg, *w_o, *final_g;
  float* out;
  char* ws;
};

typedef const __attribute__((address_space(4))) Params* PP;
#define DEVFN __device__ __attribute__((always_inline)) inline

extern __shared__ __attribute__((aligned(16))) char smem[];
__device__ __forceinline__ int opaque_tid(int wid) { unsigned z = 0; asm volatile("" : "+v"(z)); return wid * 64 + (int)__builtin_amdgcn_mbcnt_hi(~0u, __builtin_amdgcn_mbcnt_lo(~0u, z)); }
__device__ __forceinline__ int opaque_bid() { int v = blockIdx.x; asm volatile("" : "+s"(v)); return v; }
__device__ __forceinline__ float shx(float v, int mask, int lane) {
  return __int_as_float(__builtin_amdgcn_ds_bpermute((lane ^ mask) << 2, __float_as_int(v)));
}
__device__ __forceinline__ PP opaque_pp(PP p) { asm volatile("" : "+s"(p)); return p; }

__device__ __forceinline__ u16 f2bf(float f) {
  unsigned u = __float_as_uint(f);
  u += 0x7fffu + ((u >> 16) & 1u);
  return (u16)(u >> 16);
}
__device__ __forceinline__ unsigned pk_bf16(float lo, float hi) {
  unsigned r; asm("v_cvt_pk_bf16_f32 %0, %1, %2" : "=v"(r) : "v"(lo), "v"(hi)); return r;
}
typedef unsigned u32x4 __attribute__((ext_vector_type(4)));
__device__ __forceinline__ bf16x8 mk8(unsigned a, unsigned b, unsigned c, unsigned d) { u32x4 t = {a, b, c, d}; return __builtin_bit_cast(bf16x8, t); }
__device__ __forceinline__ float bf2f(u16 h) { return __uint_as_float(((unsigned)h) << 16); }
__device__ __forceinline__ float sigmoidf_(float x) { return __builtin_amdgcn_rcpf(1.f + __expf(-x)); }
__device__ __forceinline__ float siluf_(float x) { return x * __builtin_amdgcn_rcpf(1.f + __expf(-x)); }
__device__ __forceinline__ float gelu_tanh(float x) {
  float u2 = 1.5957691216057308f * (x + 0.044715f * x * x * x);
  return x * __builtin_amdgcn_rcpf(1.f + __expf(-u2));
}
__device__ __forceinline__ float wave_sum(float v, int lane) {
#pragma unroll
  for (int o = 32; o > 0; o >>= 1) v += shx(v, o, lane);
  return v;
}

DEVFN void xpose(const int WID, const float* __restrict__ src, u16* __restrict__ dst, int K, int Nsrc, int Ndst, int mode) {
  const int BID = opaque_bid();
  float* tile = (float*)smem;
  const int tid = opaque_tid(WID);
  const int tilesK = K / 64, nt = (Ndst / 64) * tilesK;
  const int kr = tid >> 4, nc = (tid & 15) * 4;
  const int n = tid >> 3, kc = (tid & 7) * 8;
  int t = BID;
  if (t >= nt) return;
  float4 cur0, cur1;
  {
    int tn = t / tilesK, tk = t - tn * tilesK; int n0 = tn * 64, k0 = tk * 64;
    int sc0 = n0, nvalid = 64;
    if (mode == 1) { if (n0 < 2048) sc0 = n0; else if (n0 < 8192) sc0 = n0 + 48; else if (n0 == 8192) { sc0 = 2048; nvalid = 48; } else { sc0 = 0; nvalid = 0; } }
    cur0 = make_float4(0.f, 0.f, 0.f, 0.f); cur1 = cur0;
    if (nc < nvalid) { cur0 = *(const float4*)&src[(size_t)(k0 + kr) * Nsrc + sc0 + nc]; cur1 = *(const float4*)&src[(size_t)(k0 + kr + 32) * Nsrc + sc0 + nc]; }
  }
  int it = 0;
  for (; t < nt; t += gridDim.x, ++it) {
    const int t2 = (t + (int)gridDim.x < nt) ? t + (int)gridDim.x : t;
    float4 nx0, nx1;
    {
      int tn = t2 / tilesK, tk = t2 - tn * tilesK; int n0 = tn * 64, k0 = tk * 64;
      int sc0 = n0, nvalid = 64;
      if (mode == 1) { if (n0 < 2048) sc0 = n0; else if (n0 < 8192) sc0 = n0 + 48; else if (n0 == 8192) { sc0 = 2048; nvalid = 48; } else { sc0 = 0; nvalid = 0; } }
      nx0 = make_float4(0.f, 0.f, 0.f, 0.f); nx1 = nx0;
      if (nc < nvalid) { nx0 = *(const float4*)&src[(size_t)(k0 + kr) * Nsrc + sc0 + nc]; nx1 = *(const float4*)&src[(size_t)(k0 + kr + 32) * Nsrc + sc0 + nc]; }
    }
    float* tb = tile + (it & 1) * (64 * 65);
    tb[kr * 65 + nc + 0] = cur0.x; tb[kr * 65 + nc + 1] = cur0.y; tb[kr * 65 + nc + 2] = cur0.z; tb[kr * 65 + nc + 3] = cur0.w;
    tb[(kr + 32) * 65 + nc + 0] = cur1.x; tb[(kr + 32) * 65 + nc + 1] = cur1.y; tb[(kr + 32) * 65 + nc + 2] = cur1.z; tb[(kr + 32) * 65 + nc + 3] = cur1.w;
    __syncthreads();
    {
      int tn = t / tilesK, tk = t - tn * tilesK; int n0 = tn * 64, k0 = tk * 64;
      uint4 o;
      o.x = pk_bf16(tb[(kc + 0) * 65 + n], tb[(kc + 1) * 65 + n]);
      o.y = pk_bf16(tb[(kc + 2) * 65 + n], tb[(kc + 3) * 65 + n]);
      o.z = pk_bf16(tb[(kc + 4) * 65 + n], tb[(kc + 5) * 65 + n]);
      o.w = pk_bf16(tb[(kc + 6) * 65 + n], tb[(kc + 7) * 65 + n]);
      *(uint4*)&dst[(size_t)(n0 + n) * K + k0 + kc] = o;
    }
    cur0 = nx0; cur1 = nx1;
  }
  __syncthreads();
}

DEVFN void phase_prep(const int WID, PP p) {
  const int BID = opaque_bid();
  const int tid = opaque_tid(WID), lane = tid & 63, wave = tid >> 6;
  char* ws = p->ws;
  for (int job = 0; job < 13; job++) {
    const float* src; u16* dst; int K = 2048, Nsrc, Ndst, mode = 0;
    int l = job & 1, kind = job >> 1;
    if (kind == 0) { src = p->w_in + (size_t)l * 2048 * 4096; dst = (u16*)(ws + OFF_WT_IN) + (size_t)l * 4096 * 2048; Nsrc = 4096; Ndst = 4096; }
    else if (kind == 1) { src = p->w_glu + (size_t)l * 2048 * 2048; dst = (u16*)(ws + OFF_WT_GLU) + (size_t)l * 2048 * 2048; Nsrc = 2048; Ndst = 2048; }
    else if (kind == 2) { src = p->w_out + (size_t)l * 2048 * 2048; dst = (u16*)(ws + OFF_WT_OUT) + (size_t)l * 2048 * 2048; Nsrc = 2048; Ndst = 2048; }
    else if (kind == 3) { src = p->w_qg + (size_t)l * 2048 * 8240; dst = (u16*)(ws + OFF_WT_QG) + (size_t)l * 8448 * 2048; Nsrc = 8240; Ndst = 8448; mode = 1; }
    else if (kind == 4) { src = p->w_o + (size_t)l * 2048 * 2048; dst = (u16*)(ws + OFF_WT_O) + (size_t)l * 2048 * 2048; Nsrc = 2048; Ndst = 2048; }
    else if (kind == 5) { src = p->cmp_w1 + (size_t)l * 4096 * 128; dst = (u16*)(ws + OFF_W1T) + (size_t)l * 128 * 4096; K = 4096; Nsrc = 128; Ndst = 128; }
    else { src = p->w_kv; dst = (u16*)(ws + OFF_WT_KV); Nsrc = 3072; Ndst = 3072; }
    xpose(WID, src, dst, K, Nsrc, Ndst, mode);
  }
  {
    uint4* z = (uint4*)(ws + OFF_KC);
    unsigned zz = 0; asm volatile("" : "+v"(zz));
    for (int i = BID * 512 + tid; i < (int)(2 * MB / 16); i += gridDim.x * 512) z[i] = make_uint4(zz, zz, zz, zz);
  }
  {
    float* cact = (float*)smem;
    float* red = cact + 8192;
    float* modv = (float*)(ws + OFF_MODV);
    float* kvmod = (float*)(ws + OFF_KVMOD);
    for (int i = tid; i < 8192; i += 512) { float v = p->c[i]; cact[i] = v / (1.f + expf(-v)); }
    __syncthreads();
    for (int task = BID; task < 448; task += gridDim.x) {
      const float* W; const float* bias; float* outp; int N; int col0;
      if (task < 384) {
        int l = task / 96; col0 = (task % 96) * 64; W = p->mod_w + (size_t)l * 2048 * 6144; N = 6144;
        bias = p->mod_b + l * 6144; outp = modv + l * 4 * 6144;
      } else {
        col0 = (task - 384) * 64; W = p->kv_mod_w; N = 4096; bias = p->kv_mod_b; outp = kvmod;
      }
      float a0 = 0, a1 = 0, a2 = 0, a3 = 0;
      int kb = wave * 256;
      const float* wp = W + (size_t)kb * N + col0 + lane;
#pragma unroll 1
      for (int k0 = 0; k0 < 256; k0 += 32) {
        float wv[32];
#pragma unroll
        for (int i = 0; i < 32; i++) wv[i] = wp[(size_t)(k0 + i) * N];
#pragma unroll
        for (int i = 0; i < 32; i++) {
          int k = kb + k0 + i;
          a0 += cact[k] * wv[i]; a1 += cact[2048 + k] * wv[i]; a2 += cact[4096 + k] * wv[i]; a3 += cact[6144 + k] * wv[i];
        }
      }
      red[(wave * 4 + 0) * 64 + lane] = a0; red[(wave * 4 + 1) * 64 + lane] = a1;
      red[(wave * 4 + 2) * 64 + lane] = a2; red[(wave * 4 + 3) * 64 + lane] = a3;
      __syncthreads();
      if (tid < 256) {
        int b = tid >> 6, ln = tid & 63; float s = 0;
#pragma unroll
        for (int w = 0; w < 8; w++) s += red[(w * 4 + b) * 64 + ln];
        outp[b * N + col0 + ln] = s + bias[col0 + ln];
      }
      __syncthreads();
    }
  }
  {
    float2* abar = (float2*)(ws + OFF_ABAR); float2* aq = (float2*)(ws + OFF_AQ);
    float* bbre = (float*)(ws + OFF_BBRE); float* bbim = (float*)(ws + OFF_BBIM);
    for (int i = BID * 512 + tid; i < 2 * 128 * 64; i += gridDim.x * 512) {
      int lg = i >> 6;
      float dt = expf(p->log_step[lg]);
      float lr = p->lam_re[i], li = p->lam_im[i];
      float zr = lr * dt, zi = li * dt;
      float em1 = expm1f(zr), cz = cosf(zi), sz = sinf(zi), sh = sinf(0.5f * zi);
      float mag = em1 + 1.f;
      float arm1 = em1 * cz - 2.f * sh * sh;
      float are = 1.f + arm1, aim = mag * sz;
      float den = lr * lr + li * li;
      float cre = (arm1 * lr + aim * li) / den, cim = (aim * lr - arm1 * li) / den;
      abar[i] = make_float2(are, aim);
      float m64 = expf(zr * 64.f), a64 = zi * 64.f;
      aq[i] = make_float2(m64 * cosf(a64), m64 * sinf(a64));
#pragma unroll
      for (int c = 0; c < 16; c++) {
        float br = p->b_re[(size_t)i * 16 + c], bi = p->b_im[(size_t)i * 16 + c];
        bbre[(size_t)i * 16 + c] = cre * br - cim * bi;
        bbim[(size_t)i * 16 + c] = cre * bi + cim * br;
      }
    }
  }
  {
    float* red = (float*)smem + 16384;
    float* pebp = (float*)(ws + OFF_PEBP);
    for (int task = BID; task < 256; task += gridDim.x) {
      int kvi = task >> 7, kq = task & 127;
      int j = tid & 127, sub = tid >> 7;
      const float* pe = p->cmp_pe + kvi * 4096 + kq * 32 + sub * 8; const float* w1 = p->cmp_w1 + ((size_t)kvi * 4096 + kq * 32 + sub * 8) * 128 + j;
      float a = 0;
#pragma unroll
      for (int k = 0; k < 8; k++) a += pe[k] * w1[(size_t)k * 128];
      red[tid] = a;
      __syncthreads();
      if (tid < 128) pebp[(size_t)task * 128 + tid] = red[tid] + red[tid + 128] + red[tid + 256] + red[tid + 384];
      __syncthreads();
    }
  }
}

DEVFN void phase_peb_final(const int WID, PP p) {
  const int BID = opaque_bid();
  const int tid = opaque_tid(WID);
  if (BID != 0 || tid >= 256) return;
  char* ws = p->ws;
  const float* pebp = (const float*)(ws + OFF_PEBP);
  float* peb = (float*)(ws + OFF_PEB);
  int kvi = tid >> 7, j = tid & 127;
  float s = p->cmp_b1[kvi * 128 + j];
#pragma unroll 1
  for (int k0 = 0; k0 < 128; k0 += 32) {
    float v[32];
#pragma unroll
    for (int i = 0; i < 32; i++) v[i] = pebp[(size_t)(kvi * 128 + k0 + i) * 128 + j];
#pragma unroll
    for (int i = 0; i < 32; i++) s += v[i];
  }
  peb[kvi * 128 + j] = s;
}

DEVFN void phase_prenorm(const int WID, PP p, int layer, bool dual) {
  const int BID = opaque_bid();
  const int tid = opaque_tid(WID), lane = tid & 63, wave = tid >> 6;
  char* ws = p->ws;
  const float* xin = (layer == 0) ? p->x : (const float*)(ws + OFF_XBUF);
  const float* modv = (const float*)(ws + OFF_MODV);
  const float* kvmod = (const float*)(ws + OFF_KVMOD);
  u16* hbuf = (u16*)(ws + OFF_HBUF);
  u16* hkv = (u16*)(ws + OFF_HKV);
  for (int r0 = (BID * 8 + wave) * 2; r0 < T_; r0 += gridDim.x * 16) {
    float4 v[2][8]; float ss[2] = {0.f, 0.f};
#pragma unroll
    for (int rr = 0; rr < 2; rr++) {
      const float* xr = xin + (size_t)(r0 + rr) * 2048;
#pragma unroll
      for (int i = 0; i < 8; i++) v[rr][i] = *(const float4*)&xr[(i * 64 + lane) * 4];
    }
#pragma unroll
    for (int rr = 0; rr < 2; rr++) {
#pragma unroll
      for (int i = 0; i < 8; i++) ss[rr] += v[rr][i].x * v[rr][i].x + v[rr][i].y * v[rr][i].y + v[rr][i].z * v[rr][i].z + v[rr][i].w * v[rr][i].w;
      ss[rr] = wave_sum(ss[rr], lane);
    }
    const int b = r0 >> 12;
    const float* g = p->norm_g + layer * 2048; const float* mv = modv + (size_t)(layer * 4 + b) * 6144;
#pragma unroll
    for (int rr = 0; rr < 2; rr++) {
      const int r = r0 + rr;
      const float rstd = rsqrtf(ss[rr] * (1.f / 2048.f) + 1e-6f);
#pragma unroll
      for (int i = 0; i < 8; i++) {
        int c = (i * 64 + lane) * 4;
        float4 gg = *(const float4*)&g[c], sh = *(const float4*)&mv[c], sc = *(const float4*)&mv[2048 + c];
        uint2 o;
        o.x = pk_bf16(v[rr][i].x * rstd * gg.x * (1.f + sc.x) + sh.x, v[rr][i].y * rstd * gg.y * (1.f + sc.y) + sh.y);
        o.y = pk_bf16(v[rr][i].z * rstd * gg.z * (1.f + sc.z) + sh.z, v[rr][i].w * rstd * gg.w * (1.f + sc.w) + sh.w);
        *(uint2*)&hbuf[(size_t)r * 2048 + c] = o;
      }
      if (dual) {
        const float* g2 = p->kv_norm_g; const float* mv2 = kvmod + (size_t)b * 4096;
#pragma unroll
        for (int i = 0; i < 8; i++) {
          int c = (i * 64 + lane) * 4;
          float4 gg = *(const float4*)&g2[c], sh = *(const float4*)&mv2[c], sc = *(const float4*)&mv2[2048 + c];
          uint2 o;
          o.x = pk_bf16(v[rr][i].x * rstd * gg.x * (1.f + sc.x) + sh.x, v[rr][i].y * rstd * gg.y * (1.f + sc.y) + sh.y);
          o.y = pk_bf16(v[rr][i].z * rstd * gg.z * (1.f + sc.z) + sh.z, v[rr][i].w * rstd * gg.w * (1.f + sc.w) + sh.w);
          *(uint2*)&hkv[(size_t)r * 2048 + c] = o;
        }
      }
    }
  }
}

DEVFN void phase_final(const int WID, PP p) {
  const int BID = opaque_bid();
  const int tid = opaque_tid(WID), lane = tid & 63, wave = tid >> 6;
  const float* xin = (const float*)(p->ws + OFF_XBUF);
  for (int r0 = (BID * 8 + wave) * 2; r0 < T_; r0 += gridDim.x * 16) {
    float4 v[2][8]; float ss[2] = {0.f, 0.f};
#pragma unroll
    for (int rr = 0; rr < 2; rr++) {
      const float* xr = xin + (size_t)(r0 + rr) * 2048;
#pragma unroll
      for (int i = 0; i < 8; i++) v[rr][i] = *(const float4*)&xr[(i * 64 + lane) * 4];
    }
#pragma unroll
    for (int rr = 0; rr < 2; rr++) {
#pragma unroll
      for (int i = 0; i < 8; i++) ss[rr] += v[rr][i].x * v[rr][i].x + v[rr][i].y * v[rr][i].y + v[rr][i].z * v[rr][i].z + v[rr][i].w * v[rr][i].w;
      ss[rr] = wave_sum(ss[rr], lane);
    }
#pragma unroll
    for (int rr = 0; rr < 2; rr++) {
      const float rstd = rsqrtf(ss[rr] * (1.f / 2048.f) + 1e-6f);
#pragma unroll
      for (int i = 0; i < 8; i++) {
        int c = (i * 64 + lane) * 4;
        float4 gg = *(const float4*)&p->final_g[c];
        float4 o = make_float4(v[rr][i].x * rstd * gg.x, v[rr][i].y * rstd * gg.y, v[rr][i].z * rstd * gg.z, v[rr][i].w * rstd * gg.w);
        *(float4*)&p->out[(size_t)(r0 + rr) * 2048 + c] = o;
      }
    }
  }
}

enum { EPI_S1 = 0, EPI_S3 = 1, EPI_RES = 2, EPI_KV = 3, EPI_QG = 4 };

__device__ __forceinline__ uint2 pack4(float a, float b, float c, float d) { uint2 o; o.x = pk_bf16(a, b); o.y = pk_bf16(c, d); return o; }
__device__ __forceinline__ float bflo(unsigned u) { return __uint_as_float(u << 16); }
__device__ __forceinline__ float bfhi(unsigned u) { return __uint_as_float(u & 0xffff0000u); }

struct EpiPre { float4 x; uint2 a, b; };
template <int EPI>
__device__ __forceinline__ EpiPre epi_pre(PP p, int row, int col, int aux) {
  EpiPre r; r.x = make_float4(0.f, 0.f, 0.f, 0.f); r.a = make_uint2(0u, 0u); r.b = r.a;
  char* ws = p->ws;
  if constexpr (EPI == EPI_S3) {
    const u16* uz = (const u16*)(ws + OFF_UZ); const u16* y = (const u16*)(ws + OFF_Y);
    r.a = *(const uint2*)&y[(size_t)row * 2048 + col];
    r.b = *(const uint2*)&uz[(size_t)row * 4096 + 2048 + col];
  } else if constexpr (EPI == EPI_RES) {
    const float* xo = (aux == 0) ? p->x : (const float*)(ws + OFF_XBUF);
    r.x = *(const float4*)&xo[(size_t)row * 2048 + col];
  }
  return r;
}
template <int EPI>
__device__ __forceinline__ void epi_row(PP p, int row, int col, f32x4 v, int aux, const EpiPre& pre) {
  char* ws = p->ws;
  if constexpr (EPI == EPI_S1) {
    u16* uz = (u16*)(ws + OFF_UZ);
    if (col >= 2048) { v[0] = siluf_(v[0]); v[1] = siluf_(v[1]); v[2] = siluf_(v[2]); v[3] = siluf_(v[3]); }
    *(uint2*)&uz[(size_t)row * 4096 + col] = pack4(v[0], v[1], v[2], v[3]);
  } else if constexpr (EPI == EPI_S3) {
    const u16* uz = (const u16*)(ws + OFF_UZ); const u16* y = (const u16*)(ws + OFF_Y); u16* vo = (u16*)(ws + OFF_V);
    float4 bg = *(const float4*)&p->b_glu[aux * 2048 + col];
    uint2 yy = pre.a;
    uint2 ss = pre.b;
    *(uint2*)&vo[(size_t)row * 2048 + col] = pack4(bflo(yy.x) * sigmoidf_(v[0] + bg.x) * bflo(ss.x), bfhi(yy.x) * sigmoidf_(v[1] + bg.y) * bfhi(ss.x),
                                                   bflo(yy.y) * sigmoidf_(v[2] + bg.z) * bflo(ss.y), bfhi(yy.y) * sigmoidf_(v[3] + bg.w) * bfhi(ss.y));
  } else if constexpr (EPI == EPI_RES) {
    const float* modv = (const float*)(ws + OFF_MODV);
    float* xb = (float*)(ws + OFF_XBUF);
    const float* xo = (aux == 0) ? p->x : xb;
    int b = row >> 12;
    float4 gate = *(const float4*)&modv[(size_t)(aux * 4 + b) * 6144 + 4096 + col];
    size_t idx = (size_t)row * 2048 + col;
    float4 xv = pre.x;
    *(float4*)&xb[idx] = make_float4(xv.x + gate.x * v[0], xv.y + gate.y * v[1], xv.z + gate.z * v[2], xv.w + gate.w * v[3]);
  } else if constexpr (EPI == EPI_KV) {
    u16* kvb = (u16*)(ws + OFF_KVB);
    *(uint2*)&kvb[(size_t)row * 3072 + col] = pack4(v[0], v[1], v[2], v[3]);
  } else if constexpr (EPI == EPI_QG) {
    if (col < 2048) {
      u16* q = (u16*)(ws + OFF_Q);
      const float sc = 0.08838834764831845f * 1.4426950408889634f;
      *(uint2*)&q[(size_t)row * 2048 + col] = pack4(v[0] * sc, v[1] * sc, v[2] * sc, v[3] * sc);
    } else if (col < 8192) {
      u16* sz3 = (u16*)(ws + OFF_SZ3);
      *(uint2*)&sz3[(size_t)row * 6144 + (col - 2048)] = pack4(siluf_(v[0]), siluf_(v[1]), siluf_(v[2]), siluf_(v[3]));
    } else if (col < 8240) {
      float* gates = (float*)(ws + OFF_GATES);
      *(float4*)&gates[(size_t)row * 48 + (col - 8192)] = make_float4(sigmoidf_(v[0]), sigmoidf_(v[1]), sigmoidf_(v[2]), sigmoidf_(v[3]));
    }
  }
}
__device__ __forceinline__ void epi_vt(PP p, int row0, int col, f32x4 v) {
  int br = col >> 9;
  int which = (br == 5) ? 1 : 0;
  int gg = (col >> 7) & 3, d = col & 127;
  int b = row0 >> 12, t = row0 & 4095;
  u16* vt = (u16*)(p->ws + OFF_VT);
  *(uint2*)&vt[((size_t)((which * 4 + b) * 4 + gg) * 128 + d) * 4096 + t] = pack4(v[0], v[1], v[2], v[3]);
}

typedef const __attribute__((address_space(1))) char* gptr_t;
constexpr int G_BM = 256, G_BK = 64, G_HALF = 128, G_NXCD = 8, G_WGM = 8, G_HT = G_HALF * G_BK;

__device__ __forceinline__ int lds_byte(int r, int c) {
  int st = (r >> 4) * 2 + (c >> 5), rr = r & 15, cc = c & 31, ob = rr * 64 + cc * 2;
  return st * 1024 + (ob ^ (((ob >> 9) & 1) << 5));
}
__device__ __forceinline__ void stage_rc(int b, int& R, int& C) {
  int st = b / 1024, sb = b % 1024, swz = sb ^ (((sb >> 9) & 1) << 5);
  R = (st >> 1) * 16 + swz / 64; C = (st & 1) * 32 + (swz % 64) / 2;
}

template <int EPI>
DEVFN void gemm_phase(const int WID, PP p, const u16* __restrict__ A, const u16* __restrict__ Bt, const int N, const int aux) {
  const int BID = opaque_bid();
  constexpr int K = 2048;
  u16* shm = (u16*)smem;
#define SA(b, h) (shm + ((b) * 2 + (h)) * G_HT)
#define SB(b, h) (shm + (4 + (b) * 2 + (h)) * G_HT)
#define STAGE(P, BASE, br, kt) do { const char* _ub = (const char*)(BASE + (long)(br) * K + (long)(kt) * G_BK); \
    unsigned _l0 = lds0 + (unsigned)((char*)(P) - smem) + wbase; \
    asm volatile("s_mov_b32 m0, %2\n\ts_nop 0\n\tglobal_load_lds_dwordx4 %0, %1" :: "v"(svoff[0]), "s"(_ub), "s"(_l0) : "memory"); \
    asm volatile("s_mov_b32 m0, %2\n\ts_nop 0\n\tglobal_load_lds_dwordx4 %0, %1" :: "v"(svoff[1]), "s"(_ub), "s"(_l0 + 8192u) : "memory"); } while (0)
#define LDA(dst, b, h) for (int m = 0; m < 4; ++m) for (int k = 0; k < 2; ++k) \
    dst[m][k] = *reinterpret_cast<const bf16x8*>((char*)SA(b, h) + lds_byte(wr * 64 + m * 16 + fr, k * 32 + fq * 8))
#define LDB(dst, b, h) for (int n = 0; n < 2; ++n) for (int k = 0; k < 2; ++k) \
    dst[n][k] = *reinterpret_cast<const bf16x8*>((char*)SB(b, h) + lds_byte(wc * 32 + n * 16 + fr, k * 32 + fq * 8))
#define MMA(ai, bj, At, Bt_) do { __builtin_amdgcn_s_setprio(1); \
    for (int m = 0; m < 4; ++m) for (int n = 0; n < 2; ++n) for (int k = 0; k < 2; ++k) \
      acc[ai][bj][m][n] = __builtin_amdgcn_mfma_f32_16x16x32_bf16(At[m][k], Bt_[n][k], acc[ai][bj][m][n], 0, 0, 0); \
    __builtin_amdgcn_s_setprio(0); } while (0)
#define WAIT_V(n) asm volatile("s_waitcnt vmcnt(" #n ")" ::: "memory")
#define WAIT_L(n) asm volatile("s_waitcnt lgkmcnt(" #n ")" ::: "memory")
#define BAR __builtin_amdgcn_s_barrier()
#define SCHED __builtin_amdgcn_sched_barrier(0)

  const int nM = T_ / G_BM, nN = N / G_BM, nwg = nM * nN;
  const int gtid = opaque_tid(WID);
  const int wid = gtid >> 6, lane = gtid & 63, wr = wid >> 2, wc = wid & 3, fr = lane & 15, fq = lane >> 4;
  constexpr int nt = K / G_BK;
  const int wbase = __builtin_amdgcn_readfirstlane((gtid >> 6) << 10);
  const unsigned lds0 = (unsigned)(unsigned long)(__attribute__((address_space(3))) char*)smem;
  unsigned svoff[2];
#pragma unroll
  for (int i = 0; i < 2; ++i) { int r_, c_; stage_rc(gtid * 16 + i * 8192, r_, c_); svoff[i] = (unsigned)(r_ * K + c_) * 2u; }
  for (int vt = BID; vt < nwg; vt += gridDim.x) {
    int wgid = vt;
    { int q = nwg / G_NXCD, r = nwg % G_NXCD, xcd = wgid % G_NXCD, off = wgid / G_NXCD;
      wgid = (xcd < r ? xcd * (q + 1) : r * (q + 1) + (xcd - r) * q) + off; }
    int nig = G_WGM * nN, gid = wgid / nig, fm = gid * G_WGM, gsz = min(nM - fm, G_WGM);
    int pm = fm + ((wgid % nig) % gsz), pn = (wgid % nig) / gsz, brow = pm * G_BM, bcol = pn * G_BM;
    f32x4 acc[2][2][4][2] = {};
    bf16x8 At[4][2], B0[2][2], B1[2][2];
    asm volatile("s_waitcnt vmcnt(0)" ::: "memory");
    STAGE(SB(0, 0), Bt, bcol, 0); STAGE(SA(0, 0), A, brow, 0);
    STAGE(SB(0, 1), Bt, bcol + G_HALF, 0); STAGE(SA(0, 1), A, brow + G_HALF, 0);
    if (wr == 1) BAR;
    WAIT_V(4); BAR;
    STAGE(SB(1, 0), Bt, bcol, 1); STAGE(SA(1, 0), A, brow, 1); STAGE(SB(1, 1), Bt, bcol + G_HALF, 1);
    WAIT_V(6); BAR;
#pragma nounroll
    for (int t = 0; t < nt - 2; t += 2) {
      LDB(B0, 0, 0); SCHED; LDA(At, 0, 0); STAGE(SA(1, 1), A, brow + G_HALF, t + 1);
      WAIT_L(8); BAR; WAIT_L(0); MMA(0, 0, At, B0); BAR; SCHED;
      LDB(B1, 0, 1); STAGE(SB(0, 0), Bt, bcol, t + 2);
      BAR; WAIT_L(0); MMA(0, 1, At, B1); BAR;
      LDA(At, 0, 1); STAGE(SA(0, 0), A, brow, t + 2);
      BAR; WAIT_L(0); MMA(1, 0, At, B0); BAR; SCHED;
      STAGE(SB(0, 1), Bt, bcol + G_HALF, t + 2);
      WAIT_V(6); BAR; MMA(1, 1, At, B1); BAR;
      LDB(B0, 1, 0); SCHED; LDA(At, 1, 0); STAGE(SA(0, 1), A, brow + G_HALF, t + 2);
      WAIT_L(8); BAR; WAIT_L(0); MMA(0, 0, At, B0); BAR; SCHED;
      LDB(B1, 1, 1); STAGE(SB(1, 0), Bt, bcol, t + 3);
      BAR; WAIT_L(0); MMA(0, 1, At, B1); BAR;
      LDA(At, 1, 1); STAGE(SA(1, 0), A, brow, t + 3);
      BAR; WAIT_L(0); MMA(1, 0, At, B0); BAR; SCHED;
      STAGE(SB(1, 1), Bt, bcol + G_HALF, t + 3);
      WAIT_V(6); BAR; MMA(1, 1, At, B1); BAR;
    }
    { LDB(B0, 0, 0); LDA(At, 0, 0); STAGE(SA(1, 1), A, brow + G_HALF, nt - 1);
      BAR; WAIT_L(0); MMA(0, 0, At, B0); BAR;
      LDB(B1, 0, 1); BAR; WAIT_L(0); MMA(0, 1, At, B1); BAR;
      LDA(At, 0, 1); WAIT_V(4); BAR; WAIT_L(0); MMA(1, 0, At, B0); MMA(1, 1, At, B1); BAR; }
    { LDB(B0, 1, 0); LDA(At, 1, 0); WAIT_V(2); BAR; WAIT_L(0); MMA(0, 0, At, B0); BAR;
      LDB(B1, 1, 1); WAIT_V(0); BAR; WAIT_L(0); MMA(0, 1, At, B1); BAR;
      LDA(At, 1, 1); BAR; WAIT_L(0); MMA(1, 0, At, B0); MMA(1, 1, At, B1); BAR; }
    if (wr == 0) BAR;
    {
      float* et = (float*)(smem + wid * 16384);
      const int te = opaque_tid(WID);
      const int fr = te & 15, fq = (te >> 4) & 3, wr = te >> 8, wc = (te >> 6) & 3;
      bool vtb = false;
      if constexpr (EPI == EPI_KV) { int br = bcol >> 9; vtb = (br == 3) || (br == 5); }
#pragma unroll
      for (int ai = 0; ai < 2; ++ai) {
#pragma unroll
        for (int bj = 0; bj < 2; ++bj)
#pragma unroll
          for (int m = 0; m < 4; ++m)
#pragma unroll
            for (int n = 0; n < 2; ++n)
#pragma unroll
              for (int j = 0; j < 4; ++j)
                et[(m * 16 + fq * 4 + j) * 64 + ((bj * 32 + n * 16 + fr) ^ (fq << 4))] = acc[ai][bj][m][n][j];
        const int rbase = brow + ai * G_HALF + wr * 64;
        if (!vtb) {
#pragma unroll 1
          for (int it0 = 0; it0 < 16; it0 += 4) {
            const int c4 = fr * 4;
            const int gcol = bcol + (c4 >> 5) * G_HALF + wc * 32 + (c4 & 31);
            EpiPre pre[4];
#pragma unroll
            for (int u = 0; u < 4; ++u) pre[u] = epi_pre<EPI>(p, rbase + (it0 + u) * 4 + fq, gcol, aux);
#pragma unroll
            for (int u = 0; u < 4; ++u) {
              int row = (it0 + u) * 4 + fq;
              f32x4 v = *(const f32x4*)&et[row * 64 + (c4 ^ (((row >> 2) & 3) << 4))];
              epi_row<EPI>(p, rbase + row, gcol, v, aux, pre[u]);
            }
          }
        } else {
#pragma unroll 1
          for (int it = 0; it < 16; ++it) {
            int c = it * 4 + fq, r4 = fr * 4;
            int sw = (fr & 3) << 4;
            f32x4 v;
            v[0] = et[(r4 + 0) * 64 + (c ^ sw)]; v[1] = et[(r4 + 1) * 64 + (c ^ sw)];
            v[2] = et[(r4 + 2) * 64 + (c ^ sw)]; v[3] = et[(r4 + 3) * 64 + (c ^ sw)];
            int gcol = bcol + (c >> 5) * G_HALF + wc * 32 + (c & 31);
            epi_vt(p, rbase + r4, gcol, v);
          }
        }
      }
    }
    __syncthreads();
  }
#undef SA
#undef SB
#undef STAGE
#undef LDA
#undef LDB
#undef MMA
}

DEVFN void phase_ssm_a(const int WID, PP p, int layer) {
  const int BID = opaque_bid();
  const int tid = opaque_tid(WID), lane = tid & 63, wave = tid >> 6;
  char* ws = p->ws;
  const u16* uz = (const u16*)(ws + OFF_UZ);
  const float2* abar = (const float2*)(ws + OFF_ABAR);
  const float* bbre = (const float*)(ws + OFF_BBRE); const float* bbim = (const float*)(ws + OFF_BBIM);
  float2* st = (float2*)(ws + OFF_ST);
  float* uw = (float*)smem + wave * 1024;
  for (int task = BID; task < 4096; task += gridDim.x) {
    int bg = task >> 3, co = task & 7; int b = bg >> 7, g = bg & 127;
    int c = co * 8 + wave;
    {
      int t = c * 64 + lane;
      const u16* up = uz + (size_t)(b * 4096 + t) * 4096 + g * 16;
      bf16x8 u0 = *(const bf16x8*)up, u1 = *(const bf16x8*)(up + 8);
#pragma unroll
      for (int j = 0; j < 8; j++) { uw[lane * 16 + j] = bf2f((u16)u0[j]); uw[lane * 16 + 8 + j] = bf2f((u16)u1[j]); }
    }
    int gi = (layer * 128 + g) * 64 + lane;
    float br[16], bi[16];
#pragma unroll
    for (int k = 0; k < 16; k++) { br[k] = bbre[(size_t)gi * 16 + k]; bi[k] = bbim[(size_t)gi * 16 + k]; }
    float2 a = abar[gi];
    __syncthreads();
    float xr = 0, xi = 0;
    for (int s = 0; s < 64; s++) {
      float bur = 0, bui = 0;
#pragma unroll
      for (int k4 = 0; k4 < 4; k4++) {
        float4 u = *(const float4*)&uw[s * 16 + k4 * 4];
        bur += br[k4 * 4 + 0] * u.x + br[k4 * 4 + 1] * u.y + br[k4 * 4 + 2] * u.z + br[k4 * 4 + 3] * u.w;
        bui += bi[k4 * 4 + 0] * u.x + bi[k4 * 4 + 1] * u.y + bi[k4 * 4 + 2] * u.z + bi[k4 * 4 + 3] * u.w;
      }
      float nr = a.x * xr - a.y * xi + bur;
      float ni = a.x * xi + a.y * xr + bui;
      xr = nr; xi = ni;
    }
    st[((size_t)bg * 64 + c) * 64 + lane] = make_float2(xr, xi);
    __syncthreads();
  }
}


DEVFN void phase_ssm_gen(const int WID, PP p, int layer) {
  const int BID = opaque_bid();
  const int tid = opaque_tid(WID);
  char* ws = p->ws;
  float2* pwr = (float2*)smem;
  float2* Cc = (float2*)(smem + 33280);
  float2* Bb = (float2*)(smem + 41472);
  const float* bbre = (const float*)(ws + OFF_BBRE); const float* bbim = (const float*)(ws + OFF_BBIM);
  for (int task = BID; task < 256; task += gridDim.x) {
    const int g = task >> 1, hf = task & 1;
    const int lg = layer * 128 + g;
    for (int i = tid; i < 1024; i += 512) {
      Cc[i] = make_float2(p->c_re[(size_t)lg * 1024 + i], p->c_im[(size_t)lg * 1024 + i]);
      Bb[i] = make_float2(bbre[(size_t)lg * 1024 + i], bbim[(size_t)lg * 1024 + i]);
    }
    {
      float dt = expf(p->log_step[lg]);
      for (int i = tid; i < 65 * 64; i += 512) {
        int d = i >> 6, n = i & 63;
        float lr = p->lam_re[lg * 64 + n], li = p->lam_im[lg * 64 + n];
        float mag = expf(lr * dt * (float)d);
        float sn, cs; sincosf(li * dt * (float)d, &sn, &cs);
        pwr[i] = make_float2(mag * cs, mag * sn);
      }
    }
    __syncthreads();
    {
      u16* kt = (u16*)(ws + OFF_SSM_KT) + (size_t)g * 16384;
      int d = hf * 32 + (tid >> 4), cp = tid & 15;
      float acc[16];
#pragma unroll
      for (int c = 0; c < 16; c++) acc[c] = 0.f;
      for (int n = 0; n < 64; n++) {
        float2 C = Cc[cp * 64 + n], P = pwr[d * 64 + n];
        float tr = C.x * P.x - C.y * P.y, ti = C.x * P.y + C.y * P.x;
#pragma unroll
        for (int c = 0; c < 16; c++) { float2 B = Bb[n * 16 + c]; acc[c] += tr * B.x - ti * B.y; }
      }
      uint4 o0, o1;
      o0.x = pk_bf16(acc[0], acc[1]); o0.y = pk_bf16(acc[2], acc[3]); o0.z = pk_bf16(acc[4], acc[5]); o0.w = pk_bf16(acc[6], acc[7]);
      o1.x = pk_bf16(acc[8], acc[9]); o1.y = pk_bf16(acc[10], acc[11]); o1.z = pk_bf16(acc[12], acc[13]); o1.w = pk_bf16(acc[14], acc[15]);
      *(uint4*)&kt[(d * 16 + cp) * 16] = o0;
      *(uint4*)&kt[(d * 16 + cp) * 16 + 8] = o1;
    }
    unsigned* w1 = (unsigned*)((u16*)(ws + OFF_SSM_W1) + (size_t)g * 131072);
    for (int e2 = hf * 32768 + tid; e2 < hf * 32768 + 32768; e2 += 512) {
      int e = e2 * 2; int row = e >> 10, k = e & 1023; int sidx = k >> 4, c = k & 15, n = row & 63;
      float2 P = pwr[(63 - sidx) * 64 + n];
      float2 B0 = Bb[n * 16 + c], B1 = Bb[n * 16 + c + 1];
      float v0, v1;
      if (row < 64) { v0 = P.x * B0.x - P.y * B0.y; v1 = P.x * B1.x - P.y * B1.y; }
      else { v0 = P.x * B0.y + P.y * B0.x; v1 = P.x * B1.y + P.y * B1.x; }
      w1[e2] = pk_bf16(v0, v1);
    }
    unsigned* w2 = (unsigned*)((u16*)(ws + OFF_SSM_W2) + (size_t)g * 131072);
    for (int e2 = hf * 32768 + tid; e2 < hf * 32768 + 32768; e2 += 512) {
      int e = e2 * 2; int row = e >> 7, k2 = e & 127; int sidx = row >> 4, cp = row & 15, n = k2 & 63;
      float2 C0 = Cc[cp * 64 + n], C1 = Cc[cp * 64 + n + 1];
      float2 P0 = pwr[(sidx + 1) * 64 + n], P1 = pwr[(sidx + 1) * 64 + n + 1];
      float v0, v1;
      if (k2 < 64) { v0 = C0.x * P0.x - C0.y * P0.y; v1 = C1.x * P1.x - C1.y * P1.y; }
      else { v0 = -(C0.x * P0.y + C0.y * P0.x); v1 = -(C1.x * P1.y + C1.y * P1.x); }
      w2[e2] = pk_bf16(v0, v1);
    }
    __syncthreads();
  }
}

DEVFN void phase_ssm_x1(const int WID, PP p, int layer) {
  const int BID = opaque_bid();
  const int tid = opaque_tid(WID), lane = tid & 63, wave = tid >> 6;
  char* ws = p->ws;
  const u16* uz = (const u16*)(ws + OFF_UZ);
  float* st = (float*)(ws + OFF_ST);
  const int l15 = lane & 15, l4 = lane >> 4;
  for (int bt = BID; bt < 256; bt += gridDim.x) {
    int wt = bt * 8 + wave; int g = wt >> 4, ct = wt & 15;
    int col = ct * 16 + l15; int b = col >> 6, chunk = col & 63;
    const u16* ub = uz + (size_t)(b * 4096 + chunk * 64) * 4096 + g * 16;
    const u16* w1 = (const u16*)(ws + OFF_SSM_W1) + (size_t)g * 131072;
    f32x4 acc[8];
#pragma unroll
    for (int mt = 0; mt < 8; mt++) acc[mt] = f32x4{0.f, 0.f, 0.f, 0.f};
#pragma unroll 4
    for (int ks = 0; ks < 32; ks++) {
      int sidx = ks * 2 + (l4 >> 1), c0 = (l4 & 1) * 8;
      bf16x8 bfr = *(const bf16x8*)&ub[(size_t)sidx * 4096 + c0];
#pragma unroll
      for (int mt = 0; mt < 8; mt++) {
        bf16x8 afr = *(const bf16x8*)&w1[(size_t)(mt * 16 + l15) * 1024 + ks * 32 + l4 * 8];
        acc[mt] = __builtin_amdgcn_mfma_f32_16x16x32_bf16(afr, bfr, acc[mt], 0, 0, 0);
      }
    }
    float* sb = st + (((size_t)(b * 128 + g) * 64 + chunk) * 64) * 2;
#pragma unroll
    for (int mt = 0; mt < 8; mt++)
#pragma unroll
      for (int j = 0; j < 4; j++) {
        int n2 = mt * 16 + l4 * 4 + j;
        sb[(n2 & 63) * 2 + (n2 >> 6)] = acc[mt][j];
      }
  }
}


DEVFN void phase_ssm_x3(const int WID, PP p, int layer) {
  const int BID = opaque_bid();
  const int tid = opaque_tid(WID), lane = tid & 63, wave = tid >> 6;
  char* ws = p->ws;
  const u16* uz = (const u16*)(ws + OFF_UZ);
  u16* yb = (u16*)(ws + OFF_Y);
  char* Kl = smem + 512;
  char* Wl = smem + 33280;
  const int l15 = lane & 15, l4 = lane >> 4;
  for (int bt = BID; bt < 256; bt += gridDim.x) {
    int wt = bt * 8 + wave; int g = wt >> 4, ct = wt & 15;
    int col = ct * 16 + l15; int b = col >> 6, chunk = col & 63;
    const u16* ub = uz + (size_t)(b * 4096 + chunk * 64) * 4096 + g * 16;
    const u16* kt = (const u16*)(ws + OFF_SSM_KT) + (size_t)g * 16384;
    const u16* w2 = (const u16*)(ws + OFF_SSM_W2) + (size_t)g * 131072;
    const u16* xpb = (const u16*)(ws + OFF_SSM_XP) + ((size_t)(b * 128 + g) * 64 + chunk) * 128;
    const int c0 = (l4 & 1) * 8;
    const char* kbase_l = Kl + (l15 - (l4 >> 1) * 16) * 32 + c0 * 2;
    float4 dsk = *(const float4*)&p->dskip[layer * 2048 + g * 16 + l4 * 4];
    __syncthreads();
#pragma unroll
    for (int i = 0; i < 4; i++) {
      int ci = tid + 512 * i;
      *(uint4*)(Kl + ci * 16) = *(const uint4*)&kt[ci * 8];
    }
    if (tid < 32) { unsigned zz = 0; asm volatile("" : "+v"(zz)); *(uint4*)(smem + tid * 16) = make_uint4(zz, zz, zz, zz); }
#pragma unroll 1
    for (int qd = 0; qd < 4; qd++) {
      if (qd) __syncthreads();
#pragma unroll
      for (int i = 0; i < 8; i++) {
        int ci = tid + 512 * i; int row = ci >> 4, c16 = ci & 15;
        *(uint4*)(Wl + row * 272 + c16 * 16) = *(const uint4*)&w2[(size_t)(qd * 256 + row) * 128 + c16 * 8];
      }
      __syncthreads();
      f32x4 acc[16];
#pragma unroll
      for (int sl = 0; sl < 16; sl++) acc[sl] = f32x4{0.f, 0.f, 0.f, 0.f};
      const int nks = 8 * qd + 8;
      bf16x8 ucur[4], unxt[4];
#pragma unroll
      for (int i = 0; i < 4; i++) ucur[i] = *(const bf16x8*)&ub[(size_t)(2 * i + (l4 >> 1)) * 4096 + c0];
#pragma unroll 1
      for (int ks0 = 0; ks0 < nks; ks0 += 4) {
#pragma unroll
        for (int i = 0; i < 4; i++) {
          int ksn = min(ks0 + 4 + i, nks - 1);
          unxt[i] = *(const bf16x8*)&ub[(size_t)(2 * ksn + (l4 >> 1)) * 4096 + c0];
        }
#pragma unroll
        for (int i = 0; i < 4; i++) {
          const int ks = ks0 + i;
#pragma unroll
          for (int sl = 0; sl < 16; sl++) {
            int sidx = qd * 16 + sl;
            if (sidx >= 2 * ks) {
              bf16x8 afr = *(const bf16x8*)(kbase_l + (sidx - 2 * ks) * 512);
              acc[sl] = __builtin_amdgcn_mfma_f32_16x16x32_bf16(afr, ucur[i], acc[sl], 0, 0, 0);
            }
          }
        }
#pragma unroll
        for (int i = 0; i < 4; i++) ucur[i] = unxt[i];
      }
#pragma unroll
      for (int kk = 0; kk < 4; kk++) {
        bf16x8 bfr = *(const bf16x8*)&xpb[kk * 32 + l4 * 8];
#pragma unroll
        for (int sl = 0; sl < 16; sl++) {
          bf16x8 afr = *(const bf16x8*)(Wl + (sl * 16 + l15) * 272 + (kk * 32 + l4 * 8) * 2);
          acc[sl] = __builtin_amdgcn_mfma_f32_16x16x32_bf16(afr, bfr, acc[sl], 0, 0, 0);
        }
      }
      {
        uint2 uuv[16];
#pragma unroll
        for (int sl = 0; sl < 16; sl++) {
          int t = chunk * 64 + qd * 16 + sl;
          uuv[sl] = *(const uint2*)&uz[(size_t)(b * 4096 + t) * 4096 + g * 16 + l4 * 4];
        }
#pragma unroll
        for (int sl = 0; sl < 16; sl++) {
          int t = chunk * 64 + qd * 16 + sl;
          uint2 uu = uuv[sl];
          float y0 = gelu_tanh(acc[sl][0] + dsk.x * __uint_as_float(uu.x << 16));
          float y1 = gelu_tanh(acc[sl][1] + dsk.y * __uint_as_float(uu.x & 0xffff0000u));
          float y2 = gelu_tanh(acc[sl][2] + dsk.z * __uint_as_float(uu.y << 16));
          float y3 = gelu_tanh(acc[sl][3] + dsk.w * __uint_as_float(uu.y & 0xffff0000u));
          uint2 o;
          o.x = pk_bf16(y0, y1);
          o.y = pk_bf16(y2, y3);
          *(uint2*)&yb[(size_t)(b * 4096 + t) * 2048 + g * 16 + l4 * 4] = o;
        }
      }
    }
  }
}

DEVFN void phase_ssm_b(const int WID, PP p, int layer) {
  const int BID = opaque_bid();
  const int tid = opaque_tid(WID);
  char* ws = p->ws;
  const float2* aq = (const float2*)(ws + OFF_AQ);
  float2* st = (float2*)(ws + OFF_ST);
  u16* xp = (u16*)(ws + OFF_SSM_XP);
  for (int i = BID * 512 + tid; i < 4 * 128 * 64; i += gridDim.x * 512) {
    int n = i & 63, bg = i >> 6, g = bg & 127;
    float2 a = aq[(layer * 128 + g) * 64 + n];
    float xr = 0, xi = 0;
#pragma unroll 1
    for (int c0 = 0; c0 < 64; c0 += 32) {
      float2 sv[32];
#pragma unroll
      for (int k = 0; k < 32; k++) sv[k] = st[((size_t)bg * 64 + c0 + k) * 64 + n];
#pragma unroll
      for (int k = 0; k < 32; k++) {
        xp[((size_t)bg * 64 + c0 + k) * 128 + n] = f2bf(xr);
        xp[((size_t)bg * 64 + c0 + k) * 128 + 64 + n] = f2bf(xi);
        float nr = a.x * xr - a.y * xi + sv[k].x;
        float ni = a.x * xi + a.y * xr + sv[k].y;
        xr = nr; xi = ni;
      }
    }
  }
}

DEVFN void phase_ssm_c(const int WID, PP p, int layer) {
  const int BID = opaque_bid();
  const int tid = opaque_tid(WID), lane = tid & 63, wave = tid >> 6;
  char* ws = p->ws;
  const u16* uz = (const u16*)(ws + OFF_UZ);
  u16* yb = (u16*)(ws + OFF_Y);
  const float2* abar = (const float2*)(ws + OFF_ABAR);
  const float* bbre = (const float*)(ws + OFF_BBRE); const float* bbim = (const float*)(ws + OFF_BBIM);
  const float2* st = (const float2*)(ws + OFF_ST);
  float* Cs = (float*)smem;
  float* uw = (float*)(smem + 8192 + wave * 12416);
  float* xs = uw + 1024;
  for (int task = BID; task < 4096; task += gridDim.x) {
    int bg = task >> 3, co = task & 7; int b = bg >> 7, g = bg & 127;
    int c = co * 8 + wave;
    for (int i = tid; i < 2048; i += 512) {
      int im = i >> 10, cp = (i >> 6) & 15, n = i & 63;
      const float* src = im ? p->c_im : p->c_re;
      Cs[n * 32 + im * 16 + cp] = src[((size_t)(layer * 128 + g) * 16 + cp) * 64 + n];
    }
    {
      int t = c * 64 + lane;
      const u16* up = uz + (size_t)(b * 4096 + t) * 4096 + g * 16;
      bf16x8 u0 = *(const bf16x8*)up, u1 = *(const bf16x8*)(up + 8);
#pragma unroll
      for (int j = 0; j < 8; j++) { uw[lane * 16 + j] = bf2f((u16)u0[j]); uw[lane * 16 + 8 + j] = bf2f((u16)u1[j]); }
    }
    int gi = (layer * 128 + g) * 64 + lane;
    float br[16], bi[16];
#pragma unroll
    for (int k = 0; k < 16; k++) { br[k] = bbre[(size_t)gi * 16 + k]; bi[k] = bbim[(size_t)gi * 16 + k]; }
    float2 a = abar[gi];
    float2 x0 = st[((size_t)bg * 64 + c) * 64 + lane];
    float xr = x0.x, xi = x0.y;
    const int s16 = lane >> 2, cq = lane & 3;
    float4 dsk = *(const float4*)&p->dskip[layer * 2048 + g * 16 + cq * 4];
    __syncthreads();
    for (int sub = 0; sub < 4; sub++) {
      for (int s = 0; s < 16; s++) {
        int sg = sub * 16 + s;
        float bur = 0, bui = 0;
#pragma unroll
        for (int k4 = 0; k4 < 4; k4++) {
          float4 u = *(const float4*)&uw[sg * 16 + k4 * 4];
          bur += br[k4 * 4 + 0] * u.x + br[k4 * 4 + 1] * u.y + br[k4 * 4 + 2] * u.z + br[k4 * 4 + 3] * u.w;
          bui += bi[k4 * 4 + 0] * u.x + bi[k4 * 4 + 1] * u.y + bi[k4 * 4 + 2] * u.z + bi[k4 * 4 + 3] * u.w;
        }
        float nr = a.x * xr - a.y * xi + bur;
        float ni = a.x * xi + a.y * xr + bui;
        xr = nr; xi = ni;
        *(float2*)&xs[s * 130 + 2 * lane] = make_float2(xr, xi);
      }
      __syncthreads();
      float y0 = 0, y1 = 0, y2 = 0, y3 = 0;
#pragma unroll 8
      for (int n = 0; n < 64; n++) {
        float2 xv = *(const float2*)&xs[s16 * 130 + 2 * n];
        float4 cr = *(const float4*)&Cs[n * 32 + cq * 4];
        float4 ci = *(const float4*)&Cs[n * 32 + 16 + cq * 4];
        y0 += cr.x * xv.x - ci.x * xv.y; y1 += cr.y * xv.x - ci.y * xv.y;
        y2 += cr.z * xv.x - ci.z * xv.y; y3 += cr.w * xv.x - ci.w * xv.y;
      }
      int sg = sub * 16 + s16;
      float4 u = *(const float4*)&uw[sg * 16 + cq * 4];
      y0 = gelu_tanh(y0 + dsk.x * u.x); y1 = gelu_tanh(y1 + dsk.y * u.y);
      y2 = gelu_tanh(y2 + dsk.z * u.z); y3 = gelu_tanh(y3 + dsk.w * u.w);
      int t = c * 64 + sg;
      uint2 o;
      o.x = (unsigned)f2bf(y0) | ((unsigned)f2bf(y1) << 16);
      o.y = (unsigned)f2bf(y2) | ((unsigned)f2bf(y3) << 16);
      *(uint2*)&yb[(size_t)(b * 4096 + t) * 2048 + g * 16 + cq * 4] = o;
      __syncthreads();
    }
  }
}

DEVFN void phase_compress(const int WID, PP p) {
  const int BID = opaque_bid();
  const int tid = opaque_tid(WID), lane = tid & 63, wave = tid >> 6;
  char* ws = p->ws;
  const u16* kvb = (const u16*)(ws + OFF_KVB);
  const float* peb = (const float*)(ws + OFF_PEB);
  u16* kc = (u16*)(ws + OFF_KC); u16* vct = (u16*)(ws + OFF_VCT);
  float* red = (float*)smem;
  float* hm = red + 8 * 2048;
  for (int task = BID; task < 510; task += gridDim.x) {
    int kvi = task / 255, tile = task % 255;
    const u16* w1t = (const u16*)(ws + OFF_W1T) + (size_t)kvi * 128 * 4096;
    int R = tile * 16 + (lane & 15);
    int b = R / 1020, rem = R % 1020, n = rem >> 2, g = rem & 3;
    const u16* arow = kvb + (size_t)(b * 4096 + 16 * n) * 3072 + kvi * 512 + g * 128;
    f32x4 acc[8] = {};
#pragma unroll 4
    for (int ks = 0; ks < 16; ks++) {
      int s = wave * 4 + (ks >> 2), d = (ks & 3) * 32 + (lane >> 4) * 8;
      bf16x8 af = *(const bf16x8*)&arow[(size_t)s * 3072 + d];
      int k = wave * 512 + ks * 32 + (lane >> 4) * 8;
#pragma unroll
      for (int nt = 0; nt < 8; nt++) {
        bf16x8 bfr = *(const bf16x8*)&w1t[(size_t)(nt * 16 + (lane & 15)) * 4096 + k];
        acc[nt] = __builtin_amdgcn_mfma_f32_16x16x32_bf16(af, bfr, acc[nt], 0, 0, 0);
      }
    }
#pragma unroll
    for (int nt = 0; nt < 8; nt++)
#pragma unroll
      for (int j = 0; j < 4; j++) red[wave * 2048 + ((lane >> 4) * 4 + j) * 128 + nt * 16 + (lane & 15)] = acc[nt][j];
    __syncthreads();
    for (int i = tid; i < 2048; i += 512) {
      float s = 0;
#pragma unroll
      for (int w = 0; w < 8; w++) s += red[w * 2048 + i];
      hm[i] = gelu_tanh(s + peb[kvi * 128 + (i & 127)]);
    }
    __syncthreads();
    {
      int r = tid >> 5, c0 = (tid & 31) * 4;
      const float* w2 = p->cmp_w2 + (size_t)kvi * 128 * 128;
      float4 o = *(const float4*)&p->cmp_b2[kvi * 128 + c0];
#pragma unroll 16
      for (int k = 0; k < 128; k++) {
        float hv = hm[r * 128 + k];
        float4 w = *(const float4*)&w2[k * 128 + c0];
        o.x += hv * w.x; o.y += hv * w.y; o.z += hv * w.z; o.w += hv * w.w;
      }
      int R2 = tile * 16 + r;
      int b2 = R2 / 1020, rem2 = R2 % 1020, n2 = rem2 >> 2, g2 = rem2 & 3;
      if (kvi == 0) {
        u16* dst = kc + ((size_t)((b2 * 4 + g2) * 256 + n2)) * 128 + c0;
        uint2 pk;
        pk.x = (unsigned)f2bf(o.x) | ((unsigned)f2bf(o.y) << 16);
        pk.y = (unsigned)f2bf(o.z) | ((unsigned)f2bf(o.w) << 16);
        *(uint2*)dst = pk;
      } else {
        u16* dst = vct + ((size_t)((b2 * 4 + g2) * 128 + c0)) * 256 + n2;
        dst[0] = f2bf(o.x); dst[256] = f2bf(o.y); dst[512] = f2bf(o.z); dst[768] = f2bf(o.w);
      }
    }
    __syncthreads();
  }
}

__device__ __forceinline__ float quad_sum(float v) {
  float a = v + __int_as_float(__builtin_amdgcn_update_dpp(0, __float_as_int(v), 0xB1, 0xF, 0xF, false));
  return a + __int_as_float(__builtin_amdgcn_update_dpp(0, __float_as_int(a), 0x4E, 0xF, 0xF, false));
}

DEVFN void phase_n2(const int WID, PP p) {
  const int BID = opaque_bid();
  const int tid = opaque_tid(WID), lane = tid & 63, wave = tid >> 6;
  char* ws = p->ws;
  const u16* q = (const u16*)(ws + OFF_Q);
  const u16* kc = (const u16*)(ws + OFF_KC); const u16* vct = (const u16*)(ws + OFF_VCT);
  u16* sz3 = (u16*)(ws + OFF_SZ3);
  const float* gates = (const float*)(ws + OFF_GATES);
  u64* selm = (u64*)(ws + OFF_SELM);
  char* Kl = smem;
  char* Vl = smem + 69632;
  float* psl = (float*)(smem + 137216) + wave * 256;
  const int l15 = lane & 15, l4 = lane >> 4;
  for (int task = BID; task < 256; task += gridDim.x) {
    const int bg = task >> 4, rr = task & 15;
    const int b = bg >> 2, g = bg & 3;
    const int thi = (31 - rr) * 128;
    const int NTb = min(16, (((thi + 127 - 31) >> 4) + 1 + 15) >> 4);
    __syncthreads();
    for (int ci = tid; ci < ((NTb + 1) & ~1) * 256; ci += 512) {
      int row = ci >> 4, c16 = ci & 15;
      *(uint4*)(Kl + row * 272 + c16 * 16) = *(const uint4*)&kc[((size_t)bg * 256 + row) * 128 + c16 * 8];
    }
    {
      const int cpr = ((NTb + 1) >> 1) * 4;
      for (int ci = tid; ci < 128 * cpr; ci += 512) {
        int row = ci / cpr, ch = ci - row * cpr;
        *(uint4*)(Vl + row * 528 + ch * 16) = *(const uint4*)&vct[((size_t)bg * 128 + row) * 256 + ch * 8];
      }
    }
    __syncthreads();
    const int head = g * 4 + (l15 & 3);
    bf16x8 Qf[4];
    {
      const int tl0 = thi + wave * 16 + (l15 >> 2);
#pragma unroll
      for (int kk = 0; kk < 4; kk++)
        Qf[kk] = *(const bf16x8*)&q[(size_t)(b * 4096 + tl0) * 2048 + head * 128 + kk * 32 + l4 * 8];
    }
#pragma unroll 1
    for (int it = 0; it < 8; it++) {
      const int t0 = ((it < 4) ? thi : rr * 128) + wave * 16 + (it & 3) * 4;
      const int tl = t0 + (l15 >> 2);
      const int tmax = t0 + 3;
      const int nvmax = (tmax >= 31) ? ((tmax - 31) >> 4) + 1 : 0;
      const int NT = (nvmax + 15) >> 4;
      const int nvalid = (tl >= 31) ? ((tl - 31) >> 4) + 1 : 0;
      f32x4 S[16];
#pragma unroll
      for (int kt = 0; kt < 16; kt++) S[kt] = f32x4{0.f, 0.f, 0.f, 0.f};
#pragma unroll
      for (int kp = 0; kp < 8; kp++) {
        if (2 * kp < NT) {
          bf16x8 kf[2][4];
#pragma unroll
          for (int h = 0; h < 2; h++)
#pragma unroll
            for (int kk = 0; kk < 4; kk++)
              kf[h][kk] = *(const bf16x8*)(Kl + ((2 * kp + h) * 16 + l15) * 272 + (kk * 32 + l4 * 8) * 2);
          asm volatile("" ::: "memory");
#pragma unroll
          for (int kk = 0; kk < 4; kk++)
#pragma unroll
            for (int h = 0; h < 2; h++)
              S[2 * kp + h] = __builtin_amdgcn_mfma_f32_16x16x32_bf16(kf[h][kk], Qf[kk], S[2 * kp + h], 0, 0, 0);
        }
      }
      {
        const int itn = (it < 7) ? it + 1 : 7;
        const int tln = ((itn < 4) ? thi : rr * 128) + wave * 16 + (itn & 3) * 4 + (l15 >> 2);
#pragma unroll
        for (int kk = 0; kk < 4; kk++)
          Qf[kk] = *(const bf16x8*)&q[(size_t)(b * 4096 + tln) * 2048 + head * 128 + kk * 32 + l4 * 8];
      }
      float mx = -1e30f;
#pragma unroll
      for (int kt = 0; kt < 16; kt++)
#pragma unroll
        for (int j = 0; j < 4; j++) { bool ok = (kt * 16 + l4 * 4 + j) < nvalid; mx = fmaxf(mx, ok ? S[kt][j] : -1e30f); }
      mx = fmaxf(mx, shx(mx, 16, lane));
      mx = fmaxf(mx, shx(mx, 32, lane));
      float sm = 0.f;
#pragma unroll
      for (int kt = 0; kt < 16; kt++)
#pragma unroll
        for (int j = 0; j < 4; j++) {
          bool ok = (kt * 16 + l4 * 4 + j) < nvalid;
          float e = ok ? __builtin_amdgcn_exp2f(S[kt][j] - mx) : 0.f; S[kt][j] = e; sm += e;
        }
      sm += shx(sm, 16, lane);
      sm += shx(sm, 32, lane);
      const float inv = (sm > 0.f) ? 1.f / sm : 0.f;
#pragma unroll
      for (int kt = 0; kt < 16; kt++)
#pragma unroll
        for (int j = 0; j < 4; j++) S[kt][j] *= inv;
      {
        float v3q[16], wq[16];
#pragma unroll
        for (int kt = 0; kt < 16; kt++) {
          wq[kt] = quad_sum(2.f * (S[kt][0] + S[kt][1] + S[kt][2]) + S[kt][3]);
          v3q[kt] = quad_sum(S[kt][3]);
        }
        const int srcl = (l4 > 0) ? lane - 16 : lane + 48;
#pragma unroll
        for (int kt = 0; kt < 16; kt++) {
          float pub = (l4 == 3) ? ((kt > 0) ? v3q[kt > 0 ? kt - 1 : 0] : 0.f) : v3q[kt];
          float prev = __int_as_float(__builtin_amdgcn_ds_bpermute(srcl << 2, __float_as_int(pub)));
          if ((l15 & 3) == 0) psl[(l15 >> 2) * 64 + kt * 4 + l4] = wq[kt] + prev;
        }
      }
      f32x4 O[8];
#pragma unroll
      for (int dt = 0; dt < 8; dt++) O[dt] = f32x4{0.f, 0.f, 0.f, 0.f};
      const int nks = (NT + 1) >> 1;
      const size_t tok = (size_t)(b * 4096 + tl);
      const float gate = gates[tok * 48 + head];
      uint2 zz[8];
#pragma unroll
      for (int dt = 0; dt < 8; dt++) zz[dt] = *(const uint2*)&sz3[tok * 6144 + head * 128 + dt * 16 + l4 * 4];
#pragma unroll
      for (int ks = 0; ks < 8; ks++) {
        if (ks < nks) {
          bf16x8 pf = mk8(pk_bf16(S[2 * ks][0], S[2 * ks][1]), pk_bf16(S[2 * ks][2], S[2 * ks][3]),
                          pk_bf16(S[2 * ks + 1][0], S[2 * ks + 1][1]), pk_bf16(S[2 * ks + 1][2], S[2 * ks + 1][3]));
          bf16x8 vf[8];
#pragma unroll
          for (int dt = 0; dt < 8; dt++) {
            const char* vrow = Vl + (dt * 16 + l15) * 528 + (ks * 32 + l4 * 4) * 2;
            uint2 h0 = *(const uint2*)(vrow);
            uint2 h1 = *(const uint2*)(vrow + 32);
            vf[dt] = mk8(h0.x, h0.y, h1.x, h1.y);
          }
          asm volatile("" ::: "memory");
#pragma unroll
          for (int dt = 0; dt < 8; dt++) O[dt] = __builtin_amdgcn_mfma_f32_16x16x32_bf16(vf[dt], pf, O[dt], 0, 0, 0);
        }
      }
      {
#pragma unroll
        for (int dt = 0; dt < 8; dt++) {
          size_t zi = tok * 6144 + head * 128 + dt * 16 + l4 * 4;
          uint2 o;
          o.x = pk_bf16(O[dt][0] * gate * __uint_as_float(zz[dt].x << 16), O[dt][1] * gate * __uint_as_float(zz[dt].x & 0xffff0000u));
          o.y = pk_bf16(O[dt][2] * gate * __uint_as_float(zz[dt].y << 16), O[dt][3] * gate * __uint_as_float(zz[dt].y & 0xffff0000u));
          *(uint2*)&sz3[zi] = o;
        }
      }
      __builtin_amdgcn_fence(__ATOMIC_SEQ_CST, "wavefront");
      __builtin_amdgcn_wave_barrier();
#pragma unroll 1
      for (int tk = 0; tk < 4; tk++) {
        int t = t0 + tk, cur = t >> 6;
        float pslv = psl[tk * 64 + lane];
        bool valid = lane <= cur;
        bool forced = (lane == 0) || (lane == cur) || (lane == cur - 1);
        float key = valid ? (forced ? 3e38f : pslv) : -1.f;
        int cnt = 0;
#pragma unroll 4
        for (int jp = 0; jp < 64; jp++) {
          float kp = __int_as_float(__builtin_amdgcn_readlane(__float_as_int(key), jp));
          cnt += ((kp > key) || (kp == key && jp < lane)) ? 1 : 0;
        }
        bool sel = valid && (cnt < 16);
        u64 m = __ballot(sel);
        if (lane == 0) selm[(size_t)bg * 4096 + t] = m;
      }
      __builtin_amdgcn_fence(__ATOMIC_SEQ_CST, "wavefront");
      __builtin_amdgcn_wave_barrier();
    }
  }
}


DEVFN void phase_gates(const int WID, PP p, int j) {
  const int BID = opaque_bid();
  const int tid = opaque_tid(WID), lane = tid & 63, wave = tid >> 6;
  char* ws = p->ws;
  const u16* h = (const u16*)(ws + OFF_HBUF);
  const u16* wg = (const u16*)(ws + OFF_WT_QG) + (size_t)j * 8448 * 2048 + (size_t)8192 * 2048;
  float* gates = (float*)(ws + OFF_GATES);
  float* red = (float*)smem;
  const int l15 = lane & 15, l4 = lane >> 4;
  const int mt = wave & 3, kh = wave >> 2;
  for (int bt = BID; bt < 256; bt += gridDim.x) {
    const int row0 = bt * 64 + mt * 16;
    f32x4 acc[3];
#pragma unroll
    for (int nt = 0; nt < 3; nt++) acc[nt] = f32x4{0.f, 0.f, 0.f, 0.f};
    const u16* ap = h + (size_t)(row0 + l15) * 2048 + kh * 1024 + l4 * 8;
    const u16* bp = wg + (size_t)l15 * 2048 + kh * 1024 + l4 * 8;
#pragma unroll 8
    for (int ks = 0; ks < 32; ks++) {
      bf16x8 af = *(const bf16x8*)&ap[ks * 32];
#pragma unroll
      for (int nt = 0; nt < 3; nt++) {
        bf16x8 bfr = *(const bf16x8*)&bp[(size_t)nt * 16 * 2048 + ks * 32];
        acc[nt] = __builtin_amdgcn_mfma_f32_16x16x32_bf16(af, bfr, acc[nt], 0, 0, 0);
      }
    }
    __syncthreads();
    if (kh == 1) {
#pragma unroll
      for (int nt = 0; nt < 3; nt++)
#pragma unroll
        for (int jj = 0; jj < 4; jj++) red[(mt * 16 + l4 * 4 + jj) * 48 + nt * 16 + l15] = acc[nt][jj];
    }
    __syncthreads();
    if (kh == 0) {
#pragma unroll
      for (int nt = 0; nt < 3; nt++)
#pragma unroll
        for (int jj = 0; jj < 4; jj++) {
          float v = acc[nt][jj] + red[(mt * 16 + l4 * 4 + jj) * 48 + nt * 16 + l15];
          gates[(size_t)(row0 + l4 * 4 + jj) * 48 + nt * 16 + l15] = sigmoidf_(v);
        }
    }
  }
}


DEVFN void phase_n3(const int WID, PP p) {
  const int BID = opaque_bid();
  const int tid = opaque_tid(WID), lane = tid & 63, wave = tid >> 6;
  char* ws = p->ws;
  const u16* q = (const u16*)(ws + OFF_Q);
  const u16* kvb = (const u16*)(ws + OFF_KVB);
  const u16* vt = (const u16*)(ws + OFF_VT);
  u16* sz3 = (u16*)(ws + OFF_SZ3);
  u16* ocomb = (u16*)(ws + OFF_HBUF);
  const float* gates = (const float*)(ws + OFF_GATES);
  const u64* selm = (const u64*)(ws + OFF_SELM);
  char* Ks = smem;
  char* Vs = smem + 32768;
  char* Qs = smem + 65536 + wave * 8704;
  const unsigned lds0 = (unsigned)(unsigned long)(__attribute__((address_space(3))) char*)smem;
  const int l15 = lane & 15, l4 = lane >> 4;
  unsigned koff[2], voff[2];
#pragma unroll
  for (int i = 0; i < 2; i++) {
    int slab = i * 8 + wave;
    int rk = slab * 4 + (lane >> 4), ck = (lane & 15) ^ (rk & 15);
    koff[i] = (unsigned)(rk * 3072 + ck * 8) * 2u;
    int rv = slab * 8 + (lane >> 3), cv = (lane & 7) ^ ((rv >> 1) & 7);
    voff[i] = (unsigned)(rv * 4096 + cv * 8) * 2u;
  }
  const unsigned slab0 = (unsigned)__builtin_amdgcn_readfirstlane(wave * 1024);
#define N3_DMA(voffv, sbase, ldsa) asm volatile("s_mov_b32 m0, %2\n\ts_nop 0\n\tglobal_load_lds_dwordx4 %0, %1" :: "v"(voffv), "s"(sbase), "s"(ldsa) : "memory")
  int kofs[4], vofs[4];
#pragma unroll
  for (int kk = 0; kk < 4; kk++) kofs[kk] = l15 * 256 + (((kk * 4 + l4) ^ l15) & 15) * 16;
#pragma unroll
  for (int c = 0; c < 4; c++) {
    int logical = (c >> 1) * 4 + (l4 >> 1) + (c & 1) * 2;
    vofs[c] = l15 * 128 + ((logical ^ ((l15 >> 1) & 7)) & 7) * 16 + (l4 & 1) * 8;
  }
  const int qofs = l15 * 272 + l4 * 16;
  for (int task = BID; task < 512; task += gridDim.x) {
    int bg = task >> 5, pp = task & 31; int b = bg >> 2, g = bg & 3;
#pragma unroll 1
    for (int half = 0; half < 2; half++) {
      int cur = half ? pp : 63 - pp;
      int tq0 = cur * 64 + wave * 8;
#pragma unroll
      for (int i = 0; i < 8; i++) {
        int ci = lane + 64 * i; int row = ci >> 4, c16 = ci & 15;
        uint4 v = *(const uint4*)&q[(size_t)(b * 4096 + tq0 + (row >> 2)) * 2048 + (g * 4 + (row & 3)) * 128 + c16 * 8];
        *(uint4*)(Qs + row * 272 + c16 * 16) = v;
      }
      __builtin_amdgcn_fence(__ATOMIC_SEQ_CST, "wavefront");
      __builtin_amdgcn_wave_barrier();
      int tokL[2]; u64 sm_[2];
#pragma unroll
      for (int mt = 0; mt < 2; mt++) { tokL[mt] = tq0 + mt * 4 + (l15 >> 2); sm_[mt] = selm[(size_t)bg * 4096 + tokL[mt]]; }
      u64 wm = 0;
#pragma unroll
      for (int i = 0; i < 8; i++) wm |= selm[(size_t)bg * 4096 + tq0 + i];
      const int head = g * 4 + (l15 & 3);
#pragma unroll 1
      for (int mode = 0; mode < 2; mode++) {
        int jb0 = (mode == 0) ? 0 : max(0, cur - 8);
        int ntile = cur - jb0 + 1;
        int kbr = (mode == 0) ? 2 : 4;
        const u16* kbase = kvb + (size_t)b * 4096 * 3072 + kbr * 512 + g * 128;
        const u16* vbase = vt + (size_t)((mode * 4 + b) * 4 + g) * 128 * 4096;
        f32x4 O[8][2];
        float mrow[2], ls[2];
#pragma unroll
        for (int mt = 0; mt < 2; mt++) {
#pragma unroll
          for (int dt = 0; dt < 8; dt++) O[dt][mt] = f32x4{0.f, 0.f, 0.f, 0.f};
          mrow[mt] = -1e30f; ls[mt] = 0.f;
        }
        __syncthreads();
        {
          const char* kb_ = (const char*)(kbase + (size_t)jb0 * 64 * 3072);
          const char* vb_ = (const char*)(vbase + (size_t)jb0 * 64);
          N3_DMA(koff[0], kb_, lds0 + slab0);
          N3_DMA(koff[1], kb_, lds0 + slab0 + 8192u);
          N3_DMA(voff[0], vb_, lds0 + 32768u + slab0);
          N3_DMA(voff[1], vb_, lds0 + 32768u + slab0 + 8192u);
        }
        asm volatile("s_waitcnt vmcnt(0)" ::: "memory");
        __syncthreads();
        for (int it = 0; it < ntile; it++) {
          int jb = jb0 + it;
          const int jn = (it + 1 < ntile) ? jb + 1 : jb;
          {
            const unsigned nb = (unsigned)((it + 1) & 1) * 16384u;
            const char* kb_ = (const char*)(kbase + (size_t)jn * 64 * 3072);
            const char* vb_ = (const char*)(vbase + (size_t)jn * 64);
            N3_DMA(koff[0], kb_, lds0 + nb + slab0);
            N3_DMA(koff[1], kb_, lds0 + nb + slab0 + 8192u);
            N3_DMA(voff[0], vb_, lds0 + 32768u + nb + slab0);
            N3_DMA(voff[1], vb_, lds0 + 32768u + nb + slab0 + 8192u);
          }
          const char* Kc = Ks + (it & 1) * 16384;
          const char* Vc = Vs + (it & 1) * 16384;
          bool act = (mode == 1) || ((wm >> jb) & 1ull);
          if (act) {
            f32x4 S[4][2];
#pragma unroll
            for (int nt = 0; nt < 4; nt++)
#pragma unroll
              for (int mt = 0; mt < 2; mt++) S[nt][mt] = f32x4{0.f, 0.f, 0.f, 0.f};
#define N3_LOADKQ(kk, qf, kf) do { \
              _Pragma("unroll") for (int mt = 0; mt < 2; mt++) qf[mt] = *(const bf16x8*)(Qs + qofs + mt * 4352 + (kk) * 64); \
              _Pragma("unroll") for (int nt = 0; nt < 4; nt++) kf[nt] = *(const bf16x8*)(Kc + kofs[kk] + nt * 4096); } while (0)
#define N3_MMAS(qf, kf) do { \
              _Pragma("unroll") for (int nt = 0; nt < 4; nt++) \
              _Pragma("unroll") for (int mt = 0; mt < 2; mt++) S[nt][mt] = __builtin_amdgcn_mfma_f32_16x16x32_bf16(kf[nt], qf[mt], S[nt][mt], 0, 0, 0); } while (0)
#define CBAR asm volatile("" ::: "memory")
            {
              bf16x8 qa[2], ka[4], qb[2], kb[4];
              N3_LOADKQ(0, qa, ka); CBAR;
              N3_LOADKQ(1, qb, kb); CBAR;
              N3_MMAS(qa, ka);
              N3_LOADKQ(2, qa, ka); CBAR;
              N3_MMAS(qb, kb);
              N3_LOADKQ(3, qb, kb); CBAR;
              N3_MMAS(qa, ka);
              N3_MMAS(qb, kb);
            }
            const bool interior = (mode == 0) ? (jb < cur) : (jb < cur && jb > cur - 8);
            bf16x8 Pf[2][2];
            float alpha[2];
#pragma unroll
            for (int mt = 0; mt < 2; mt++) {
              const bool rowok = (mode == 1) || ((sm_[mt] >> jb) & 1ull);
              const int tt = tokL[mt];
              float mx = -1e30f;
              float psum = 0.f;
              if (interior) {
#pragma unroll
                for (int nt = 0; nt < 4; nt++)
#pragma unroll
                  for (int j = 0; j < 4; j++) mx = fmaxf(mx, S[nt][mt][j]);
                mx = rowok ? mx : -1e30f;
                mx = fmaxf(mx, shx(mx, 16, lane));
                mx = fmaxf(mx, shx(mx, 32, lane));
                float mnew = fmaxf(mrow[mt], mx);
                alpha[mt] = __builtin_amdgcn_exp2f(mrow[mt] - mnew);
                mrow[mt] = mnew;
                const float msub = rowok ? mnew : 1e30f;
#pragma unroll
                for (int nt = 0; nt < 4; nt++)
#pragma unroll
                  for (int j = 0; j < 4; j++) { float pv = __builtin_amdgcn_exp2f(S[nt][mt][j] - msub); S[nt][mt][j] = pv; psum += pv; }
              } else {
#pragma unroll
                for (int nt = 0; nt < 4; nt++)
#pragma unroll
                  for (int j = 0; j < 4; j++) {
                    int kp = jb * 64 + nt * 16 + l4 * 4 + j;
                    bool ok = rowok && (kp <= tt) && ((mode == 0) || (kp + 512 > tt));
                    float sv = ok ? S[nt][mt][j] : -1e30f; S[nt][mt][j] = sv; mx = fmaxf(mx, sv);
                  }
                mx = fmaxf(mx, shx(mx, 16, lane));
                mx = fmaxf(mx, shx(mx, 32, lane));
                float mnew = fmaxf(mrow[mt], mx);
                alpha[mt] = __builtin_amdgcn_exp2f(mrow[mt] - mnew);
                mrow[mt] = mnew;
#pragma unroll
                for (int nt = 0; nt < 4; nt++)
#pragma unroll
                  for (int j = 0; j < 4; j++) {
                    float sv = S[nt][mt][j];
                    float pv = (sv > -1e29f) ? __builtin_amdgcn_exp2f(sv - mnew) : 0.f;
                    S[nt][mt][j] = pv; psum += pv;
                  }
              }
              ls[mt] = ls[mt] * alpha[mt] + psum;
#pragma unroll
              for (int ks = 0; ks < 2; ks++) {
                Pf[mt][ks] = mk8(pk_bf16(S[2 * ks][mt][0], S[2 * ks][mt][1]), pk_bf16(S[2 * ks][mt][2], S[2 * ks][mt][3]),
                                 pk_bf16(S[2 * ks + 1][mt][0], S[2 * ks + 1][mt][1]), pk_bf16(S[2 * ks + 1][mt][2], S[2 * ks + 1][mt][3]));
              }
            }
            if (__builtin_amdgcn_ballot_w64((alpha[0] != 1.f) || (alpha[1] != 1.f)) != 0ull) {
#pragma unroll
              for (int mt = 0; mt < 2; mt++)
#pragma unroll
                for (int dt = 0; dt < 8; dt++)
#pragma unroll
                  for (int j = 0; j < 4; j++) O[dt][mt][j] *= alpha[mt];
            }
#define N3_LOADV(ks, d0, vf) do { \
              _Pragma("unroll") for (int dd = 0; dd < 4; dd++) { \
                uint2 h0 = *(const uint2*)(Vc + vofs[(ks) * 2] + ((d0) + dd) * 2048); uint2 h1 = *(const uint2*)(Vc + vofs[(ks) * 2 + 1] + ((d0) + dd) * 2048); \
                vf[dd] = mk8(h0.x, h0.y, h1.x, h1.y); } } while (0)
#define N3_MMAV(ks, d0, vf) do { \
              _Pragma("unroll") for (int dd = 0; dd < 4; dd++) \
              _Pragma("unroll") for (int mt = 0; mt < 2; mt++) O[(d0) + dd][mt] = __builtin_amdgcn_mfma_f32_16x16x32_bf16(vf[dd], Pf[mt][ks], O[(d0) + dd][mt], 0, 0, 0); } while (0)
            {
              bf16x8 va[4], vb[4];
              N3_LOADV(0, 0, va); CBAR;
              N3_LOADV(0, 4, vb); CBAR;
              N3_MMAV(0, 0, va);
              N3_LOADV(1, 0, va); CBAR;
              N3_MMAV(0, 4, vb);
              N3_LOADV(1, 4, vb); CBAR;
              N3_MMAV(1, 0, va);
              N3_MMAV(1, 4, vb);
            }
          }
          asm volatile("s_waitcnt vmcnt(0)" ::: "memory");
          __syncthreads();
        }
#pragma unroll
        for (int mt = 0; mt < 2; mt++) {
          size_t tok = (size_t)(b * 4096 + tokL[mt]);
          float l = ls[mt];
          l += shx(l, 16, lane);
          l += shx(l, 32, lane);
          float inv = (l > 0.f) ? 1.f / l : 0.f;
          float gate = gates[tok * 48 + (mode + 1) * 16 + head] * inv;
#pragma unroll
          for (int dt = 0; dt < 8; dt++) {
            int d0 = dt * 16 + l4 * 4;
            size_t zi = tok * 6144 + (size_t)(mode + 1) * 2048 + head * 128 + d0;
            uint2 zz = *(const uint2*)&sz3[zi];
            float v0 = O[dt][mt][0] * gate * __uint_as_float(zz.x << 16);
            float v1 = O[dt][mt][1] * gate * __uint_as_float(zz.x & 0xffff0000u);
            float v2 = O[dt][mt][2] * gate * __uint_as_float(zz.y << 16);
            float v3 = O[dt][mt][3] * gate * __uint_as_float(zz.y & 0xffff0000u);
            if (mode == 0) {
              uint2 o; o.x = pk_bf16(v0, v1); o.y = pk_bf16(v2, v3);
              *(uint2*)&ocomb[tok * 2048 + head * 128 + d0] = o;
            } else {
              uint2 c0 = *(const uint2*)&sz3[tok * 6144 + head * 128 + d0];
              uint2 c1 = *(const uint2*)&ocomb[tok * 2048 + head * 128 + d0];
              v0 += __uint_as_float(c0.x << 16) + __uint_as_float(c1.x << 16);
              v1 += __uint_as_float(c0.x & 0xffff0000u) + __uint_as_float(c1.x & 0xffff0000u);
              v2 += __uint_as_float(c0.y << 16) + __uint_as_float(c1.y << 16);
              v3 += __uint_as_float(c0.y & 0xffff0000u) + __uint_as_float(c1.y & 0xffff0000u);
              uint2 o; o.x = pk_bf16(v0, v1); o.y = pk_bf16(v2, v3);
              *(uint2*)&ocomb[tok * 2048 + head * 128 + d0] = o;
            }
          }
        }
      }
    }
  }
}

constexpr int N_PHASES = 27;

DEVFN void decode_phase(int ph, int& kind, int& arg) {
  arg = 0;
  if (ph == 0) kind = 0;
  else if (ph <= 14) { arg = (ph - 1) / 7; kind = 1 + (ph - 1) % 7; }
  else {
    switch (ph) {
      case 15: kind = 1; arg = 2; break;
      case 16: kind = 8; break;
      case 17: kind = 10; arg = 0; break;
      case 18: kind = 11; break;
      case 19: kind = 12; break;
      case 20: kind = 7; arg = 2; break;
      case 21: kind = 1; arg = 3; break;
      case 22: kind = 10; arg = 1; break;
      case 23: kind = 11; break;
      case 24: kind = 12; break;
      case 25: kind = 7; arg = 3; break;
      default: kind = 13; break;
    }
  }
}
static void decode_phase_host(int ph, int& kind, int& arg) {
  arg = 0;
  if (ph == 0) kind = 0;
  else if (ph <= 14) { arg = (ph - 1) / 7; kind = 1 + (ph - 1) % 7; }
  else {
    const int kk[12] = {1, 8, 10, 11, 12, 7, 1, 10, 11, 12, 7, 13};
    const int aa[12] = {2, 0, 0, 0, 0, 2, 3, 1, 0, 0, 3, 0};
    kind = kk[ph - 15]; arg = aa[ph - 15];
  }
}

template <int KIND>
DEVFN void run_kind(const int WID, PP p, int arg) {
  char* ws = p->ws;
  if constexpr (KIND == 0) phase_prep(WID, p);
  else if constexpr (KIND == 1) { phase_prenorm(WID, p, arg, arg == 2); if (arg < 2) phase_ssm_gen(WID, p, arg); if (arg == 2) phase_peb_final(WID, p); }
  else if constexpr (KIND == 2) gemm_phase<EPI_S1>(WID, p, (const u16*)(ws + OFF_HBUF), (const u16*)(ws + OFF_WT_IN) + (size_t)arg * 4096 * 2048, 4096, arg);
  else if constexpr (KIND == 3) phase_ssm_x1(WID, p, arg);
  else if constexpr (KIND == 4) phase_ssm_b(WID, p, arg);
  else if constexpr (KIND == 5) phase_ssm_x3(WID, p, arg);
  else if constexpr (KIND == 6) gemm_phase<EPI_S3>(WID, p, (const u16*)(ws + OFF_Y), (const u16*)(ws + OFF_WT_GLU) + (size_t)arg * 2048 * 2048, 2048, arg);
  else if constexpr (KIND == 7) {
    const u16* A = (arg < 2) ? (const u16*)(ws + OFF_V) : (const u16*)(ws + OFF_HBUF);
    const u16* B = (arg < 2) ? (const u16*)(ws + OFF_WT_OUT) + (size_t)arg * 2048 * 2048
                             : (const u16*)(ws + OFF_WT_O) + (size_t)(arg - 2) * 2048 * 2048;
    gemm_phase<EPI_RES>(WID, p, A, B, 2048, arg);
  }
  else if constexpr (KIND == 8) gemm_phase<EPI_KV>(WID, p, (const u16*)(ws + OFF_HKV), (const u16*)(ws + OFF_WT_KV), 3072, 0);
  else if constexpr (KIND == 9) { }
  else if constexpr (KIND == 10) {
    if (arg == 0) phase_compress(WID, p);
    __syncthreads();
    phase_gates(WID, p, arg);
    __syncthreads();
    gemm_phase<EPI_QG>(WID, p, (const u16*)(ws + OFF_HBUF), (const u16*)(ws + OFF_WT_QG) + (size_t)arg * 8448 * 2048, 8192, arg);
  }
  else if constexpr (KIND == 11) phase_n2(WID, p);
  else if constexpr (KIND == 12) phase_n3(WID, p);
  else phase_final(WID, p);
}


#define XB_TMO      128
#define XB_XCNT(j)  (256  + 64 * (j))
#define XB_XSUB(j)  (1280 + 64 * (j))
#define XB_XGEN(j)  (2304 + 64 * (j))
#define XB_TOP      3328
#define XB_TOPGEN   3392
#define XCD_BAR_WORDS 3456
#define XB_SPIN_CAP (1u << 20)
#define LAS __attribute__((address_space(3)))
__device__ __forceinline__ unsigned xb_ld(unsigned* p)              { return __hip_atomic_load(p, __ATOMIC_RELAXED, __HIP_MEMORY_SCOPE_AGENT); }
__device__ __forceinline__ unsigned xb_add(unsigned* p, unsigned v) { return __hip_atomic_fetch_add(p, v, __ATOMIC_RELAXED, __HIP_MEMORY_SCOPE_AGENT); }
__device__ __forceinline__ unsigned xb_xcc_id() { return (unsigned)__builtin_amdgcn_s_getreg((3 << 11) | 20) & 0xFu; }
#define XB_SPIN(cond, bar) do { unsigned _sp = 0; while (cond) { __builtin_amdgcn_s_sleep(1); \
    if ((++_sp & 255u) == 0u) { if (xb_ld(&(bar)[XB_TMO])) break; if (_sp > XB_SPIN_CAP) { atomicAdd(&(bar)[XB_TMO], 1u); break; } } } } while (0)
struct XcdBarrier { unsigned* bar; unsigned x; volatile LAS unsigned* st; };
__device__ __forceinline__ XcdBarrier xcd_barrier_post(unsigned* bar, volatile LAS unsigned* st) {
  XcdBarrier b; b.bar = bar; b.x = xb_xcc_id(); b.st = st;
  if (threadIdx.x == 0) (void)xb_add(&bar[XB_XCNT(b.x)], 1u);
  return b;
}
__device__ __forceinline__ void xcd_barrier_complete(unsigned* bar, unsigned x, unsigned& nloc, unsigned& nx) {
  const unsigned G = gridDim.x * gridDim.y * gridDim.z;
  unsigned sum, cnt, mine, sp = 0u;
  for (;;) {
    sum = 0u; cnt = 0u; mine = 0u;
#pragma unroll
    for (unsigned j = 0; j < 16; ++j) { const unsigned c = xb_ld(&bar[XB_XCNT(j)]); sum += c; cnt += (c > 0u) ? 1u : 0u; mine = (j == x) ? c : mine; }
    if (sum == G) break;
    __builtin_amdgcn_s_sleep(1);
    if ((++sp & 255u) == 0u) { if (xb_ld(&bar[XB_TMO])) break; if (sp > XB_SPIN_CAP) { atomicAdd(&bar[XB_TMO], 1u); break; } }
  }
  nloc = mine > 0u ? mine : 1u; nx = cnt > 0u ? cnt : 1u;
}
__device__ __forceinline__ void xcd_barrier(const XcdBarrier& b, const int WID) {
  asm volatile("s_waitcnt vmcnt(0)" ::: "memory");
  __syncthreads();
  if (opaque_tid(WID) == 0) {
    unsigned* bar = b.bar; asm volatile("" : "+s"(bar));
    __builtin_amdgcn_s_waitcnt(0);
    unsigned nloc = b.st[0], nx = b.st[1];
    if (nloc == 0u) { xcd_barrier_complete(bar, b.x, nloc, nx); b.st[0] = nloc; b.st[1] = nx; }
    const unsigned old = xb_add(&bar[XB_XSUB(b.x)], 1u);
    const unsigned gen = old / nloc;
    if (old + 1u == (gen + 1u) * nloc) {
      __builtin_amdgcn_fence(__ATOMIC_RELEASE, "agent");
      asm volatile("s_waitcnt vmcnt(0)" ::: "memory");
      const unsigned og = xb_add(&bar[XB_TOP], 1u);
      const unsigned tg = og / nx;
      if (og + 1u == (tg + 1u) * nx) xb_add(&bar[XB_TOPGEN], 1u);
      else XB_SPIN(xb_ld(&bar[XB_TOPGEN]) == tg, bar);
      __builtin_amdgcn_fence(__ATOMIC_ACQUIRE, "agent");
      xb_add(&bar[XB_XGEN(b.x)], 1u);
      asm volatile("s_waitcnt vmcnt(0)" ::: "memory");
    } else {
      XB_SPIN(xb_ld(&bar[XB_XGEN(b.x)]) == gen, bar);
      __builtin_amdgcn_fence(__ATOMIC_ACQUIRE, "agent");
      asm volatile("s_waitcnt vmcnt(0)" ::: "memory");
    }
  }
  __syncthreads();
}

#if ONE_LAUNCH
__global__ void __launch_bounds__(512) mega(Params pv, int lo, int hi) {
  cg::grid_group grid = cg::this_grid();
  PP pp = (PP)__builtin_amdgcn_kernarg_segment_ptr();
  const int WID = __builtin_amdgcn_readfirstlane((int)(threadIdx.x >> 6));
  __shared__ uint4 xb_words;
  if (threadIdx.x == 0) xb_words = make_uint4(0u, 0u, 0u, 0u);
  __syncthreads();
  XcdBarrier xb = xcd_barrier_post((unsigned*)(pp->ws + OFF_BAR), (volatile LAS unsigned*)&xb_words);
  for (int ph = lo; ph < hi; ph++) {
    PP p = opaque_pp(pp);
    int kind, arg;
    decode_phase(ph, kind, arg);
#if REPEAT_MASK
    for (int rep = 0; rep < (((REPEAT_MASK >> kind) & 1) ? 2 : 1); rep++) {
    if (rep) xcd_barrier(xb, WID);
#endif
    switch (kind) {
      case 0: run_kind<0>(WID, p, arg); break;
      case 1: run_kind<1>(WID, p, arg); break;
      case 2: run_kind<2>(WID, p, arg); break;
      case 3: run_kind<3>(WID, p, arg); break;
      case 4: run_kind<4>(WID, p, arg); break;
      case 5: run_kind<5>(WID, p, arg); break;
      case 6: run_kind<6>(WID, p, arg); break;
      case 7: run_kind<7>(WID, p, arg); break;
      case 8: run_kind<8>(WID, p, arg); break;
      case 9: run_kind<9>(WID, p, arg); break;
      case 10: run_kind<10>(WID, p, arg); break;
      case 11: run_kind<11>(WID, p, arg); break;
      case 12: run_kind<12>(WID, p, arg); break;
      default: run_kind<13>(WID, p, arg); break;
    }
#if REPEAT_MASK
    }
#endif
    if (ph + 1 < hi) {
      if (hi > 1000) grid.sync();
      xcd_barrier(xb, WID);
    }
  }
}
#else
template <int KIND>
__global__ void __launch_bounds__(512) pk(Params pv, int arg) {
  PP p = opaque_pp((PP)__builtin_amdgcn_kernarg_segment_ptr());
  const int WID = __builtin_amdgcn_readfirstlane((int)(threadIdx.x >> 6));
  run_kind<KIND>(WID, p, arg);
}
template <int KIND>
static void launch_kind(const Params& p, int arg, int grid, hipStream_t stream) {
  static bool attr_set = false;
  if (!attr_set) { (void)hipFuncSetAttribute((const void*)pk<KIND>, hipFuncAttributeMaxDynamicSharedMemorySize, LDS_BYTES); attr_set = true; }
  hipLaunchKernelGGL(pk<KIND>, dim3(grid), dim3(512), LDS_BYTES, stream, p, arg);
}
#endif

extern "C" void kernel_launch(void* const* d_in, const int* in_sizes, int n_in, void* d_out, int out_size, void* d_ws,
                              size_t ws_size, hipStream_t stream) {
  Params p{};
  const float** f = (const float**)&p;
  for (int i = 0; i < 29; i++) f[i] = (const float*)d_in[i];
  p.out = (float*)d_out;
  p.ws = (char*)d_ws;
#if ONE_LAUNCH
  static int grid_blocks = 0;
  if (!grid_blocks) {
    (void)hipFuncSetAttribute((const void*)mega, hipFuncAttributeMaxDynamicSharedMemorySize, LDS_BYTES);
    int dev = 0, cus = 0, per_cu = 0;
    (void)hipGetDevice(&dev);
    (void)hipDeviceGetAttribute(&cus, hipDeviceAttributeMultiprocessorCount, dev);
    (void)hipOccupancyMaxActiveBlocksPerMultiprocessor(&per_cu, mega, 512, LDS_BYTES);
    if (per_cu < 1) per_cu = 1;
    grid_blocks = cus * per_cu;
    if (ws_size < WS_NEEDED) fprintf(stderr, "workspace too small: %zu < %zu\n", ws_size, (size_t)WS_NEEDED);
  }
  (void)hipMemsetAsync((char*)d_ws + OFF_BAR, 0, 16384, stream);
  int lo = 0, hi = N_PHASES;
  void* args[] = {&p, &lo, &hi};
  hipError_t e = hipLaunchCooperativeKernel((void*)mega, dim3(grid_blocks), dim3(512), args, LDS_BYTES, stream);
  if (e != hipSuccess) fprintf(stderr, "cooperative launch failed: %s (grid %d)\n", hipGetErrorString(e), grid_blocks);
#else
  const int grid = 256;
  for (int ph = 0; ph < N_PHASES; ph++) {
    int kind, arg;
    decode_phase_host(ph, kind, arg);
    for (int rep = 0; rep < (((REPEAT_MASK >> kind) & 1) ? 2 : 1); rep++)
    switch (kind) {
      case 0: launch_kind<0>(p, arg, grid, stream); break;
      case 1: launch_kind<1>(p, arg, grid, stream); break;
      case 2: launch_kind<2>(p, arg, grid, stream); break;
      case 3: launch_kind<3>(p, arg, grid, stream); break;
      case 4: launch_kind<4>(p, arg, grid, stream); break;
      case 5: launch_kind<5>(p, arg, grid, stream); break;
      case 6: launch_kind<6>(p, arg, grid, stream); break;
      case 7: launch_kind<7>(p, arg, grid, stream); break;
      case 8: launch_kind<8>(p, arg, grid, stream); break;
      case 9: launch_kind<9>(p, arg, grid, stream); break;
      case 10: launch_kind<10>(p, arg, grid, stream); break;
      case 11: launch_kind<11>(p, arg, grid, stream); break;
      case 12: launch_kind<12>(p, arg, grid, stream); break;
      default: launch_kind<13>(p, arg, grid, stream); break;
    }
  }
#endif
}
```
